# Optimizing an MI355X kernel written in HIP

```python
import math
import jax
import jax.numpy as jnp
from jax import lax
import numpy as np


D_MODEL = 2048
BATCH = 4
SEQ = 4096
DEPTH = 2

HEAD_DIM = 128
N_MIXERS = 4
GROUP_HEADS = D_MODEL // (N_MIXERS * HEAD_DIM)
GROUP_WIDTH = GROUP_HEADS * HEAD_DIM
MIX_WIDTH = N_MIXERS * GROUP_WIDTH
ROPE_THETA = 10000.0
Q_BLOCK = 128
NORM_EPS = 1e-6

DIFF_HEADS = GROUP_HEADS
DIFF_QK_DIM = HEAD_DIM // 2
DIFF_V_DIM = HEAD_DIM

GRID_W = 64
NA_HEADS = GROUP_HEADS
NA_WIN_ROWS = 8
NA_WIN_COLS = 16
NA_QCOLS = 16
NA_KV_COLS = 2 * NA_WIN_COLS

SWA_Q_HEADS = GROUP_HEADS
SWA_KV_HEADS = GROUP_HEADS // 2
SWA_WINDOW = 128

MLA_HEADS = GROUP_HEADS
MLA_Q_LORA = 512
MLA_KV_LORA = 512
MLA_NOPE = 128
MLA_ROPE = 64
MLA_V = HEAD_DIM

DIFF_COLS = 2 * DIFF_HEADS * 2 * DIFF_QK_DIM + DIFF_HEADS * DIFF_V_DIM
NA_COLS = 3 * NA_HEADS * HEAD_DIM
SWA_COLS = (SWA_Q_HEADS + 2 * SWA_KV_HEADS) * HEAD_DIM
MLA_COLS = MLA_Q_LORA + MLA_KV_LORA + MLA_ROPE
IN_COLS = DIFF_COLS + NA_COLS + SWA_COLS + MLA_COLS

FFN_DIM = 7 * D_MODEL // 2
N_EXPERTS = 8
TOP_K = 2
MOE_BLOCK = 512
N_DENSE = (DEPTH + 1) // 2
N_MOE = DEPTH // 2

PLE_DIM = 256

kernel_name = "hybrid_parallel_heads_encoder"


def rms_norm(x, g):
    x32 = x.astype(jnp.float32)
    y = x32 * lax.rsqrt(jnp.mean(x32 * x32, axis=-1, keepdims=True) + NORM_EPS)
    return (y * g.astype(jnp.float32)).astype(x.dtype)


def rope_tables(seq, dim):
    inv = ROPE_THETA ** (-jnp.arange(0, dim, 2, dtype=jnp.float32) / dim)
    ang = jnp.arange(seq, dtype=jnp.float32)[:, None] * inv[None, :]
    ang = jnp.concatenate([ang, ang], axis=-1)
    return jnp.cos(ang), jnp.sin(ang)


def apply_rope(x, cos, sin):
    x32 = x.astype(jnp.float32)
    half = x.shape[-1] // 2
    rot = jnp.concatenate([-x32[..., half:], x32[..., :half]], axis=-1)
    return (x32 * cos + rot * sin).astype(x.dtype)


def to_heads(t, n_heads):
    b, s, _ = t.shape
    return t.reshape(b, s, n_heads, -1).transpose(0, 2, 1, 3)


def from_heads(t):
    b, h, s, d = t.shape
    return t.transpose(0, 2, 1, 3).reshape(b, s, h * d)


def to_q_blocks(t):
    *lead, s, d = t.shape
    t = t.reshape(*lead, s // Q_BLOCK, Q_BLOCK, d)
    return jnp.moveaxis(t, -3, 0)


def from_q_blocks(o):
    o = jnp.moveaxis(o, 0, -3)
    *lead, nq, qb, d = o.shape
    return o.reshape(*lead, nq * qb, d)


def dense_attention(q, k, v, scale):
    def block(qb):
        s = jnp.einsum('bhqd,bhkd->bhqk', qb, k).astype(jnp.float32) * scale
        return jnp.einsum('bhqk,bhkd->bhqd', jax.nn.softmax(s, axis=-1).astype(v.dtype), v)
    return from_q_blocks(lax.map(block, to_q_blocks(q)))


def diff_attention(z, lq1, lk1, lq2, lk2, subln, lambda_init, cos, sin):
    b, s, _ = z.shape
    qk = DIFF_HEADS * 2 * DIFF_QK_DIM
    q = z[..., :qk].reshape(b, s, DIFF_HEADS, 2, DIFF_QK_DIM).transpose(0, 2, 3, 1, 4)
    k = z[..., qk:2 * qk].reshape(b, s, DIFF_HEADS, 2, DIFF_QK_DIM).transpose(0, 2, 3, 1, 4)
    v = to_heads(z[..., 2 * qk:], DIFF_HEADS)
    q = apply_rope(q, cos, sin)
    k = apply_rope(k, cos, sin)
    k1, k2 = k[:, :, 0], k[:, :, 1]
    lam = (jnp.exp(jnp.sum(lq1.astype(jnp.float32) * lk1.astype(jnp.float32)))
           - jnp.exp(jnp.sum(lq2.astype(jnp.float32) * lk2.astype(jnp.float32)))
           + lambda_init)
    scale = DIFF_QK_DIM ** -0.5

    def block(qb):
        s1 = jnp.einsum('bhqd,bhkd->bhqk', qb[:, :, 0], k1).astype(jnp.float32) * scale
        s2 = jnp.einsum('bhqd,bhkd->bhqk', qb[:, :, 1], k2).astype(jnp.float32) * scale
        w = jax.nn.softmax(s1, axis=-1) - lam * jax.nn.softmax(s2, axis=-1)
        return jnp.einsum('bhqk,bhkd->bhqd', w.astype(v.dtype), v)

    o = from_q_blocks(lax.map(block, to_q_blocks(q)))
    o = rms_norm(o, subln) * (1.0 - lambda_init)
    return from_heads(o)


def neighbourhood_attention(z, rpb):
    b, s, _ = z.shape
    w = NA_HEADS * HEAD_DIM
    q = to_heads(z[..., :w], NA_HEADS)
    k = to_heads(z[..., w:2 * w], NA_HEADS)
    v = to_heads(z[..., 2 * w:], NA_HEADS)
    rows = s // GRID_W
    kr = min(NA_WIN_ROWS, rows)
    q5 = q.reshape(b, NA_HEADS, rows, GRID_W, HEAD_DIM)
    k5 = k.reshape(b, NA_HEADS, rows, GRID_W, HEAD_DIM)
    v5 = v.reshape(b, NA_HEADS, rows, GRID_W, HEAD_DIM)
    row_start = np.clip(np.arange(rows) - kr // 2, 0, rows - kr).astype(np.int32)
    nj = GRID_W // NA_QCOLS
    blk_start = np.clip(np.arange(nj) * NA_QCOLS - NA_WIN_COLS // 2, 0, GRID_W - NA_KV_COLS)
    key_cols = blk_start[:, None] + np.arange(NA_KV_COLS)[None, :]
    q_cols = np.arange(GRID_W).reshape(nj, NA_QCOLS)
    win_start = np.clip(q_cols - NA_WIN_COLS // 2, 0, GRID_W - NA_WIN_COLS)
    col_mask = ((key_cols[:, None, :] >= win_start[..., None])
                & (key_cols[:, None, :] < win_start[..., None] + NA_WIN_COLS))
    col_idx = np.clip(key_cols[:, None, :] - q_cols[..., None],
                      -(NA_WIN_COLS - 1), NA_WIN_COLS - 1) + NA_WIN_COLS - 1
    rpb_cols = rpb[:, :, col_idx].astype(jnp.float32)
    scale = HEAD_DIM ** -0.5

    def row_step(args):
        q_row, r, rs = args
        kwin = lax.dynamic_slice_in_dim(k5, rs, kr, axis=2)
        vwin = lax.dynamic_slice_in_dim(v5, rs, kr, axis=2)
        kb = kwin[:, :, :, key_cols]
        vb = vwin[:, :, :, key_cols]
        qb = q_row.reshape(b, NA_HEADS, nj, NA_QCOLS, HEAD_DIM)
        sc = jnp.einsum('bhjqd,bhajcd->bhjqac', qb, kb).astype(jnp.float32) * scale
        row_idx = rs + jnp.arange(kr) - r + NA_WIN_ROWS - 1
        bias = jnp.take(rpb_cols, row_idx, axis=1).transpose(0, 2, 3, 1, 4)
        sc = jnp.where(col_mask[None, None, :, :, None, :], sc + bias[None], -jnp.inf)
        prob = jax.nn.softmax(sc, axis=(-2, -1))
        o = jnp.einsum('bhjqac,bhajcd->bhjqd', prob.astype(v.dtype), vb)
        return o.reshape(b, NA_HEADS, GRID_W, HEAD_DIM)

    out = lax.map(row_step, (jnp.moveaxis(q5, 2, 0), jnp.arange(rows, dtype=jnp.int32),
                             jnp.asarray(row_start)))
    out = jnp.moveaxis(out, 0, 2).reshape(b, NA_HEADS, s, HEAD_DIM)
    return from_heads(out)


def sliding_window_attention(z, sinks, cos, sin):
    b, s, _ = z.shape
    nq = SWA_Q_HEADS * HEAD_DIM
    nkv = SWA_KV_HEADS * HEAD_DIM
    q = apply_rope(to_heads(z[..., :nq], SWA_Q_HEADS), cos, sin)
    k = apply_rope(to_heads(z[..., nq:nq + nkv], SWA_KV_HEADS), cos, sin)
    v = to_heads(z[..., nq + nkv:], SWA_KV_HEADS)
    g = SWA_Q_HEADS // SWA_KV_HEADS
    nb = s // Q_BLOCK
    n_side = SWA_WINDOW // Q_BLOCK
    span = (2 * n_side + 1) * Q_BLOCK

    def band(t):
        tp = jnp.pad(t, ((0, 0), (0, 0), (SWA_WINDOW, SWA_WINDOW), (0, 0)))
        tp = tp.reshape(b, SWA_KV_HEADS, nb + 2 * n_side, Q_BLOCK, HEAD_DIM)
        return jnp.concatenate([tp[:, :, o:o + nb] for o in range(2 * n_side + 1)], axis=3)

    kb, vb = band(k), band(v)
    qb = q.reshape(b, SWA_KV_HEADS, g, nb, Q_BLOCK, HEAD_DIM)
    sc = jnp.einsum('bkgnqd,bkncd->bkgnqc', qb, kb).astype(jnp.float32) * HEAD_DIM ** -0.5
    qpos = jnp.arange(nb)[:, None, None] * Q_BLOCK + jnp.arange(Q_BLOCK)[None, :, None]
    kpos = jnp.arange(nb)[:, None, None] * Q_BLOCK - SWA_WINDOW + jnp.arange(span)[None, None, :]
    valid = (kpos >= 0) & (kpos < s) & (jnp.abs(qpos - kpos) <= SWA_WINDOW)
    sc = jnp.where(valid, sc, -jnp.inf)
    sink = jnp.broadcast_to(sinks.astype(jnp.float32).reshape(1, SWA_KV_HEADS, g, 1, 1, 1),
                            sc.shape[:-1] + (1,))
    prob = jax.nn.softmax(jnp.concatenate([sc, sink], axis=-1), axis=-1)[..., :-1]
    o = jnp.einsum('bkgnqc,bkncd->bkgnqd', prob.astype(v.dtype), vb)
    return from_heads(o.reshape(b, SWA_Q_HEADS, s, HEAD_DIM))


def latent_attention(z, q_norm, kv_norm, w_uq, w_ukv, cos, sin):
    b, s, _ = z.shape
    cq = rms_norm(z[..., :MLA_Q_LORA], q_norm)
    ckv = rms_norm(z[..., MLA_Q_LORA:MLA_Q_LORA + MLA_KV_LORA], kv_norm)
    k_rope = apply_rope(z[..., MLA_Q_LORA + MLA_KV_LORA:][:, None], cos, sin)
    q = to_heads(cq @ w_uq, MLA_HEADS)
    q = jnp.concatenate([q[..., :MLA_NOPE], apply_rope(q[..., MLA_NOPE:], cos, sin)], axis=-1)
    kv = to_heads(ckv @ w_ukv, MLA_HEADS)
    k = jnp.concatenate([kv[..., :MLA_NOPE],
                         jnp.broadcast_to(k_rope, (b, MLA_HEADS, s, MLA_ROPE))], axis=-1)
    v = kv[..., MLA_NOPE:]
    return from_heads(dense_attention(q, k, v, (MLA_NOPE + MLA_ROPE) ** -0.5))


def swiglu(x, w_gate, w_up, w_down):
    return (jax.nn.silu(x @ w_gate) * (x @ w_up)) @ w_down


def moe_swiglu(h, w_router, w_gate, w_up, w_down):
    n, d = h.shape
    logits = (h @ w_router).astype(jnp.float32)
    top_val, top_idx = lax.top_k(logits, TOP_K)
    gates = jax.nn.softmax(top_val, axis=-1)
    n_assign = n * TOP_K
    flat_e = top_idx.reshape(-1)
    flat_tok = jnp.repeat(jnp.arange(n, dtype=jnp.int32), TOP_K)
    flat_g = gates.reshape(-1)
    order = jnp.argsort(flat_e)
    e_s, tok_s, g_s = flat_e[order], flat_tok[order], flat_g[order]
    counts = jnp.bincount(flat_e, length=N_EXPERTS)
    padded = (counts + MOE_BLOCK - 1) // MOE_BLOCK * MOE_BLOCK
    grp_start = jnp.cumsum(counts) - counts
    pad_end = jnp.cumsum(padded)
    pad_start = pad_end - padded
    dest = pad_start[e_s] + jnp.arange(n_assign) - grp_start[e_s]
    n_blk = n_assign // MOE_BLOCK + N_EXPERTS
    buf_tok = jnp.full((n_blk * MOE_BLOCK,), n, dtype=jnp.int32).at[dest].set(tok_s)
    blk_exp = jnp.minimum(jnp.searchsorted(pad_end, jnp.arange(n_blk) * MOE_BLOCK, side='right'),
                          N_EXPERTS - 1)
    h_pad = jnp.concatenate([h, jnp.zeros((1, d), h.dtype)], axis=0)

    def expert_block(args):
        tok, e = args
        xb = h_pad[tok]
        return swiglu(xb, w_gate[e], w_up[e], w_down[e])

    y_buf = lax.map(expert_block, (buf_tok.reshape(n_blk, MOE_BLOCK), blk_exp))
    y = y_buf.reshape(-1, d)[dest]
    return jnp.zeros((n, d), h.dtype).at[tok_s].add(g_s[:, None].astype(h.dtype) * y)


def setup_inputs(seed: int = 0) -> dict:
    key = jax.random.key(seed)
    ks = iter(jax.random.split(key, 32))

    def nrm(shape, scale):
        return jax.random.normal(next(ks), shape, jnp.float32) * scale

    def gain(shape):
        return 1.0 + 0.05 * jax.random.normal(next(ks), shape, jnp.float32)

    return {
        'x': nrm((BATCH, SEQ, D_MODEL), 1.0),
        'p': nrm((DEPTH, BATCH, SEQ, PLE_DIM), 1.0),
        'attn_norm': gain((DEPTH, D_MODEL)),
        'w_in': nrm((DEPTH, D_MODEL, IN_COLS), D_MODEL ** -0.5),
        'diff_lq1': nrm((DEPTH, DIFF_QK_DIM), 0.1),
        'diff_lk1': nrm((DEPTH, DIFF_QK_DIM), 0.1),
        'diff_lq2': nrm((DEPTH, DIFF_QK_DIM), 0.1),
        'diff_lk2': nrm((DEPTH, DIFF_QK_DIM), 0.1),
        'diff_subln': gain((DEPTH, DIFF_V_DIM)),
        'na_rpb': nrm((DEPTH, NA_HEADS, 2 * NA_WIN_ROWS - 1, 2 * NA_WIN_COLS - 1), 0.1),
        'swa_sinks': nrm((DEPTH, SWA_Q_HEADS), 0.5),
        'mla_q_norm': gain((DEPTH, MLA_Q_LORA)),
        'mla_kv_norm': gain((DEPTH, MLA_KV_LORA)),
        'mla_w_uq': nrm((DEPTH, MLA_Q_LORA, MLA_HEADS * (MLA_NOPE + MLA_ROPE)), MLA_Q_LORA ** -0.5),
        'mla_w_ukv': nrm((DEPTH, MLA_KV_LORA, MLA_HEADS * (MLA_NOPE + MLA_V)), MLA_KV_LORA ** -0.5),
        'w_out': nrm((DEPTH, MIX_WIDTH, D_MODEL), MIX_WIDTH ** -0.5),
        'ffn_norm': gain((DEPTH, D_MODEL)),
        'dense_w_gate': nrm((N_DENSE, D_MODEL, FFN_DIM), D_MODEL ** -0.5),
        'dense_w_up': nrm((N_DENSE, D_MODEL, FFN_DIM), D_MODEL ** -0.5),
        'dense_w_down': nrm((N_DENSE, FFN_DIM, D_MODEL), FFN_DIM ** -0.5),
        'moe_router': nrm((N_MOE, D_MODEL, N_EXPERTS), D_MODEL ** -0.5),
        'moe_w_gate': nrm((N_MOE, N_EXPERTS, D_MODEL, FFN_DIM), D_MODEL ** -0.5),
        'moe_w_up': nrm((N_MOE, N_EXPERTS, D_MODEL, FFN_DIM), D_MODEL ** -0.5),
        'moe_w_down': nrm((N_MOE, N_EXPERTS, FFN_DIM, D_MODEL), FFN_DIM ** -0.5),
        'ple_norm': gain((DEPTH, D_MODEL)),
        'ple_gate': nrm((DEPTH, D_MODEL, D_MODEL), D_MODEL ** -0.5),
        'ple_proj': nrm((DEPTH, PLE_DIM, D_MODEL), PLE_DIM ** -0.5),
        'final_norm': gain((D_MODEL,)),
    }


def reference(x, p, attn_norm, w_in, diff_lq1, diff_lk1, diff_lq2, diff_lk2, diff_subln,
              na_rpb, swa_sinks, mla_q_norm, mla_kv_norm, mla_w_uq, mla_w_ukv, w_out,
              ffn_norm, dense_w_gate, dense_w_up, dense_w_down, moe_router, moe_w_gate,
              moe_w_up, moe_w_down, ple_norm, ple_gate, ple_proj, final_norm):
    b, s, _ = x.shape
    cos_d, sin_d = rope_tables(s, DIFF_QK_DIM)
    cos_h, sin_h = rope_tables(s, HEAD_DIM)
    cos_r, sin_r = rope_tables(s, MLA_ROPE)
    o0 = DIFF_COLS
    o1 = o0 + NA_COLS
    o2 = o1 + SWA_COLS
    h = x
    for i in range(DEPTH):
        z = rms_norm(h, attn_norm[i]) @ w_in[i]
        lambda_init = 0.8 - 0.6 * math.exp(-0.3 * i)
        mixed = jnp.concatenate([
            diff_attention(z[..., :o0], diff_lq1[i], diff_lk1[i], diff_lq2[i], diff_lk2[i],
                           diff_subln[i], lambda_init, cos_d, sin_d),
            neighbourhood_attention(z[..., o0:o1], na_rpb[i]),
            sliding_window_attention(z[..., o1:o2], swa_sinks[i], cos_h, sin_h),
            latent_attention(z[..., o2:], mla_q_norm[i], mla_kv_norm[i], mla_w_uq[i],
                             mla_w_ukv[i], cos_r, sin_r),
        ], axis=-1)
        h = h + mixed @ w_out[i]
        hn = rms_norm(h, ffn_norm[i])
        j = i // 2
        if i % 2 == 0:
            h = h + swiglu(hn, dense_w_gate[j], dense_w_up[j], dense_w_down[j])
        else:
            h = h + moe_swiglu(hn.reshape(b * s, -1), moe_router[j], moe_w_gate[j],
                               moe_w_up[j], moe_w_down[j]).reshape(b, s, -1)
        gate = jax.nn.sigmoid(rms_norm(h, ple_norm[i]) @ ple_gate[i])
        h = h + gate * (p[i] @ ple_proj[i])
    return rms_norm(h, final_norm)
```

```cpp
#include <hip/hip_runtime.h>
#include <cstdio>
#include <cstdint>
#include <cstring>

#ifndef MK_ONE_LAUNCH
#define MK_ONE_LAUNCH 1
#endif
#ifndef NAIVE_ATTN
#define NAIVE_ATTN 0
#endif

#define LAS __attribute__((address_space(3)))
#define GAS __attribute__((address_space(1)))
typedef unsigned short bf16_t;
typedef short bf16x8 __attribute__((ext_vector_type(8)));
typedef short s16x4 __attribute__((ext_vector_type(4)));
typedef float f32x4 __attribute__((ext_vector_type(4)));
typedef float f32x2 __attribute__((ext_vector_type(2)));
typedef float f32x16 __attribute__((ext_vector_type(16)));
typedef unsigned u32x4 __attribute__((ext_vector_type(4)));
typedef unsigned u32x2 __attribute__((ext_vector_type(2)));

constexpr int NB = 4, SEQ = 4096, DM = 2048, NTOK = NB * SEQ, DEPTH = 2;
constexpr int ZC = 5184, ZP = 5376, FF = 7168, NE = 8, PLE = 256;
constexpr int O_NA = 1536, O_SWA = 3072, O_MLA = 4096;
constexpr int QMW = 768, KVW = 1024;
constexpr float EPS = 1e-6f;
constexpr int MOE_MAXT = 136;
constexpr int NWAVES = 8, NTHR = 512;

enum { I_X = 0, I_P, I_ATTN_NORM, I_W_IN, I_LQ1, I_LK1, I_LQ2, I_LK2, I_SUBLN, I_RPB, I_SINKS, I_QNORM, I_KVNORM, I_WUQ, I_WUKV, I_WOUT,
       I_FFN_NORM, I_DG, I_DU, I_DD, I_ROUTER, I_MG, I_MU, I_MD, I_PLE_NORM, I_PLE_GATE, I_PLE_PROJ, I_FINAL_NORM, N_IN };

constexpr size_t MiB = 1u << 20;
constexpr size_t WS_CTL = 0, CTL_ZERO_BYTES = 2 * MiB;
constexpr size_t WS_SS = 1 * MiB;
constexpr size_t SZ_WIN = (size_t)ZP * DM * 2, SZ_WUQ = (size_t)QMW * 512 * 2, SZ_WUKV = (size_t)KVW * 512 * 2, SZ_WSQ = (size_t)DM * DM * 2, SZ_WPP = (size_t)DM * PLE * 2;
constexpr size_t SZ_GU = (size_t)2 * FF * DM * 2, SZ_DN = (size_t)DM * FF * 2;
constexpr size_t WS_WIN = 2 * MiB;
constexpr size_t WS_WUQ = WS_WIN + 2 * SZ_WIN;
constexpr size_t WS_WUKV = WS_WUQ + 2 * SZ_WUQ;
constexpr size_t WS_WOUT = WS_WUKV + 2 * SZ_WUKV;
constexpr size_t WS_WPG = WS_WOUT + 2 * SZ_WSQ;
constexpr size_t WS_WPP = WS_WPG + 2 * SZ_WSQ;
constexpr size_t WS_DGU = WS_WPP + 2 * SZ_WPP;
constexpr size_t WS_DDN = WS_DGU + SZ_GU;
constexpr size_t WS_MGU = WS_DDN + SZ_DN;
constexpr size_t WS_MDN = WS_MGU + NE * SZ_GU;
constexpr size_t WS_TAB64 = WS_MDN + NE * SZ_DN;
constexpr size_t WS_TAB128 = WS_TAB64 + (size_t)SEQ * 32 * 2 * 4;
constexpr size_t WS_MOEI = WS_TAB128 + (size_t)SEQ * 64 * 2 * 4;
constexpr size_t WS_SSH = WS_MOEI + (size_t)NTOK * 8 * 4;
constexpr size_t WS_TRINV = WS_SSH + (size_t)6 * NTOK * 8 * 4;
constexpr size_t WS_SRINV = WS_TRINV + (size_t)NTOK * 4;
constexpr size_t WS_STOK = WS_SRINV + (size_t)MOE_MAXT * 256 * 4;
constexpr size_t WS_HN = WS_STOK + (size_t)MOE_MAXT * 256 * 4;
constexpr size_t WS_PBF = WS_HN + (size_t)NTOK * DM * 2;
constexpr size_t WS_PP = WS_PBF + (size_t)2 * NTOK * PLE * 2;
constexpr size_t WS_ARENA = WS_PP + (size_t)NTOK * DM * 2;
constexpr size_t WS_Z = WS_ARENA;
constexpr size_t WS_QM = WS_Z + (size_t)NTOK * ZP * 2;
constexpr size_t WS_KVM = WS_QM + (size_t)NTOK * QMW * 2;
constexpr size_t WS_MIX = WS_KVM + (size_t)NTOK * KVW * 2;
constexpr size_t WS_ATT_END = WS_MIX + (size_t)NTOK * DM * 2;
constexpr size_t WS_ACT = WS_ARENA;
constexpr size_t WS_XG = WS_ACT + (size_t)MOE_MAXT * 256 * FF * 2;
constexpr size_t WS_HB2 = WS_XG + (size_t)MOE_MAXT * 256 * DM * 2;
constexpr size_t WS_HQ8 = WS_HB2 + (size_t)NTOK * DM * 2;
constexpr size_t WS_XG8 = WS_HQ8 + (size_t)NTOK * DM;
constexpr size_t WS_END = WS_XG8 + (size_t)MOE_MAXT * 256 * DM;
static_assert(WS_ATT_END <= WS_END, "arena");
static_assert(WS_WIN % 256 == 0 && WS_HN % 256 == 0 && WS_Z % 256 == 0 && WS_XG % 256 == 0 && WS_MOEI % 256 == 0 && WS_SSH % 256 == 0 && WS_TRINV % 256 == 0 && WS_SRINV % 256 == 0 && WS_STOK % 256 == 0, "align");

constexpr int CW_BAR = 1024;
constexpr int CW_MOE_CNT = 8192;
constexpr int CW_MOE_TILES = 8192 + 1024;

__device__ __forceinline__ unsigned cvt_pk_bf16(float lo, float hi) { unsigned r; asm volatile("v_cvt_pk_bf16_f32 %0, %1, %2" : "=v"(r) : "v"(lo), "v"(hi)); return r; }
__device__ __forceinline__ float bf2f(bf16_t v) { return __uint_as_float((unsigned)v << 16); }
__device__ __forceinline__ float bflo(unsigned w) { return __uint_as_float(w << 16); }
__device__ __forceinline__ float bfhi(unsigned w) { return __uint_as_float(w & 0xffff0000u); }
__device__ __forceinline__ bf16_t f2bf(float f) { return (bf16_t)(cvt_pk_bf16(f, 0.f) & 0xffffu); }
template <int M> __device__ __forceinline__ float swz_xor(float v) { return __int_as_float(__builtin_amdgcn_ds_swizzle(__float_as_int(v), (M << 10) | 0x1f)); }
__device__ __forceinline__ float xsum32(float v) { auto r = __builtin_amdgcn_permlane32_swap(__float_as_uint(v), __float_as_uint(v), false, false); return __uint_as_float(r[0]) + __uint_as_float(r[1]); }
__device__ __forceinline__ float xsum16(float v) { return v + swz_xor<16>(v); }
__device__ __forceinline__ float wave_max(float v) {
    v = fmaxf(v, swz_xor<1>(v)); v = fmaxf(v, swz_xor<2>(v)); v = fmaxf(v, swz_xor<4>(v)); v = fmaxf(v, swz_xor<8>(v)); v = fmaxf(v, swz_xor<16>(v));
    auto r = __builtin_amdgcn_permlane32_swap(__float_as_uint(v), __float_as_uint(v), false, false); return fmaxf(__uint_as_float(r[0]), __uint_as_float(r[1]));
}
__device__ __forceinline__ float wave_sum(float v) {
    v += swz_xor<1>(v); v += swz_xor<2>(v); v += swz_xor<4>(v); v += swz_xor<8>(v); v += swz_xor<16>(v);
    return xsum32(v);
}
__device__ __forceinline__ unsigned pk4_fp8(float a, float b, float c, float d) {
    a = __builtin_amdgcn_fmed3f(a, -448.f, 448.f); b = __builtin_amdgcn_fmed3f(b, -448.f, 448.f); c = __builtin_amdgcn_fmed3f(c, -448.f, 448.f); d = __builtin_amdgcn_fmed3f(d, -448.f, 448.f);
    int w = __builtin_amdgcn_cvt_pk_fp8_f32(a, b, 0, false); w = __builtin_amdgcn_cvt_pk_fp8_f32(c, d, w, true); return (unsigned)w; }
__device__ __forceinline__ unsigned pk4_i8(float a, float b, float c, float d) {
    const int ia = (int)rintf(__builtin_amdgcn_fmed3f(a, -127.f, 127.f)), ib = (int)rintf(__builtin_amdgcn_fmed3f(b, -127.f, 127.f));
    const int ic = (int)rintf(__builtin_amdgcn_fmed3f(c, -127.f, 127.f)), id = (int)rintf(__builtin_amdgcn_fmed3f(d, -127.f, 127.f));
    return (unsigned)(ia & 255) | ((unsigned)(ib & 255) << 8) | ((unsigned)(ic & 255) << 16) | ((unsigned)id << 24); }
#define LDS_WAIT() asm volatile("s_waitcnt lgkmcnt(0)" ::: "memory")
#define VM_WAIT() asm volatile("s_waitcnt vmcnt(0)" ::: "memory")

namespace pg8 {
constexpr int BM = 256, BK = 64, HALF = 128, HTB = HALF * BK * 2, STAGE_BYTES = 8 * HTB, NXCD = 8, WGM = 8;
__host__ __device__ __forceinline__ int lds_byte(int r, int c) { const int st = (r >> 4) * 2 + (c >> 5), rr = r & 15, cc = c & 31, ob = rr * 64 + cc * 2; return st * 1024 + (ob ^ (((ob >> 9) & 1) << 5)); }
__host__ __device__ __forceinline__ void stage_rc(int b, int& R, int& C) { const int st = b / 1024, sb = b % 1024, swz = sb ^ (((sb >> 9) & 1) << 5); R = (st >> 1) * 16 + swz / 64; C = (st & 1) * 32 + (swz % 64) / 2; }
__host__ __device__ __forceinline__ int perm32(int rho) { const int n = rho >> 4, i = rho & 15; return 8 * (i >> 2) + 4 * n + (i & 3); }
struct Unit { int pm, pn; };
struct StaticOrder {
    int nM, nN, nwg, G, c;
    __device__ void init(int nM_, int nN_, int G_, int c_) { nM = nM_; nN = nN_; nwg = nM * nN; G = G_; c = c_; }
    __device__ bool next(int i, Unit& u) const {
        const long L = (long)i * G + c; if (L >= nwg) return false;
        int wgid = (int)L; { const int q = nwg / NXCD, r = nwg % NXCD, xcd = wgid % NXCD, off = wgid / NXCD; wgid = (xcd < r ? xcd * (q + 1) : r * (q + 1) + (xcd - r) * q) + off; }
        const int nig = WGM * nN, gid = wgid / nig, fm = gid * WGM, gsz = (nM - fm) < WGM ? (nM - fm) : WGM;
        u.pm = fm + ((wgid % nig) % gsz); u.pn = (wgid % nig) / gsz; return true;
    }
};
struct SchedDense {
    StaticOrder o; const char* A; const char* B; size_t tA, tB;
    __device__ __forceinline__ bool next(int i, Unit& u) const { return o.next(i, u); }
    __device__ __forceinline__ const char* aptr(const Unit& u) const { return A + (size_t)u.pm * tA; }
    __device__ __forceinline__ const char* bptr(const Unit& u) const { return B + (size_t)u.pn * tB; }
    static constexpr bool GATHER = false;
    __device__ __forceinline__ unsigned rowtok(const Unit&, int) const { return 0u; }
};
struct SchedMoe {
    StaticOrder o; const char* A; const char* B; size_t tA, tB, tE; const unsigned* tile_expert;
    __device__ __forceinline__ bool next(int i, Unit& u) const { return o.next(i, u); }
    __device__ __forceinline__ const char* aptr(const Unit& u) const { return A + (size_t)u.pm * tA; }
    __device__ __forceinline__ const char* bptr(const Unit& u) const { return B + (size_t)__builtin_amdgcn_readfirstlane((int)tile_expert[u.pm]) * tE + (size_t)u.pn * tB; }
    static constexpr bool GATHER = false;
    __device__ __forceinline__ unsigned rowtok(const Unit&, int) const { return 0u; }
};
struct SchedMoeG {
    StaticOrder o; const char* A; const char* B; size_t tB, tE; const unsigned* tile_expert; const unsigned* slot_tok;
    __device__ __forceinline__ bool next(int i, Unit& u) const { return o.next(i, u); }
    __device__ __forceinline__ const char* aptr(const Unit&) const { return A; }
    __device__ __forceinline__ const char* bptr(const Unit& u) const { return B + (size_t)__builtin_amdgcn_readfirstlane((int)tile_expert[u.pm]) * tE + (size_t)u.pn * tB; }
    static constexpr bool GATHER = true;
    __device__ __forceinline__ unsigned rowtok(const Unit& u, int r) const { return slot_tok[u.pm * 256 + r]; }
};

enum { EPI_BF16 = 0, EPI_RESID = 1, EPI_SWIGLU = 2, EPI_PLE = 3, EPI_Z = 4, EPI_SCALE = 5, EPI_SWIGLU8 = 6, EPI_BF16S = 7, EPI_PLE8 = 8, EPI_SWIGLU_I = 9, EPI_SWIGLU8_I = 10, EPI_Z_I = 11, EPI_RESID_Q = 12, EPI_PLE_I = 13 };
#define ZCV(a) ((MODE == EPI_Z_I) ? (float)__float_as_int(a) : (a))
#define ZCV4(a) ((MODE == EPI_Z_I) ? (f32x4){(float)__float_as_int((a)[0]), (float)__float_as_int((a)[1]), (float)__float_as_int((a)[2]), (float)__float_as_int((a)[3])} : (a))
template <int MODE> struct Epi {
    void* O; const void* X; int ldc; const void* X2; float* SS;
    const float* RS; int rsmode;
    bf16_t* HB; float* SSO;
    LAS float* red;
    const float* RQ = nullptr;
    __device__ __forceinline__ float rowscale(const size_t row) const {
        if (rsmode == 1) { const f32x4 a = *(const f32x4*)(RS + row * 8), b = *(const f32x4*)(RS + row * 8 + 4);
            return 1.0f / sqrtf((((a[0] + a[1]) + (a[2] + a[3])) + ((b[0] + b[1]) + (b[2] + b[3]))) * (1.0f / DM) + EPS); }
        if (rsmode == 2) return RS[row];
        if (rsmode == 3) { const f32x4 a = *(const f32x4*)(RS + row * 8), b = *(const f32x4*)(RS + row * 8 + 4), c = *(const f32x4*)(RQ + row * 8), d = *(const f32x4*)(RQ + row * 8 + 4);
            return sqrtf(((((c[0] + c[1]) + (c[2] + c[3])) + ((d[0] + d[1]) + (d[2] + d[3]))) * (1.0f / DM) + EPS) / ((((a[0] + a[1]) + (a[2] + a[3])) + ((b[0] + b[1]) + (b[2] + b[3]))) * (1.0f / DM) + EPS)) * (5.0f / (127.0f * 1536.0f)); }
        return 1.0f;
    }
    __device__ __forceinline__ void operator()(const f32x4 (&acc)[2][2][4][2], const Unit& u, int wr, int wc, int fr, int fq) const {
        const int row0 = u.pm * BM + wr * 64 + fr;
        constexpr bool IS_RES = (MODE == EPI_RESID || MODE == EPI_RESID_Q), IS_PLE = (MODE == EPI_PLE || MODE == EPI_PLE8 || MODE == EPI_PLE_I);
        if constexpr (IS_RES || IS_PLE) {
            constexpr int MG = (MODE == EPI_PLE_I) ? 2 : 4;
#pragma unroll
            for (int ai = 0; ai < 2; ++ai)
#pragma unroll
            for (int mg = 0; mg < 4; mg += MG) {
                u32x4 hin[MG][2], pin[MG][2]; float rsg[MG], rq8[MG]; (void)rq8;
#pragma unroll
                for (int mm = 0; mm < MG; ++mm) { rsg[mm] = (MODE == EPI_PLE8) ? (1.0f / 262144.0f) : 1.0f; if constexpr (MODE == EPI_PLE) rsg[mm] = rowscale((size_t)(row0 + ai * HALF + (mg + mm) * 16));
                    if constexpr (MODE == EPI_RESID_Q) rsg[mm] = rowscale((size_t)(row0 + ai * HALF + (mg + mm) * 16)) * (127.0f / 5.0f);
                    if constexpr (MODE == EPI_PLE_I) { const size_t row_ = (size_t)(row0 + ai * HALF + (mg + mm) * 16); const f32x4 a_ = *(const f32x4*)(RQ + row_ * 8), b_ = *(const f32x4*)(RQ + row_ * 8 + 4);
                        const float rinv_ = rowscale(row_); rq8[mm] = rinv_ * (127.0f / 5.0f);
                        rsg[mm] = rinv_ * sqrtf((((a_[0] + a_[1]) + (a_[2] + a_[3])) + ((b_[0] + b_[1]) + (b_[2] + b_[3]))) * (1.0f / DM) + EPS) * (5.0f / (127.0f * 1536.0f)); } }
#pragma unroll
                for (int mm = 0; mm < MG; ++mm) { const int m = mg + mm; const size_t off = (size_t)(row0 + ai * HALF + m * 16) * ldc + u.pn * BM + wc * 32 + 8 * fq;
#pragma unroll
                    for (int bj = 0; bj < 2; ++bj) {
                        if constexpr (IS_RES) { hin[mm][bj] = *(const u32x4*)((const bf16_t*)X + off + bj * HALF); }
                        else { hin[mm][bj] = *(const u32x4*)((const bf16_t*)X2 + off + bj * HALF); pin[mm][bj] = *(const u32x4*)((const bf16_t*)X + off + bj * HALF); }
                    } }
#pragma unroll
                for (int mm = 0; mm < MG; ++mm) { const int m = mg + mm; const size_t off = (size_t)(row0 + ai * HALF + m * 16) * ldc + u.pn * BM + wc * 32 + 8 * fq;
                    const float rs = rsg[mm];
                    float sq = 0.f;
#pragma unroll
                    for (int bj = 0; bj < 2; ++bj) {
                        const u32x4 hw = hin[mm][bj];
                        f32x4 h0 = {bflo(hw.x), bfhi(hw.x), bflo(hw.y), bfhi(hw.y)}, h1 = {bflo(hw.z), bfhi(hw.z), bflo(hw.w), bfhi(hw.w)};
                        if constexpr (IS_RES) { h0 = h0 + acc[ai][bj][m][0]; h1 = h1 + acc[ai][bj][m][1]; }
                        else { const u32x4 pw = pin[mm][bj];
                            const float pv[8] = {bflo(pw.x), bfhi(pw.x), bflo(pw.y), bfhi(pw.y), bflo(pw.z), bfhi(pw.z), bflo(pw.w), bfhi(pw.w)};
#pragma unroll
                            for (int j = 0; j < 4; ++j) { const float a0 = ((MODE == EPI_PLE_I) ? (float)__float_as_int(acc[ai][bj][m][0][j]) : acc[ai][bj][m][0][j]) * rs, a1 = ((MODE == EPI_PLE_I) ? (float)__float_as_int(acc[ai][bj][m][1][j]) : acc[ai][bj][m][1][j]) * rs;
                                h0[j] += __builtin_amdgcn_rcpf(1.0f + __builtin_amdgcn_exp2f(-1.4426950408889634f * a0)) * pv[j];
                                h1[j] += __builtin_amdgcn_rcpf(1.0f + __builtin_amdgcn_exp2f(-1.4426950408889634f * a1)) * pv[4 + j]; } }
                        { u32x4 w; w.x = cvt_pk_bf16(h0[0], h0[1]); w.y = cvt_pk_bf16(h0[2], h0[3]); w.z = cvt_pk_bf16(h1[0], h1[1]); w.w = cvt_pk_bf16(h1[2], h1[3]);
                            *(u32x4*)(HB + off + bj * HALF) = w; }
                        if constexpr (MODE == EPI_RESID_Q) { u32x2 q8; q8.x = pk4_i8(h0[0] * rs, h0[1] * rs, h0[2] * rs, h0[3] * rs); q8.y = pk4_i8(h1[0] * rs, h1[1] * rs, h1[2] * rs, h1[3] * rs);
                            *(u32x2*)((unsigned char*)O + off + bj * HALF) = q8; }
                        if constexpr (MODE == EPI_PLE_I) { if (O) { const float qs_ = rq8[mm]; u32x2 q8; q8.x = pk4_i8(h0[0] * qs_, h0[1] * qs_, h0[2] * qs_, h0[3] * qs_); q8.y = pk4_i8(h1[0] * qs_, h1[1] * qs_, h1[2] * qs_, h1[3] * qs_);
                            *(u32x2*)((unsigned char*)O + off + bj * HALF) = q8; } }
                        sq += ((h0[0] * h0[0] + h0[1] * h0[1]) + (h0[2] * h0[2] + h0[3] * h0[3])) + ((h1[0] * h1[0] + h1[1] * h1[1]) + (h1[2] * h1[2] + h1[3] * h1[3]));
                    }
                    if (SSO) { sq = xsum32(xsum16(sq)); if (fq == 0) red[wc * 256 + ai * HALF + wr * 64 + m * 16 + fr] = sq; }
                }
            }
        } else
#pragma unroll
        for (int ai = 0; ai < 2; ++ai) {
            float rsv[4];
            if constexpr (MODE == EPI_Z || MODE == EPI_Z_I || MODE == EPI_SWIGLU || MODE == EPI_SWIGLU_I || MODE == EPI_SWIGLU8_I) {
#pragma unroll
                for (int m = 0; m < 4; ++m) rsv[m] = rowscale((size_t)(row0 + ai * HALF + m * 16));
            }
            if constexpr (MODE == EPI_SCALE) {
#pragma unroll
                for (int m = 0; m < 4; ++m) { const size_t row = (size_t)(row0 + ai * HALF + m * 16);
                    const f32x4 pa_ = *(const f32x4*)(SS + row * 16), pb_ = *(const f32x4*)(SS + row * 16 + 4);
                    rsv[m] = 1.0f / sqrtf((((pa_[0] + pa_[1]) + (pa_[2] + pa_[3])) + ((pb_[0] + pb_[1]) + (pb_[2] + pb_[3]))) * (1.0f / 512) + EPS); }
            }
#pragma unroll
            for (int m = 0; m < 4; ++m) {
                const size_t row = (size_t)(row0 + ai * HALF + m * 16);
                if constexpr (MODE == EPI_BF16 || MODE == EPI_BF16S) {
                    bf16_t* rowp = (bf16_t*)O + row * ldc + u.pn * BM + wc * 32 + 8 * fq;
                    constexpr float sc_ = (MODE == EPI_BF16S) ? (1.0f / 262144.0f) : 1.0f;
#pragma unroll
                    for (int bj = 0; bj < 2; ++bj) { const f32x4 v0 = acc[ai][bj][m][0] * sc_, v1 = acc[ai][bj][m][1] * sc_;
                        u32x4 w; w.x = cvt_pk_bf16(v0[0], v0[1]); w.y = cvt_pk_bf16(v0[2], v0[3]); w.z = cvt_pk_bf16(v1[0], v1[1]); w.w = cvt_pk_bf16(v1[2], v1[3]);
                        *(u32x4*)(rowp + bj * HALF) = w; }
                } else if constexpr (MODE == EPI_SCALE) {
                    const float ri = rsv[m];
                    bf16_t* rowp = (bf16_t*)O + row * ldc + u.pn * BM + wc * 32 + 8 * fq;
#pragma unroll
                    for (int bj = 0; bj < 2; ++bj) { const f32x4 v0 = acc[ai][bj][m][0] * ri, v1 = acc[ai][bj][m][1] * ri;
                        u32x4 w; w.x = cvt_pk_bf16(v0[0], v0[1]); w.y = cvt_pk_bf16(v0[2], v0[3]); w.z = cvt_pk_bf16(v1[0], v1[1]); w.w = cvt_pk_bf16(v1[2], v1[3]);
                        *(u32x4*)(rowp + bj * HALF) = w; }
                } else if constexpr (MODE == EPI_Z || MODE == EPI_Z_I) {
                    const float rs = rsv[m];
                    const int pn = u.pn; const bool r64 = (pn == 2) | (pn == 3) | (pn == 20), r128 = (pn == 14);
                    if (r64 | r128) {
                        const int pos = (int)row & (SEQ - 1); const int j0 = r64 ? 8 * fq : (wc & 1) * 32 + 8 * fq;
                        const float* tb = r64 ? (const float*)X + ((size_t)pos * 32 + j0) * 2 : (const float*)X2 + ((size_t)pos * 64 + j0) * 2;
                        const f32x4 t0 = *(const f32x4*)tb, t1 = *(const f32x4*)(tb + 4), t2 = *(const f32x4*)(tb + 8), t3 = *(const f32x4*)(tb + 12);
                        const float cs[16] = {t0[0], t0[1], t0[2], t0[3], t1[0], t1[1], t1[2], t1[3], t2[0], t2[1], t2[2], t2[3], t3[0], t3[1], t3[2], t3[3]};
                        float y1[8], y2[8];
#pragma unroll
                        for (int n = 0; n < 2; ++n)
#pragma unroll
                            for (int j = 0; j < 4; ++j) { const float x1 = ZCV(acc[ai][0][m][n][j]) * rs, x2 = ZCV(acc[ai][1][m][n][j]) * rs, c = cs[(n * 4 + j) * 2], sn = cs[(n * 4 + j) * 2 + 1];
                                y1[n * 4 + j] = x1 * c - x2 * sn; y2[n * 4 + j] = x2 * c + x1 * sn; }
                        const int c1 = pn * BM + (r64 ? wc * 64 + j0 : (wc >> 1) * 128 + j0), c2 = c1 + (r64 ? 32 : 64);
                        u32x4 w; w.x = cvt_pk_bf16(y1[0], y1[1]); w.y = cvt_pk_bf16(y1[2], y1[3]); w.z = cvt_pk_bf16(y1[4], y1[5]); w.w = cvt_pk_bf16(y1[6], y1[7]);
                        *(u32x4*)((bf16_t*)O + row * ldc + c1) = w;
                        w.x = cvt_pk_bf16(y2[0], y2[1]); w.y = cvt_pk_bf16(y2[2], y2[3]); w.z = cvt_pk_bf16(y2[4], y2[5]); w.w = cvt_pk_bf16(y2[6], y2[7]);
                        *(u32x4*)((bf16_t*)O + row * ldc + c2) = w;
                    } else {
                        bf16_t* rowp = (bf16_t*)O + row * ldc + pn * BM + wc * 32 + 8 * fq;
                        float sq = 0.f;
#pragma unroll
                        for (int bj = 0; bj < 2; ++bj) { const f32x4 v0 = ZCV4(acc[ai][bj][m][0]) * rs, v1 = ZCV4(acc[ai][bj][m][1]) * rs;
                            sq += ((v0[0] * v0[0] + v0[1] * v0[1]) + (v0[2] * v0[2] + v0[3] * v0[3])) + ((v1[0] * v1[0] + v1[1] * v1[1]) + (v1[2] * v1[2] + v1[3] * v1[3]));
                            u32x4 w; w.x = cvt_pk_bf16(v0[0], v0[1]); w.y = cvt_pk_bf16(v0[2], v0[3]); w.z = cvt_pk_bf16(v1[0], v1[1]); w.w = cvt_pk_bf16(v1[2], v1[3]);
                            *(u32x4*)(rowp + bj * HALF) = w; }
                        if (pn >= 16 && pn < 20) {
                            sq = xsum32(xsum16(sq));
                            if (fq == 0) SS[row * 16 + (pn - 16) * 4 + wc] = sq;
                        }
                    }
                } else if constexpr (MODE == EPI_SWIGLU || MODE == EPI_SWIGLU8 || MODE == EPI_SWIGLU_I || MODE == EPI_SWIGLU8_I) {
                    const float rs = (MODE == EPI_SWIGLU8) ? (1.0f / 262144.0f) : rsv[m];
                    bf16_t* rowp = (bf16_t*)O + row * ldc + u.pn * HALF + wc * 32 + 8 * fq;
                    float r[8];
#pragma unroll
                    for (int n = 0; n < 2; ++n)
#pragma unroll
                        for (int j = 0; j < 4; ++j) { constexpr bool IA = (MODE == EPI_SWIGLU_I || MODE == EPI_SWIGLU8_I);
                            const float g = (IA ? (float)__float_as_int(acc[ai][0][m][n][j]) : acc[ai][0][m][n][j]) * rs, up = (IA ? (float)__float_as_int(acc[ai][1][m][n][j]) : acc[ai][1][m][n][j]) * rs;
                            r[n * 4 + j] = g * __builtin_amdgcn_rcpf(1.0f + __builtin_amdgcn_exp2f(-1.4426950408889634f * g)) * up; }
                    if constexpr (MODE == EPI_SWIGLU8 || MODE == EPI_SWIGLU8_I) { u32x2 w8; w8.x = pk4_fp8(r[0] * 32.f, r[1] * 32.f, r[2] * 32.f, r[3] * 32.f); w8.y = pk4_fp8(r[4] * 32.f, r[5] * 32.f, r[6] * 32.f, r[7] * 32.f);
                        *(u32x2*)((unsigned char*)O + row * ldc + u.pn * HALF + wc * 32 + 8 * fq) = w8; }
                    else {
                    u32x4 w; w.x = cvt_pk_bf16(r[0], r[1]); w.y = cvt_pk_bf16(r[2], r[3]); w.z = cvt_pk_bf16(r[4], r[5]); w.w = cvt_pk_bf16(r[6], r[7]);
                    *(u32x4*)rowp = w; }
                }
            }
        }
        if constexpr (IS_RES || IS_PLE) {
            if (SSO) {
                asm volatile("s_waitcnt lgkmcnt(0)" ::: "memory"); __builtin_amdgcn_s_barrier(); asm volatile("" ::: "memory");
                unsigned on2_ = ~0u; asm volatile("" : "+s"(on2_)); const int t = (wr * 4 + wc) * 64 + __builtin_amdgcn_mbcnt_hi(on2_, __builtin_amdgcn_mbcnt_lo(on2_, 0u));
                if (t < 256) SSO[((size_t)u.pm * BM + t) * 8 + u.pn] = (red[t] + red[256 + t]) + (red[512 + t] + red[768 + t]);
            }
        }
    }
};

typedef int v4i_t __attribute__((ext_vector_type(4)));
typedef int v8i_t __attribute__((ext_vector_type(8)));
__device__ __forceinline__ v8i_t cat8(bf16x8 a, bf16x8 b) { const v4i_t x = __builtin_bit_cast(v4i_t, a), y = __builtin_bit_cast(v4i_t, b); return __builtin_shufflevector(x, y, 0, 1, 2, 3, 4, 5, 6, 7); }
__device__ __forceinline__ void mfma8_inplace(f32x4& c, const v8i_t a, const v8i_t b, const int sc) {
    asm volatile("s_nop 1\n\tv_mfma_scale_f32_16x16x128_f8f6f4 %0, %1, %2, %0, %3, %3 op_sel_hi:[0,0,0]" : "+v"(c) : "v"(a), "v"(b), "v"(sc));
}
template <class EpiT, class Sched, int QM = 0>
__device__ __forceinline__ void gemm_phase(LAS unsigned char* lds, const int tid, const int lda, const int ldb, const int K, const Sched& S, const EpiT& E) {
    constexpr bool FP8 = (QM == 1), INT8 = (QM == 2);
    const int wid = __builtin_amdgcn_readfirstlane(tid >> 6), lane = tid & 63, wr = wid >> 2, wc = wid & 3, fr = lane & 15, fq = lane >> 4;
    const int nt = K / BK;
    unsigned voffA[2], voffB[2];
#pragma unroll
    for (int i = 0; i < 2; ++i) { int R, C; stage_rc(tid * 16 + i * 8192, R, C); const int Rb = (R & ~31) + perm32(R & 31);
        voffA[i] = (unsigned)(R * lda + C) * 2u; voffB[i] = (unsigned)(Rb * ldb + C) * 2u; }
    const size_t kstep = (size_t)(BK * 2);
    const size_t hstepA = Sched::GATHER ? (size_t)0 : (size_t)HALF * lda * 2, hstepB = (size_t)HALF * ldb * 2;
    unsigned vc0[2], vc1[2], vn0[2], vn1[2];
#define PG8_ROWOFFS(u_, d0, d1) do { if constexpr (Sched::GATHER) { _Pragma("unroll") for (int i = 0; i < 2; ++i) { int R, C; stage_rc(tid * 16 + i * 8192, R, C); \
        d0[i] = S.rowtok(u_, R) * (unsigned)(lda * 2) + (unsigned)C * 2u; d1[i] = S.rowtok(u_, HALF + R) * (unsigned)(lda * 2) + (unsigned)C * 2u; } } \
        } while (0)
#define PG8_V(arr) (Sched::GATHER ? (const unsigned*)(arr) : (const unsigned*)voffA)
    const unsigned ldsw = (unsigned)wid * 1024u;
    const int aoff = lds_byte(wr * 64 + fr, fq * 8), boff = lds_byte(wc * 32 + fr, fq * 8);
#define PG8_SA(b, h) (((b) * 2 + (h)) * HTB)
#define PG8_SB(b, h) ((4 + (b) * 2 + (h)) * HTB)
#define PG8_STAGE(bufoff, gbase, voff) do { _Pragma("unroll") for (int _i = 0; _i < 2; ++_i) \
        __builtin_amdgcn_global_load_lds((const unsigned*)((const char*)(gbase) + (voff)[_i]), (LAS unsigned*)(lds + (bufoff) + ldsw + _i * 8192), 16, 0, 0); } while (0)
#define PG8_LDA(dst, b, h) do { if constexpr (FP8) { _Pragma("unroll") for (int m = 0; m < 4; ++m) dst##8[m] = cat8(*(const LAS bf16x8*)(lds + PG8_SA(b, h) + aoff + m * 2048), *(const LAS bf16x8*)(lds + PG8_SA(b, h) + aoff + m * 2048 + 1024)); } \
        else { _Pragma("unroll") for (int m = 0; m < 4; ++m) _Pragma("unroll") for (int k = 0; k < 2; ++k) dst[m][k] = *(const LAS bf16x8*)(lds + PG8_SA(b, h) + aoff + m * 2048 + k * 1024); } } while (0)
#define PG8_LDB(dst, b, h) do { if constexpr (FP8) { _Pragma("unroll") for (int n = 0; n < 2; ++n) dst##8[n] = cat8(*(const LAS bf16x8*)(lds + PG8_SB(b, h) + boff + n * 2048), *(const LAS bf16x8*)(lds + PG8_SB(b, h) + boff + n * 2048 + 1024)); } \
        else { _Pragma("unroll") for (int n = 0; n < 2; ++n) _Pragma("unroll") for (int k = 0; k < 2; ++k) dst[n][k] = *(const LAS bf16x8*)(lds + PG8_SB(b, h) + boff + n * 2048 + k * 1024); } } while (0)
#define PG8_MMA(ai, bj, At, Bt) do { __builtin_amdgcn_s_setprio(1); if constexpr (FP8) { _Pragma("unroll") for (int m = 0; m < 4; ++m) _Pragma("unroll") for (int n = 0; n < 2; ++n) \
        mfma8_inplace(acc[ai][bj][m][n], Bt##8[n], At##8[m], sc8); } else if constexpr (INT8) { \
        _Pragma("unroll") for (int m = 0; m < 4; ++m) _Pragma("unroll") for (int n = 0; n < 2; ++n) _Pragma("unroll") for (int k = 0; k < 2; ++k) \
        acc[ai][bj][m][n] = __builtin_bit_cast(f32x4, __builtin_amdgcn_mfma_i32_16x16x64_i8(__builtin_bit_cast(v4i_t, Bt[n][k]), __builtin_bit_cast(v4i_t, At[m][k]), __builtin_bit_cast(v4i_t, acc[ai][bj][m][n]), 0, 0, 0)); } else { \
        _Pragma("unroll") for (int m = 0; m < 4; ++m) _Pragma("unroll") for (int n = 0; n < 2; ++n) _Pragma("unroll") for (int k = 0; k < 2; ++k) \
        acc[ai][bj][m][n] = __builtin_amdgcn_mfma_f32_16x16x32_bf16(Bt[n][k], At[m][k], acc[ai][bj][m][n], 0, 0, 0); } __builtin_amdgcn_s_setprio(0); } while (0)
#define PG8_WAIT_V(n) asm volatile("s_waitcnt vmcnt(" #n ")" ::: "memory")
#define PG8_WAIT_L(n) asm volatile("s_waitcnt lgkmcnt(" #n ")" ::: "memory")
#define PG8_BAR __builtin_amdgcn_s_barrier()
#define PG8_SCHED __builtin_amdgcn_sched_barrier(0)
    Unit cur, nxt; int ui = 0;
    if (!S.next(0, cur)) return;
    f32x4 acc[2][2][4][2];
#pragma unroll
    for (int a = 0; a < 2; ++a)
#pragma unroll
        for (int b = 0; b < 2; ++b)
#pragma unroll
            for (int m = 0; m < 4; ++m)
#pragma unroll
                for (int n = 0; n < 2; ++n) acc[a][b][m][n] = (f32x4){0.f, 0.f, 0.f, 0.f};
    bf16x8 At[4][2], B0[2][2], B1[2][2]; v8i_t At8[4], B08[2], B18[2];
    int sc8 = 0x7f7f7f7f; (void)sc8;
    const char* cA = S.aptr(cur); const char* cB = S.bptr(cur);
    PG8_ROWOFFS(cur, vc0, vc1);
    PG8_STAGE(PG8_SB(0, 0), cB, voffB); PG8_STAGE(PG8_SB(0, 1), cB + hstepB, voffB); PG8_STAGE(PG8_SA(0, 0), cA, PG8_V(vc0)); PG8_STAGE(PG8_SA(0, 1), cA + hstepA, PG8_V(vc1));
    if (wr == 1) PG8_BAR;
    PG8_WAIT_V(2); PG8_BAR;
    PG8_STAGE(PG8_SB(1, 0), cB + kstep, voffB); PG8_STAGE(PG8_SA(1, 0), cA + kstep, PG8_V(vc0)); PG8_STAGE(PG8_SB(1, 1), cB + hstepB + kstep, voffB);
    PG8_WAIT_V(6); PG8_BAR;
    for (;;) {
        const bool has_next = S.next(ui + 1, nxt);
        const char* nA = has_next ? S.aptr(nxt) : cA; const char* nB = has_next ? S.bptr(nxt) : cB;
        if constexpr (Sched::GATHER) { if (has_next) { PG8_ROWOFFS(nxt, vn0, vn1); } else { vn0[0] = vc0[0]; vn0[1] = vc0[1]; vn1[0] = vc1[0]; vn1[1] = vc1[1]; } }
        for (int t = 0; t < nt; t += 2) {
            const bool last = (t == nt - 2);
            const char* a1 = cA + (size_t)(t + 1) * kstep;
            const char* a2 = last ? nA : cA + (size_t)(t + 2) * kstep; const char* b2 = last ? nB : cB + (size_t)(t + 2) * kstep;
            const char* a3 = a2 + kstep; const char* b3 = b2 + kstep;
            unsigned w0[2], w1[2]; if constexpr (Sched::GATHER) { w0[0] = last ? vn0[0] : vc0[0]; w0[1] = last ? vn0[1] : vc0[1]; w1[0] = last ? vn1[0] : vc1[0]; w1[1] = last ? vn1[1] : vc1[1]; }
            PG8_LDB(B0, 0, 0); PG8_LDB(B1, 0, 1); PG8_SCHED; PG8_LDA(At, 0, 0); PG8_STAGE(PG8_SA(1, 1), a1 + hstepA, PG8_V(vc1));
            PG8_WAIT_V(8); PG8_WAIT_L(0); PG8_BAR; PG8_MMA(0, 0, At, B0); PG8_MMA(0, 1, At, B1); PG8_BAR; PG8_SCHED;
            PG8_LDA(At, 0, 1); PG8_STAGE(PG8_SB(0, 0), b2, voffB); PG8_STAGE(PG8_SB(0, 1), b2 + hstepB, voffB); PG8_STAGE(PG8_SA(0, 0), a2, PG8_V(w0));
            PG8_WAIT_V(8); PG8_WAIT_L(0); PG8_BAR; PG8_MMA(1, 0, At, B0); PG8_MMA(1, 1, At, B1); PG8_BAR; PG8_SCHED;
            PG8_LDB(B0, 1, 0); PG8_LDB(B1, 1, 1); PG8_SCHED; PG8_LDA(At, 1, 0); PG8_STAGE(PG8_SA(0, 1), a2 + hstepA, PG8_V(w1));
            PG8_WAIT_V(8); PG8_WAIT_L(0); PG8_BAR; PG8_MMA(0, 0, At, B0); PG8_MMA(0, 1, At, B1); PG8_BAR; PG8_SCHED;
            PG8_LDA(At, 1, 1); PG8_STAGE(PG8_SB(1, 0), b3, voffB); PG8_STAGE(PG8_SB(1, 1), b3 + hstepB, voffB); PG8_STAGE(PG8_SA(1, 0), a3, PG8_V(w0));
            PG8_WAIT_V(8); PG8_WAIT_L(0); PG8_BAR; PG8_MMA(1, 0, At, B0); PG8_MMA(1, 1, At, B1); PG8_BAR; PG8_SCHED;
        }
        if constexpr (FP8) asm volatile("s_nop 15\n\ts_nop 15\n\ts_nop 15\n\ts_nop 15" ::: "memory");
        if (wr == 0) PG8_BAR;
        { unsigned on_ = ~0u; asm volatile("" : "+s"(on_)); const int l2_ = __builtin_amdgcn_mbcnt_hi(on_, __builtin_amdgcn_mbcnt_lo(on_, 0u)); E(acc, cur, wr, wc, l2_ & 15, l2_ >> 4); }
        if (!has_next) break;
#pragma unroll
        for (int a = 0; a < 2; ++a)
#pragma unroll
            for (int b = 0; b < 2; ++b)
#pragma unroll
                for (int m = 0; m < 4; ++m)
#pragma unroll
                    for (int n = 0; n < 2; ++n) acc[a][b][m][n] = (f32x4){0.f, 0.f, 0.f, 0.f};
        cur = nxt; cA = nA; cB = nB; ++ui; if constexpr (Sched::GATHER) { vc0[0] = vn0[0]; vc0[1] = vn0[1]; vc1[0] = vn1[0]; vc1[1] = vn1[1]; }
        if (wr == 1) PG8_BAR;
    }
    PG8_WAIT_V(0);
    PG8_BAR;
#undef PG8_SA
#undef PG8_SB
#undef PG8_STAGE
#undef PG8_LDA
#undef PG8_LDB
#undef PG8_MMA
#undef PG8_WAIT_V
#undef PG8_WAIT_L
#undef PG8_BAR
#undef PG8_SCHED
#undef PG8_ROWOFFS
#undef PG8_V
}
}

#define XB_TMO      128
#define XB_XCNT(j)  (256  + 64 * (j))
#define XB_XSUB(j)  (1280 + 64 * (j))
#define XB_XGEN(j)  (2304 + 64 * (j))
#define XB_TOP      3328
#define XB_TOPGEN   3392
#define XCD_BAR_WORDS 3456
#define XB_SPIN_CAP (1u << 18)
__device__ __forceinline__ unsigned xb_ld(unsigned* p)              { return __hip_atomic_load(p, __ATOMIC_RELAXED, __HIP_MEMORY_SCOPE_AGENT); }
__device__ __forceinline__ unsigned xb_add(unsigned* p, unsigned v) { return __hip_atomic_fetch_add(p, v, __ATOMIC_RELAXED, __HIP_MEMORY_SCOPE_AGENT); }
__device__ __forceinline__ unsigned xb_xcc_id() { return (unsigned)__builtin_amdgcn_s_getreg((3 << 11) | 20) & 0xFu; }
#define XB_SPIN(cond, bar) do { unsigned _sp = 0; while (cond) { __builtin_amdgcn_s_sleep(1); \
    if ((++_sp & 255u) == 0u) { if (xb_ld(&(bar)[XB_TMO])) break; if (_sp > XB_SPIN_CAP) { atomicAdd(&(bar)[XB_TMO], 1u); break; } } } } while (0)
struct XcdBarrier { unsigned* bar; unsigned x; volatile LAS unsigned* st; };
__device__ __forceinline__ XcdBarrier xcd_barrier_post(unsigned* bar, volatile LAS unsigned* st, const bool t0) {
    XcdBarrier b; b.bar = bar; b.x = xb_xcc_id(); b.st = st;
    if (t0) (void)xb_add(&bar[XB_XCNT(b.x)], 1u);
    return b;
}
__device__ __forceinline__ void xcd_barrier_complete(unsigned* bar, unsigned x, unsigned& nloc, unsigned& nx) {
    const unsigned G = gridDim.x * gridDim.y * gridDim.z;
    unsigned sum, cnt, mine, sp = 0u;
    for (;;) {
        sum = 0u; cnt = 0u; mine = 0u;
#pragma unroll
        for (unsigned j = 0; j < 16; ++j) { const unsigned c = xb_ld(&bar[XB_XCNT(j)]); sum += c; cnt += (c > 0u) ? 1u : 0u; mine = (j == x) ? c : mine; }
        if (sum == G) break;
        __builtin_amdgcn_s_sleep(1);
        if ((++sp & 255u) == 0u) { if (xb_ld(&bar[XB_TMO])) break; if (sp > XB_SPIN_CAP) { atomicAdd(&bar[XB_TMO], 1u); break; } }
    }
    nloc = mine > 0u ? mine : 1u; nx = cnt > 0u ? cnt : 1u;
}
__device__ __forceinline__ void xcd_barrier(const XcdBarrier& b, const bool t0) {
    asm volatile("s_waitcnt vmcnt(0)" ::: "memory");
    __syncthreads();
    if (t0) {
        unsigned* bar = b.bar;
        __builtin_amdgcn_s_waitcnt(0);
        unsigned nloc = b.st[0], nx = b.st[1];
        if (nloc == 0u) { xcd_barrier_complete(bar, b.x, nloc, nx); b.st[0] = nloc; b.st[1] = nx; }
        const unsigned old = xb_add(&bar[XB_XSUB(b.x)], 1u);
        const unsigned gen = old / nloc;
        if (old + 1u == (gen + 1u) * nloc) {
            __builtin_amdgcn_fence(__ATOMIC_RELEASE, "agent");
            asm volatile("s_waitcnt vmcnt(0)" ::: "memory");
            const unsigned og = xb_add(&bar[XB_TOP], 1u);
            const unsigned tg = og / nx;
            if (og + 1u == (tg + 1u) * nx) xb_add(&bar[XB_TOPGEN], 1u);
            else XB_SPIN(xb_ld(&bar[XB_TOPGEN]) == tg, bar);
            __builtin_amdgcn_fence(__ATOMIC_ACQUIRE, "agent");
            xb_add(&bar[XB_XGEN(b.x)], 1u);
            asm volatile("s_waitcnt vmcnt(0)" ::: "memory");
        } else {
            XB_SPIN(xb_ld(&bar[XB_XGEN(b.x)]) == gen, bar);
            __builtin_amdgcn_fence(__ATOMIC_ACQUIRE, "agent");
            asm volatile("s_waitcnt vmcnt(0)" ::: "memory");
        }
    }
    __syncthreads();
}

constexpr int RING_OFF = 0, RING_BYTES = pg8::STAGE_BYTES;
constexpr int MISC_OFF = RING_BYTES;
constexpr int RED_OFF = RING_BYTES + 4096;
constexpr int LDS_BYTES = RING_BYTES + 8192;

struct Args { const float* in[N_IN]; float* out; unsigned char* ws; int ph_lo, ph_hi; };

struct Frame {
    LAS unsigned char* lds; volatile LAS unsigned* MISC;
    int tid, lane, wave, vcu, G;
    unsigned char* ws; float* out;
};

__device__ __forceinline__ void transpose_item(const float* W, int K, int N, bf16_t* WT, int dstrow0, int k0, int n0, LAS float* scr, int lane, const float* gk, const float qs = 0.f) {
    if (gk) {
#pragma unroll 8
        for (int i = 0; i < 32; ++i) { const int kk = 2 * i + (lane >> 5); scr[kk * 33 + (lane & 31)] = __builtin_nontemporal_load(&W[(size_t)(k0 + kk) * N + n0 + (lane & 31)]) * gk[k0 + kk]; }
    } else {
#pragma unroll 8
    for (int i = 0; i < 32; ++i) { const int kk = 2 * i + (lane >> 5); scr[kk * 33 + (lane & 31)] = __builtin_nontemporal_load(&W[(size_t)(k0 + kk) * N + n0 + (lane & 31)]); }
    }
    LDS_WAIT(); asm volatile("" ::: "memory");
    const int c = lane & 7;
#pragma unroll
    for (int j = 0; j < 4; ++j) { const int n = (lane >> 3) + 8 * j; const LAS float* s = scr + (8 * c) * 33 + n;
        if (qs < 0.f) { const float q_ = -qs; u32x2 o8; o8.x = pk4_i8(s[0 * 33] * q_, s[1 * 33] * q_, s[2 * 33] * q_, s[3 * 33] * q_); o8.y = pk4_i8(s[4 * 33] * q_, s[5 * 33] * q_, s[6 * 33] * q_, s[7 * 33] * q_);
            *(u32x2*)((unsigned char*)WT + (size_t)(dstrow0 + n) * K + k0 + 8 * c) = o8; }
        else if (qs > 0.f) { u32x2 o8; o8.x = pk4_fp8(s[0 * 33] * qs, s[1 * 33] * qs, s[2 * 33] * qs, s[3 * 33] * qs); o8.y = pk4_fp8(s[4 * 33] * qs, s[5 * 33] * qs, s[6 * 33] * qs, s[7 * 33] * qs);
            *(u32x2*)((unsigned char*)WT + (size_t)(dstrow0 + n) * K + k0 + 8 * c) = o8; }
        else {
        u32x4 o; o.x = cvt_pk_bf16(s[0 * 33], s[1 * 33]); o.y = cvt_pk_bf16(s[2 * 33], s[3 * 33]); o.z = cvt_pk_bf16(s[4 * 33], s[5 * 33]); o.w = cvt_pk_bf16(s[6 * 33], s[7 * 33]);
        *(u32x4*)(WT + (size_t)(dstrow0 + n) * K + k0 + 8 * c) = o; } }
    LDS_WAIT(); asm volatile("" ::: "memory");
}
__device__ __forceinline__ int win_drow(int n0) {
    const int tile = n0 >> 8, pt = n0 & 255;
    if (tile == 2 || tile == 3 || tile == 20) return tile * 256 + ((pt >> 5) & 1) * 128 + (pt >> 6) * 32;
    if (tile == 14) return tile * 256 + ((pt >> 6) & 1) * 128 + (pt >> 7) * 64 + (pt & 63);
    return n0;
}
__device__ __forceinline__ void transpose_job(const float* W, int K, int N, bf16_t* WT, int mode, int item, LAS float* scr, int lane, const float* gk = nullptr, const float qs = 0.f) {
    const int nblk = N / 32, kb = item / nblk, nb = item % nblk, n0 = nb * 32;
    const int drow = mode == 0 ? n0 : (mode == 3 ? win_drow(n0) : ((n0 >> 7) * 256 + (n0 & 127) + (mode == 2 ? 128 : 0)));
    transpose_item(W, K, N, WT, drow, kb * 64, n0, scr, lane, gk, qs);
}
constexpr int IT_WIN = 32 * 162, IT_WUQ = 8 * 24, IT_WUKV = 8 * 32, IT_SQ = 32 * 64, IT_PP = 4 * 64, IT_LAYER = IT_WIN + IT_WUQ + IT_WUKV + 2 * IT_SQ + IT_PP;
constexpr int IT_FF = 32 * 224, IT_FFN = 3 * IT_FF;
constexpr int IT_TOTAL = 2 * IT_LAYER + IT_FFN + NE * IT_FFN;

__device__ __forceinline__ void ffn_job(const float* wg, const float* wu, const float* wd, bf16_t* gu, bf16_t* dn, int r, LAS float* scr, int lane, const float* gk, const bool moe) {
    if (r < IT_FF) { transpose_job(wg, DM, FF, gu, 1, r, scr, lane, gk, -1536.f); return; } r -= IT_FF;
    if (r < IT_FF) { transpose_job(wu, DM, FF, gu, 2, r, scr, lane, gk, -1536.f); return; } r -= IT_FF;
    transpose_job(wd, FF, DM, dn, 0, r, scr, lane, nullptr, moe ? 8192.f : 0.f);
}

__device__ __forceinline__ void rms_row_to_bf16(const float* xrow, const float* g, bf16_t* orow, int lane, float& rinv_out, f32x4 (&v)[8]) {
    const f32x4* xr = (const f32x4*)xrow + lane; float s = 0.f;
#pragma unroll
    for (int j = 0; j < 8; ++j) { v[j] = xr[64 * j]; s += (v[j].x * v[j].x + v[j].y * v[j].y) + (v[j].z * v[j].z + v[j].w * v[j].w); }
    const float rinv = 1.0f / sqrtf(wave_sum(s) * (1.0f / DM) + EPS); rinv_out = rinv;
    u32x2* o8 = (u32x2*)orow + lane;
#pragma unroll
    for (int j = 0; j < 8; ++j) { const f32x4 gg = ((const f32x4*)g)[64 * j + lane]; v[j] = v[j] * rinv * gg;
        u32x2 w; w.x = cvt_pk_bf16(v[j].x, v[j].y); w.y = cvt_pk_bf16(v[j].z, v[j].w); o8[64 * j] = w; }
}


__device__ __forceinline__ void row_hb_ss(const f32x4 (&v)[8], bf16_t* hbrow, float* ssp, int lane) {
    float s = 0.f; u32x2* o8 = (u32x2*)hbrow + lane;
#pragma unroll
    for (int j = 0; j < 8; ++j) { s += (v[j].x * v[j].x + v[j].y * v[j].y) + (v[j].z * v[j].z + v[j].w * v[j].w); u32x2 w; w.x = cvt_pk_bf16(v[j].x, v[j].y); w.y = cvt_pk_bf16(v[j].z, v[j].w); o8[64 * j] = w; }
    s = wave_sum(s);
    if (lane < 8) ssp[lane] = lane == 0 ? s : 0.f;
}

namespace att {
typedef int v4i_t __attribute__((ext_vector_type(4)));
typedef int v8i_t __attribute__((ext_vector_type(8)));
constexpr int KPL = 8192;
constexpr int KBUF = 3 * KPL;
constexpr int VT = 16384;
constexpr int OFF_K = 0, OFF_V = 2 * KBUF, OFF_WS = OFF_V + 2 * VT, OFF_BIAS = OFF_WS + 8 * 256, OFF_QL = OFF_BIAS + 2048, LDS_END = OFF_QL + 8 * 4096;
#define SBAR() __builtin_amdgcn_sched_barrier(0)
__device__ __forceinline__ int crow(int r, int hi) { return (r & 3) + 8 * (r >> 2) + 4 * hi; }
__device__ __forceinline__ int v_st(int k, int c) { const int kk = (k & ~0xC) | ((k & 4) << 1) | ((k & 8) >> 1); return ((kk >> 3) * 4 + (c >> 5)) * 512 + ((kk & 7) * 32 + (c & 31)) * 2; }
__device__ __forceinline__ int v_rd_base(int lane) { return ((lane & 3) << 3) | (((lane >> 2) & 3) << 6) | (((lane >> 4) & 1) << 5) | (((lane >> 5) & 1) << 8); }
constexpr int v_rd_off(int d0, int ks, int half) { return d0 * 512 + ks * 4096 + half * 2048; }
template <int OFF> __device__ __forceinline__ s16x4 tr_read(int vb) {
    s16x4 r; asm volatile("ds_read_b64_tr_b16 %0, %1 offset:%2" : "=&v"(r) : "v"(vb), "i"(OFF) : "memory"); return r;
}
template <int D0> __device__ __forceinline__ void pv_one(f32x16& od, int vb, bf16x8 pa0, bf16x8 pa1, bf16x8 pa2, bf16x8 pa3) {
    const s16x4 l0 = tr_read<v_rd_off(D0, 0, 0)>(vb), h0 = tr_read<v_rd_off(D0, 0, 1)>(vb), l1 = tr_read<v_rd_off(D0, 1, 0)>(vb), h1 = tr_read<v_rd_off(D0, 1, 1)>(vb);
    const s16x4 l2 = tr_read<v_rd_off(D0, 2, 0)>(vb), h2 = tr_read<v_rd_off(D0, 2, 1)>(vb), l3 = tr_read<v_rd_off(D0, 3, 0)>(vb), h3 = tr_read<v_rd_off(D0, 3, 1)>(vb);
    asm volatile("s_waitcnt lgkmcnt(0)" ::: "memory"); SBAR();
#define PK(L, H) (bf16x8){L[0], L[1], L[2], L[3], H[0], H[1], H[2], H[3]}
    od = __builtin_amdgcn_mfma_f32_32x32x16_bf16(pa0, PK(l0, h0), od, 0, 0, 0);
    od = __builtin_amdgcn_mfma_f32_32x32x16_bf16(pa1, PK(l1, h1), od, 0, 0, 0);
    od = __builtin_amdgcn_mfma_f32_32x32x16_bf16(pa2, PK(l2, h2), od, 0, 0, 0);
    od = __builtin_amdgcn_mfma_f32_32x32x16_bf16(pa3, PK(l3, h3), od, 0, 0, 0);
#undef PK
}
__device__ __forceinline__ void partialSM(f32x16& p0, f32x16& p1, float& m_reg, float& alpha, const float C, const float thr) {
    float pmax = p0[0];
#pragma unroll
    for (int r = 1; r < 16; ++r) pmax = fmaxf(pmax, p0[r]);
#pragma unroll
    for (int r = 0; r < 16; ++r) pmax = fmaxf(pmax, p1[r]);
    { auto rr = __builtin_amdgcn_permlane32_swap(__float_as_uint(pmax), __float_as_uint(pmax), false, false);
      pmax = fmaxf(__uint_as_float(rr[0]), __uint_as_float(rr[1])); }
    float mn;
    if (__builtin_expect(__all(pmax - m_reg <= thr), 1)) { mn = m_reg; alpha = 1.f; }
    else { mn = fmaxf(m_reg, pmax); alpha = __builtin_amdgcn_exp2f((m_reg - mn) * C); m_reg = mn; }
    const float mnC = -mn * C;
#pragma unroll
    for (int r = 0; r < 16; ++r) p0[r] = __builtin_amdgcn_exp2f(fmaf(p0[r], C, mnC));
#pragma unroll
    for (int r = 0; r < 16; ++r) p1[r] = __builtin_amdgcn_exp2f(fmaf(p1[r], C, mnC));
}
__device__ __forceinline__ void finishSM(const f32x16& p0, const f32x16& p1, float alpha, float& l_reg, bf16x8& pa0, bf16x8& pa1, bf16x8& pa2, bf16x8& pa3) {
    float ps = 0;
#pragma unroll
    for (int r = 0; r < 16; ++r) ps += p0[r];
#pragma unroll
    for (int r = 0; r < 16; ++r) ps += p1[r];
    { auto rr = __builtin_amdgcn_permlane32_swap(__float_as_uint(ps), __float_as_uint(ps), false, false);
      ps = __uint_as_float(rr[0]) + __uint_as_float(rr[1]); }
    l_reg = l_reg * alpha + ps;
#define PK4(P, BASE, OUT) do { unsigned a0 = cvt_pk_bf16(P[BASE + 0], P[BASE + 1]), a1 = cvt_pk_bf16(P[BASE + 2], P[BASE + 3]);   \
    unsigned b0 = cvt_pk_bf16(P[BASE + 4], P[BASE + 5]), b1 = cvt_pk_bf16(P[BASE + 6], P[BASE + 7]);                              \
    auto r0 = __builtin_amdgcn_permlane32_swap(a0, b0, false, false); auto r1 = __builtin_amdgcn_permlane32_swap(a1, b1, false, false); \
    u32x4 w = {r0[0], r1[0], r0[1], r1[1]}; OUT = *reinterpret_cast<bf16x8*>(&w); } while (0)
    PK4(p0, 0, pa0); PK4(p0, 8, pa1); PK4(p1, 0, pa2); PK4(p1, 8, pa3);
#undef PK4
}

struct Src { const bf16_t* q[3]; const bf16_t* k[3]; const bf16_t* v; int ldq, ldk[3], ldv; };
struct Par { int kt0, nkt; float C, thr; const float* rtab; int qpos0; int na_r0, na_krlo; };

template <int NCH, int MODE, int ROPE_D0S, int ROPE_HW>
__device__ __forceinline__ void attn_pass(LAS unsigned char* lds, const int tid, const Src& S, const Par& P, float& m_reg, float& l_reg, f32x16 (&o)[4]) {
    const int wid = __builtin_amdgcn_readfirstlane(tid >> 6), lane = tid & 63, r32 = lane & 31, hi = lane >> 5;
    LAS float* al_l = (LAS float*)(lds + OFF_WS + wid * 256);
    bf16x8 qr[NCH * 4];
#pragma unroll
    for (int c = 0; c < NCH; ++c)
#pragma unroll
        for (int d = 0; d < 4; ++d) qr[c * 4 + d] = *(const bf16x8*)(S.q[c] + (size_t)(wid * 32 + r32) * S.ldq + d * 16 + hi * 8);
    if constexpr (ROPE_HW > 0) {
        const float* tb = P.rtab + (size_t)(P.qpos0 + wid * 32 + r32) * (ROPE_HW * 32) + hi * 16;
#pragma unroll
        for (int d = 0; d < ROPE_HW; ++d) {
            const f32x4 t0 = *(const f32x4*)(tb + d * 32), t1 = *(const f32x4*)(tb + d * 32 + 4), t2 = *(const f32x4*)(tb + d * 32 + 8), t3 = *(const f32x4*)(tb + d * 32 + 12);
            const float cs[16] = {t0[0], t0[1], t0[2], t0[3], t1[0], t1[1], t1[2], t1[3], t2[0], t2[1], t2[2], t2[3], t3[0], t3[1], t3[2], t3[3]};
            const u32x4 a = *reinterpret_cast<const u32x4*>(&qr[ROPE_D0S + d]), b = *reinterpret_cast<const u32x4*>(&qr[ROPE_D0S + ROPE_HW + d]);
            u32x4 ya, yb;
#pragma unroll
            for (int w = 0; w < 4; ++w) {
                const float x1l = bflo(a[w]), x1h = bfhi(a[w]), x2l = bflo(b[w]), x2h = bfhi(b[w]);
                const float cl = cs[4 * w], sl = cs[4 * w + 1], ch = cs[4 * w + 2], sh = cs[4 * w + 3];
                ya[w] = cvt_pk_bf16(x1l * cl - x2l * sl, x1h * ch - x2h * sh); yb[w] = cvt_pk_bf16(x2l * cl + x1l * sl, x2h * ch + x1h * sh);
            }
            qr[ROPE_D0S + d] = *reinterpret_cast<bf16x8*>(&ya); qr[ROPE_D0S + ROPE_HW + d] = *reinterpret_cast<bf16x8*>(&yb);
        }
    }
    const int krow = tid >> 3, kpc = tid & 7, kst = krow * 128 + ((kpc ^ ((krow >> 1) & 7)) << 4);
    const int sr = tid >> 4, sc = (tid & 15) * 8, vst0 = v_st(sr, sc), vst1 = v_st(32 + sr, sc);
    const int vb0 = (int)(unsigned)(uintptr_t)(lds + OFF_V) + v_rd_base(lane);
    const int ksw = (r32 >> 1) & 7; int kro[4];
#pragma unroll
    for (int d = 0; d < 4; ++d) kro[d] = r32 * 128 + (((d * 2 + hi) ^ ksw) << 4);
    bf16x8 ks[NCH], vs0, vs1;
    unsigned koff[NCH];
#pragma unroll
    for (int c = 0; c < NCH; ++c) koff[c] = (unsigned)(krow * S.ldk[c] + kpc * 8) * 2u;
    const unsigned voff0 = (unsigned)(sr * S.ldv + sc) * 2u, voff1 = (unsigned)((32 + sr) * S.ldv + sc) * 2u;
#define A_SLOAD(k0) do { const int k0_ = __builtin_amdgcn_readfirstlane(k0); _Pragma("unroll") for (int c = 0; c < NCH; ++c) ks[c] = *(const bf16x8*)((const char*)S.k[c] + (size_t)k0_ * S.ldk[c] * 2 + koff[c]); \
        const char* vb_ = (const char*)S.v + (size_t)k0_ * S.ldv * 2; vs0 = *(const bf16x8*)(vb_ + voff0); vs1 = *(const bf16x8*)(vb_ + voff1); } while (0)
#define A_SWRITE(b) do { _Pragma("unroll") for (int c = 0; c < NCH; ++c) *(LAS bf16x8*)(lds + OFF_K + (b) * KBUF + c * KPL + kst) = ks[c]; \
        *(LAS bf16x8*)(lds + OFF_V + (b) * VT + vst0) = vs0; *(LAS bf16x8*)(lds + OFF_V + (b) * VT + vst1) = vs1; } while (0)
    A_SLOAD(P.kt0); VM_WAIT(); A_SWRITE(0); __syncthreads();
    int na_rw = 0, na_rs = 0, na_cq = 0, na_ws = 0, sw_base = 0;
    if constexpr (MODE == 1) { na_rw = P.na_r0 + (wid >> 1); na_rs = min(max(na_rw - 4, 0), 56); na_cq = (wid & 1) * 32 + r32; na_ws = min(max(na_cq - 8, 0), 48); }
    if constexpr (MODE == 2) { sw_base = P.kt0 - (P.qpos0 + wid * 32 + r32) + 128; }
    for (int j = 0; j < P.nkt; ++j) {
        const int b = j & 1;
        if (j + 1 < P.nkt) A_SLOAD(P.kt0 + (j + 1) * 64);
        bool act = true;
        if constexpr (MODE == 1) { const int kr = P.na_krlo + j; act = (kr >= na_rs) && (kr < na_rs + 8); }
        if (act) {
            f32x16 p0 = {}, p1 = {};
            const LAS unsigned char* Kb = lds + OFF_K + b * KBUF;
#pragma unroll
            for (int c = 0; c < NCH; ++c)
#pragma unroll
                for (int d = 0; d < 4; ++d) {
                    const bf16x8 k0v = *(const LAS bf16x8*)(Kb + c * KPL + kro[d]), k1v = *(const LAS bf16x8*)(Kb + c * KPL + 4096 + kro[d]);
                    p0 = __builtin_amdgcn_mfma_f32_32x32x16_bf16(k0v, qr[c * 4 + d], p0, 0, 0, 0);
                    p1 = __builtin_amdgcn_mfma_f32_32x32x16_bf16(k1v, qr[c * 4 + d], p1, 0, 0, 0);
                }
            if constexpr (MODE == 1) {
                const LAS float* bt = (const LAS float*)(lds + OFF_BIAS) + (P.na_krlo + j - na_rw + 7) * 31 + 15;
#pragma unroll
                for (int r = 0; r < 16; ++r) {
                    const int kc0 = crow(r, hi), kc1 = 32 + kc0;
                    const int dc0 = min(max(kc0 - na_cq, -15), 15), dc1 = min(max(kc1 - na_cq, -15), 15);
                    const float b0 = bt[dc0], b1 = bt[dc1];
                    p0[r] = ((unsigned)(kc0 - na_ws) < 16u) ? p0[r] + b0 : -__builtin_inff();
                    p1[r] = ((unsigned)(kc1 - na_ws) < 16u) ? p1[r] + b1 : -__builtin_inff();
                }
            }
            if constexpr (MODE == 2) {
                const int base = sw_base + j * 64;
#pragma unroll
                for (int r = 0; r < 16; ++r) {
                    const int kc0 = crow(r, hi);
                    p0[r] = ((unsigned)(base + kc0) <= 256u) ? p0[r] : -__builtin_inff();
                    p1[r] = ((unsigned)(base + kc0 + 32) <= 256u) ? p1[r] : -__builtin_inff();
                }
            }
            float alpha;
            partialSM(p0, p1, m_reg, alpha, P.C, P.thr);
            if (__any(alpha < 1.f)) {
                if (hi == 0) al_l[r32] = alpha;
                asm volatile("s_waitcnt lgkmcnt(0)" ::: "memory");
#pragma unroll
                for (int r = 0; r < 16; ++r) { const float a = al_l[crow(r, hi)];
#pragma unroll
                    for (int d = 0; d < 4; ++d) o[d][r] *= a; }
            }
            bf16x8 pa0, pa1, pa2, pa3;
            finishSM(p0, p1, alpha, l_reg, pa0, pa1, pa2, pa3); SBAR();
            const int vb = vb0 + b * VT;
            pv_one<0>(o[0], vb, pa0, pa1, pa2, pa3); pv_one<1>(o[1], vb, pa0, pa1, pa2, pa3); pv_one<2>(o[2], vb, pa0, pa1, pa2, pa3); pv_one<3>(o[3], vb, pa0, pa1, pa2, pa3);
        }
        if (j + 1 < P.nkt) { VM_WAIT(); A_SWRITE(b ^ 1); }
        __syncthreads();
    }
#undef A_SLOAD
#undef A_SWRITE
}

__device__ __forceinline__ void partialSM2(f32x16& p0, f32x16& p1, float& m_reg, float& alpha, const float C, const float thr, const float pofs = 0.f) {
    float pmax = p0[0];
#pragma unroll
    for (int r = 1; r < 16; ++r) pmax = fmaxf(pmax, p0[r]);
#pragma unroll
    for (int r = 0; r < 16; ++r) pmax = fmaxf(pmax, p1[r]);
    { auto rr = __builtin_amdgcn_permlane32_swap(__float_as_uint(pmax), __float_as_uint(pmax), false, false);
      pmax = fmaxf(__uint_as_float(rr[0]), __uint_as_float(rr[1])); }
    float mn;
    if (__builtin_expect(__all(pmax - m_reg <= thr), 1)) { mn = m_reg; alpha = 1.f; }
    else { mn = fmaxf(m_reg, pmax); alpha = __builtin_amdgcn_exp2f((m_reg - mn) * C); m_reg = mn; }
    const float mnC = -mn * C + pofs;
#pragma unroll
    for (int r = 0; r < 16; ++r) p0[r] = fmaf(p0[r], C, mnC);
#pragma unroll
    for (int r = 0; r < 16; ++r) p1[r] = fmaf(p1[r], C, mnC);
#pragma unroll
    for (int r = 0; r < 16; ++r) p0[r] = __builtin_amdgcn_exp2f(p0[r]);
}
__device__ __forceinline__ void finishSM2(f32x16& p0, f32x16& p1, float alpha, float& l_reg, bf16x8& pa0, bf16x8& pa1, bf16x8& pa2, bf16x8& pa3) {
#pragma unroll
    for (int r = 0; r < 16; ++r) p1[r] = __builtin_amdgcn_exp2f(p1[r]);
    finishSM(p0, p1, alpha, l_reg, pa0, pa1, pa2, pa3);
}
typedef __bf16 bf16x2_t __attribute__((ext_vector_type(2)));
typedef short s16x2_t __attribute__((ext_vector_type(2)));
__device__ __forceinline__ unsigned cvt4_fp8_bf16(unsigned a, unsigned b) {
    s16x2_t r = {0, 0}; r = __builtin_amdgcn_cvt_scalef32_pk_fp8_bf16(r, __builtin_bit_cast(bf16x2_t, a), 1.0f, false); r = __builtin_amdgcn_cvt_scalef32_pk_fp8_bf16(r, __builtin_bit_cast(bf16x2_t, b), 1.0f, true);
    return __builtin_bit_cast(unsigned, r); }
__device__ __forceinline__ u32x2 cvt8_fp8_bf16(const u32x4 w) { u32x2 e; e.x = cvt4_fp8_bf16(w.x, w.y); e.y = cvt4_fp8_bf16(w.z, w.w); return e; }
__device__ __forceinline__ void finishSM8(f32x16& p0, f32x16& p1, float alpha, float& l_reg, v8i_t& pa8) {
#pragma unroll
    for (int r = 0; r < 16; ++r) p1[r] = __builtin_amdgcn_exp2f(p1[r]);
    float ps = 0;
#pragma unroll
    for (int r = 0; r < 16; ++r) ps += p0[r];
#pragma unroll
    for (int r = 0; r < 16; ++r) ps += p1[r];
    { auto rr = __builtin_amdgcn_permlane32_swap(__float_as_uint(ps), __float_as_uint(ps), false, false);
      ps = __uint_as_float(rr[0]) + __uint_as_float(rr[1]); }
    l_reg = l_reg * alpha + ps;
#pragma unroll
    for (int k = 0; k < 4; ++k) {
        pa8[k] = __builtin_amdgcn_cvt_pk_fp8_f32(p0[4 * k + 2], p0[4 * k + 3], __builtin_amdgcn_cvt_pk_fp8_f32(p0[4 * k], p0[4 * k + 1], 0, false), true);
        pa8[4 + k] = __builtin_amdgcn_cvt_pk_fp8_f32(p1[4 * k + 2], p1[4 * k + 3], __builtin_amdgcn_cvt_pk_fp8_f32(p1[4 * k], p1[4 * k + 1], 0, false), true); }
}
template <int OFF> __device__ __forceinline__ u32x2 tr8_read(int vb) {
    u32x2 r; asm volatile("ds_read_b64_tr_b8 %0, %1 offset:%2" : "=&v"(r) : "v"(vb), "i"(OFF) : "memory"); return r;
}
template <int D0> __device__ __forceinline__ void pv8_one(f32x16& od, int vb, const v8i_t pa8) {
    const u32x2 t0 = tr8_read<D0 * 256>(vb), t1 = tr8_read<D0 * 256 + 2048>(vb), t2 = tr8_read<D0 * 256 + 4096>(vb), t3 = tr8_read<D0 * 256 + 6144>(vb);
    asm volatile("s_waitcnt lgkmcnt(0)" ::: "memory"); SBAR();
    const v8i_t vf = {(int)t0.x, (int)t0.y, (int)t1.x, (int)t1.y, (int)t2.x, (int)t2.y, (int)t3.x, (int)t3.y};
    od = __builtin_amdgcn_mfma_scale_f32_32x32x64_f8f6f4(pa8, vf, od, 0, 0, 0, 0x7f7f7f7f, 0, 0x7f7f7f7f);
}
template <int NCH, int ROPE_D0S, int ROPE_HW, int SDEPTH, int QLDS, int K8 = 0>
__device__ __forceinline__ void attn_pass_pipe(LAS unsigned char* lds, const int tid, const Src& S, const Par& P, float& m_reg, float& l_reg, f32x16 (&o)[4]) {
    const int wid = __builtin_amdgcn_readfirstlane(tid >> 6), lane = tid & 63, r32 = lane & 31, hi = lane >> 5;
    LAS float* al_l = (LAS float*)(lds + OFF_WS + wid * 256);
    bf16x8 qr[NCH * 4];
#pragma unroll
    for (int c = 0; c < NCH; ++c)
#pragma unroll
        for (int d = 0; d < 4; ++d) qr[c * 4 + d] = *(const bf16x8*)(S.q[c] + (size_t)(wid * 32 + r32) * S.ldq + d * 16 + hi * 8);
    v8i_t q8[K8 ? NCH : 1]; (void)q8;
#define P_Q8(c) do { _Pragma("unroll") for (int d = 0; d < 4; ++d) { const u32x2 e_ = cvt8_fp8_bf16(*reinterpret_cast<const u32x4*>(&qr[(c) * 4 + d])); q8[c][d * 2] = (int)e_.x; q8[c][d * 2 + 1] = (int)e_.y; } } while (0)
    if constexpr (K8) {
#pragma unroll
        for (int c = 0; c < NCH; ++c) if (ROPE_HW == 0 || c * 4 + 3 < ROPE_D0S) P_Q8(c);
    }
    if constexpr (ROPE_HW > 0) {
        const float* tb = P.rtab + (size_t)(P.qpos0 + wid * 32 + r32) * (ROPE_HW * 32) + hi * 16;
#pragma unroll
        for (int d = 0; d < ROPE_HW; ++d) {
            const f32x4 t0 = *(const f32x4*)(tb + d * 32), t1 = *(const f32x4*)(tb + d * 32 + 4), t2 = *(const f32x4*)(tb + d * 32 + 8), t3 = *(const f32x4*)(tb + d * 32 + 12);
            const float cs[16] = {t0[0], t0[1], t0[2], t0[3], t1[0], t1[1], t1[2], t1[3], t2[0], t2[1], t2[2], t2[3], t3[0], t3[1], t3[2], t3[3]};
            const u32x4 a = *reinterpret_cast<const u32x4*>(&qr[ROPE_D0S + d]), b = *reinterpret_cast<const u32x4*>(&qr[ROPE_D0S + ROPE_HW + d]);
            u32x4 ya, yb;
#pragma unroll
            for (int w = 0; w < 4; ++w) {
                const float x1l = bflo(a[w]), x1h = bfhi(a[w]), x2l = bflo(b[w]), x2h = bfhi(b[w]);
                const float cl = cs[4 * w], sl = cs[4 * w + 1], ch = cs[4 * w + 2], sh = cs[4 * w + 3];
                ya[w] = cvt_pk_bf16(x1l * cl - x2l * sl, x1h * ch - x2h * sh); yb[w] = cvt_pk_bf16(x2l * cl + x1l * sl, x2h * ch + x1h * sh);
            }
            qr[ROPE_D0S + d] = *reinterpret_cast<bf16x8*>(&ya); qr[ROPE_D0S + ROPE_HW + d] = *reinterpret_cast<bf16x8*>(&yb);
        }
    }
    const int krow = tid >> 3, kpc = tid & 7, kst = krow * 128 + ((kpc ^ ((krow >> 1) & 7)) << 4);
    const int sr = tid >> 4, sc = (tid & 15) * 8, vst0 = v_st(sr, sc), vst1 = v_st(32 + sr, sc);
    const int vb0 = (int)(unsigned)(uintptr_t)(lds + OFF_V) + v_rd_base(lane);
    const int ksw = (r32 >> 1) & 7; int kro[4];
#pragma unroll
    for (int d = 0; d < 4; ++d) kro[d] = r32 * 128 + (((d * 2 + hi) ^ ksw) << 4);
    LAS unsigned char* qlds = lds + OFF_QL + wid * (QLDS > 0 ? QLDS : 1) * 4096 + lane * 16;
    if constexpr (QLDS > 0) {
#pragma unroll
        for (int c = NCH - QLDS; c < NCH; ++c)
#pragma unroll
            for (int d = 0; d < 4; ++d) *(LAS bf16x8*)(qlds + ((c - (NCH - QLDS)) * 4 + d) * 1024) = qr[c * 4 + d];
        asm volatile("s_waitcnt lgkmcnt(0)" ::: "memory");
    }
    if constexpr (K8) {
        static_assert(QLDS == 0, "K8: Q stays in registers");
#pragma unroll
        for (int c = 0; c < NCH; ++c) if (!(ROPE_HW == 0 || c * 4 + 3 < ROPE_D0S)) P_Q8(c);
    }
#undef P_Q8
    constexpr int KS8 = (NCH == 1) ? 80 : 208;
    const int kst8 = krow * KS8 + (kpc & 1) * 32 + (kpc >> 1) * 8, kro8 = r32 * KS8 + hi * 32; (void)kst8; (void)kro8;
    const int vst8 = (((sr >> 4) * 2 + ((sr >> 2) & 1)) * 8 + (sc >> 4)) * 128 + ((sr & 3) | (((sr >> 3) & 1) << 2)) * 16 + ((sc >> 3) & 1) * 8;
    const int vb8 = (int)(unsigned)(uintptr_t)(lds + OFF_V) + (lane >> 5) * 1024 + ((lane >> 4) & 1) * 128 + ((lane & 15) >> 1) * 16 + (lane & 1) * 8; (void)vst8; (void)vb8;
    v8i_t pa8; (void)pa8;
    struct Slot { bf16x8 ks[NCH], vs0, vs1; } st[SDEPTH];
    constexpr int SE = 0, SO = SDEPTH - 1;
    unsigned koff[NCH];
#pragma unroll
    for (int c = 0; c < NCH; ++c) koff[c] = (unsigned)(krow * S.ldk[c] + kpc * 8) * 2u;
    const unsigned voff0 = (unsigned)(sr * S.ldv + sc) * 2u, voff1 = (unsigned)((32 + sr) * S.ldv + sc) * 2u;
#define P_SLOAD(i, k0) do { const int k0_ = __builtin_amdgcn_readfirstlane(k0); _Pragma("unroll") for (int c = 0; c < NCH; ++c) st[i].ks[c] = *(const bf16x8*)((const char*)S.k[c] + (size_t)k0_ * S.ldk[c] * 2 + koff[c]); \
        const char* vb_ = (const char*)S.v + (size_t)k0_ * S.ldv * 2; st[i].vs0 = *(const bf16x8*)(vb_ + voff0); st[i].vs1 = *(const bf16x8*)(vb_ + voff1); } while (0)
#define P_SWRITE(b, i) do { if constexpr (K8) { _Pragma("unroll") for (int c = 0; c < NCH; ++c) { *(LAS u32x2*)(lds + OFF_K + (b) * KBUF + c * 64 + kst8) = cvt8_fp8_bf16(*reinterpret_cast<const u32x4*>(&st[i].ks[c])); } } \
        else { _Pragma("unroll") for (int c = 0; c < NCH; ++c) *(LAS bf16x8*)(lds + OFF_K + (b) * KBUF + c * KPL + kst) = st[i].ks[c]; } \
        if constexpr (K8) { *(LAS u32x2*)(lds + OFF_V + (b) * VT + vst8) = cvt8_fp8_bf16(*reinterpret_cast<const u32x4*>(&st[i].vs0)); *(LAS u32x2*)(lds + OFF_V + (b) * VT + vst8 + 4096) = cvt8_fp8_bf16(*reinterpret_cast<const u32x4*>(&st[i].vs1)); } \
        else { *(LAS bf16x8*)(lds + OFF_V + (b) * VT + vst0) = st[i].vs0; *(LAS bf16x8*)(lds + OFF_V + (b) * VT + vst1) = st[i].vs1; } } while (0)
#define P_SWAIT() do { if constexpr (SDEPTH == 2) { if constexpr (NCH == 1) asm volatile("s_waitcnt vmcnt(3)" ::: "memory"); else if constexpr (NCH == 2) asm volatile("s_waitcnt vmcnt(4)" ::: "memory"); else asm volatile("s_waitcnt vmcnt(5)" ::: "memory"); } \
        else asm volatile("s_waitcnt vmcnt(0)" ::: "memory"); } while (0)
#define P_QKT(p0, p1, b) do { p0 = f32x16{}; p1 = f32x16{}; const LAS unsigned char* Kb_ = lds + OFF_K + (b) * KBUF; \
        if constexpr (K8) { _Pragma("unroll") for (int c = 0; c < NCH; ++c) { \
            const v4i_t a0_ = *(const LAS v4i_t*)(Kb_ + c * 64 + kro8), a1_ = *(const LAS v4i_t*)(Kb_ + c * 64 + kro8 + 16), b0_ = *(const LAS v4i_t*)(Kb_ + 32 * KS8 + c * 64 + kro8), b1_ = *(const LAS v4i_t*)(Kb_ + 32 * KS8 + c * 64 + kro8 + 16); \
            p0 = __builtin_amdgcn_mfma_scale_f32_32x32x64_f8f6f4(__builtin_shufflevector(a0_, a1_, 0, 1, 2, 3, 4, 5, 6, 7), q8[c], p0, 0, 0, 0, 0x7f7f7f7f, 0, 0x7f7f7f7f); \
            p1 = __builtin_amdgcn_mfma_scale_f32_32x32x64_f8f6f4(__builtin_shufflevector(b0_, b1_, 0, 1, 2, 3, 4, 5, 6, 7), q8[c], p1, 0, 0, 0, 0x7f7f7f7f, 0, 0x7f7f7f7f); } } else \
        _Pragma("unroll") for (int c = 0; c < NCH; ++c) _Pragma("unroll") for (int d = 0; d < 4; ++d) { \
            const bf16x8 k0v = *(const LAS bf16x8*)(Kb_ + c * KPL + kro[d]), k1v = *(const LAS bf16x8*)(Kb_ + c * KPL + 4096 + kro[d]); \
            const bf16x8 qv_ = (c < NCH - QLDS) ? qr[c * 4 + d] : *(const LAS bf16x8*)(qlds + ((c - (NCH - QLDS)) * 4 + d) * 1024); \
            p0 = __builtin_amdgcn_mfma_f32_32x32x16_bf16(k0v, qv_, p0, 0, 0, 0); p1 = __builtin_amdgcn_mfma_f32_32x32x16_bf16(k1v, qv_, p1, 0, 0, 0); } } while (0)
#define P_FIN(pX0, pX1, alX) do { if constexpr (K8) finishSM8(pX0, pX1, alX, l_reg, pa8); else finishSM2(pX0, pX1, alX, l_reg, pa0, pa1, pa2, pa3); } while (0)
#define P_PV(b) do { if constexpr (K8) { const int vb_ = vb8 + (b) * VT; pv8_one<0>(o[0], vb_, pa8); pv8_one<1>(o[1], vb_, pa8); pv8_one<2>(o[2], vb_, pa8); pv8_one<3>(o[3], vb_, pa8); } else { const int vb_ = vb0 + (b) * VT; pv_one<0>(o[0], vb_, pa0, pa1, pa2, pa3); pv_one<1>(o[1], vb_, pa0, pa1, pa2, pa3); pv_one<2>(o[2], vb_, pa0, pa1, pa2, pa3); pv_one<3>(o[3], vb_, pa0, pa1, pa2, pa3); } } while (0)
#define P_RESC(a) do { if (__any((a) < 1.f)) { if (hi == 0) al_l[r32] = (a); asm volatile("s_waitcnt lgkmcnt(0)" ::: "memory"); \
        _Pragma("unroll") for (int r = 0; r < 16; ++r) { const float a_ = al_l[crow(r, hi)]; _Pragma("unroll") for (int d = 0; d < 4; ++d) o[d][r] *= a_; } } } while (0)
    f32x16 pA0, pA1, pB0, pB1; float alA, alB; bf16x8 pa0, pa1, pa2, pa3; const int NT = P.nkt, kt0 = P.kt0;
    __syncthreads();
    P_SLOAD(SE, kt0); VM_WAIT(); P_SWRITE(0, SE); __syncthreads();
    P_QKT(pA0, pA1, 0); partialSM2(pA0, pA1, m_reg, alA, P.C, P.thr, K8 ? 4.0f : 0.f);
    P_SLOAD(SO, kt0 + 64); if constexpr (SDEPTH == 2) { P_SLOAD(SE, kt0 + 128); }
    P_SWAIT(); P_SWRITE(1, SO); __syncthreads();
    for (int j = 1; j + 1 < NT; j += 2) {
        SBAR(); P_QKT(pB0, pB1, 1);
        P_FIN(pA0, pA1, alA); SBAR();
        P_SLOAD(SO, kt0 + (j + SDEPTH) * 64); SBAR();
        P_PV(0); partialSM2(pB0, pB1, m_reg, alB, P.C, P.thr, K8 ? 4.0f : 0.f);
        __syncthreads(); P_SWAIT(); P_SWRITE(0, SE);
        P_RESC(alB); __syncthreads();
        SBAR(); P_QKT(pA0, pA1, 0);
        P_FIN(pB0, pB1, alB); SBAR();
        if (SDEPTH == 1 || j + 3 < NT) P_SLOAD(SE, kt0 + (j + 1 + SDEPTH) * 64); SBAR();
        P_PV(1); partialSM2(pA0, pA1, m_reg, alA, P.C, P.thr, K8 ? 4.0f : 0.f);
        __syncthreads(); P_SWAIT(); P_SWRITE(1, SO);
        P_RESC(alA); __syncthreads();
    }
    SBAR(); P_QKT(pB0, pB1, 1);
    P_FIN(pA0, pA1, alA); SBAR();
    P_PV(0); partialSM2(pB0, pB1, m_reg, alB, P.C, P.thr, K8 ? 4.0f : 0.f);
    P_RESC(alB);
    P_FIN(pB0, pB1, alB); SBAR();
    P_PV(1);
#undef P_SLOAD
#undef P_SWRITE
#undef P_SWAIT
#undef P_QKT
#undef P_PV
#undef P_FIN
#undef P_RESC
}
__device__ __forceinline__ void normalize(LAS unsigned char* lds, const int tid, const float l_reg, f32x16 (&o)[4]) {
    const int wid = __builtin_amdgcn_readfirstlane(tid >> 6), lane = tid & 63, r32 = lane & 31, hi = lane >> 5;
    LAS float* li_l = (LAS float*)(lds + OFF_WS + wid * 256) + 32;
    if (hi == 0) li_l[r32] = l_reg;
    asm volatile("s_waitcnt lgkmcnt(0)" ::: "memory");
#pragma unroll
    for (int r = 0; r < 16; ++r) { const float rl = __builtin_amdgcn_rcpf(li_l[crow(r, hi)]);
#pragma unroll
        for (int d = 0; d < 4; ++d) o[d][r] *= rl; }
    asm volatile("s_waitcnt lgkmcnt(0)" ::: "memory");
}
__device__ __forceinline__ void store_o(bf16_t* O, const int ldo, const int tid, const f32x16 (&o)[4]) {
    const int wid = __builtin_amdgcn_readfirstlane(tid >> 6), lane = tid & 63, r32 = lane & 31, hi = lane >> 5;
#pragma unroll
    for (int r = 0; r < 16; ++r) { bf16_t* rowp = O + (size_t)(wid * 32 + crow(r, hi)) * ldo + r32;
#pragma unroll
        for (int d = 0; d < 4; ++d) rowp[d * 32] = f2bf(o[d][r]); }
}
}

#if NAIVE_ATTN
template <int MODE>
__global__ void __launch_bounds__(256) naive_attn(Args args, int layer) {
    unsigned char* ws = args.ws;
    const bf16_t* z = (const bf16_t*)(ws + WS_Z); bf16_t* mix = (bf16_t*)(ws + WS_MIX);
    const float* tab64 = (const float*)(ws + WS_TAB64); const float* tab128 = (const float*)(ws + WS_TAB128);
    const int lane = threadIdx.x & 63; const int gw = blockIdx.x * 4 + (threadIdx.x >> 6);
    const int b = gw / (4 * SEQ), h = (gw / SEQ) & 3, i = gw % SEQ; const size_t rb = (size_t)b * SEQ;
    if constexpr (MODE == 0) {
        float lam; { float a = lane < 64 ? args.in[I_LQ1][layer * 64 + lane] * args.in[I_LK1][layer * 64 + lane] : 0.f, c = args.in[I_LQ2][layer * 64 + lane] * args.in[I_LK2][layer * 64 + lane];
            const float li = 0.8f - 0.6f * expf(-0.3f * layer); lam = expf(wave_sum(a)) - expf(wave_sum(c)) + li; }
        const float li = 0.8f - 0.6f * expf(-0.3f * layer);
        float oc[2][2];
        for (int comp = 0; comp < 2; ++comp) {
            float q = bf2f(z[(rb + i) * ZP + h * 128 + comp * 64 + lane]);
            { const float qo = __shfl_xor(q, 32); const int j = lane & 31; const float c = tab64[((size_t)i * 32 + j) * 2], s = tab64[((size_t)i * 32 + j) * 2 + 1];
              q = lane < 32 ? q * c - qo * s : q * c + qo * s; }
            float m = -1e30f, l = 0.f, o0 = 0.f, o1 = 0.f;
            for (int k = 0; k < SEQ; ++k) {
                const float kk = bf2f(z[(rb + k) * ZP + 512 + h * 128 + comp * 64 + lane]);
                const float s = wave_sum(q * kk) * 0.125f;
                const float mn = fmaxf(m, s), al = __expf(m - mn), p = __expf(s - mn);
                l = l * al + p; o0 = o0 * al + p * bf2f(z[(rb + k) * ZP + 1024 + h * 128 + lane]); o1 = o1 * al + p * bf2f(z[(rb + k) * ZP + 1024 + h * 128 + 64 + lane]); m = mn;
            }
            oc[comp][0] = o0 / l; oc[comp][1] = o1 / l;
        }
        const float a0 = oc[0][0] - lam * oc[1][0], a1 = oc[0][1] - lam * oc[1][1];
        const float r = 1.0f / sqrtf(wave_sum(a0 * a0 + a1 * a1) * (1.0f / 128) + EPS);
        mix[(rb + i) * DM + h * 128 + lane] = f2bf(a0 * r * args.in[I_SUBLN][layer * 128 + lane] * (1.f - li));
        mix[(rb + i) * DM + h * 128 + 64 + lane] = f2bf(a1 * r * args.in[I_SUBLN][layer * 128 + 64 + lane] * (1.f - li));
    } else if constexpr (MODE == 1) {
        const float* rpb = args.in[I_RPB] + ((size_t)layer * 4 + h) * 15 * 31;
        const int r = i >> 6, c = i & 63, rs = min(max(r - 4, 0), 56), wsx = min(max(c - 8, 0), 48);
        const float q0 = bf2f(z[(rb + i) * ZP + O_NA + h * 128 + lane]), q1 = bf2f(z[(rb + i) * ZP + O_NA + h * 128 + 64 + lane]);
        float m = -1e30f, l = 0.f, o0 = 0.f, o1 = 0.f;
        for (int a = 0; a < 8; ++a) for (int cc = 0; cc < 16; ++cc) {
            const int kr = rs + a, kc = wsx + cc; const size_t kt = rb + kr * 64 + kc;
            const float s = wave_sum(q0 * bf2f(z[kt * ZP + O_NA + 512 + h * 128 + lane]) + q1 * bf2f(z[kt * ZP + O_NA + 512 + h * 128 + 64 + lane])) * 0.08838834764831845f + rpb[(kr - r + 7) * 31 + (kc - c + 15)];
            const float mn = fmaxf(m, s), al = __expf(m - mn), p = __expf(s - mn);
            l = l * al + p; o0 = o0 * al + p * bf2f(z[kt * ZP + O_NA + 1024 + h * 128 + lane]); o1 = o1 * al + p * bf2f(z[kt * ZP + O_NA + 1024 + h * 128 + 64 + lane]); m = mn;
        }
        mix[(rb + i) * DM + 512 + h * 128 + lane] = f2bf(o0 / l); mix[(rb + i) * DM + 512 + h * 128 + 64 + lane] = f2bf(o1 / l);
    } else if constexpr (MODE == 2) {
        const int kvh = h >> 1;
        float q0 = bf2f(z[(rb + i) * ZP + O_SWA + h * 128 + lane]), q1 = bf2f(z[(rb + i) * ZP + O_SWA + h * 128 + 64 + lane]);
        { const float c = tab128[((size_t)i * 64 + lane) * 2], s = tab128[((size_t)i * 64 + lane) * 2 + 1]; const float a = q0 * c - q1 * s, d = q1 * c + q0 * s; q0 = a; q1 = d; }
        float m = args.in[I_SINKS][layer * 4 + h], l = 1.f, o0 = 0.f, o1 = 0.f;
        for (int k = max(0, i - 128); k <= min(SEQ - 1, i + 128); ++k) {
            const size_t kt = rb + k;
            const float s = wave_sum(q0 * bf2f(z[kt * ZP + O_SWA + 512 + kvh * 128 + lane]) + q1 * bf2f(z[kt * ZP + O_SWA + 512 + kvh * 128 + 64 + lane])) * 0.08838834764831845f;
            const float mn = fmaxf(m, s), al = __expf(m - mn), p = __expf(s - mn);
            l = l * al + p; o0 = o0 * al + p * bf2f(z[kt * ZP + O_SWA + 768 + kvh * 128 + lane]); o1 = o1 * al + p * bf2f(z[kt * ZP + O_SWA + 768 + kvh * 128 + 64 + lane]); m = mn;
        }
        mix[(rb + i) * DM + 1024 + h * 128 + lane] = f2bf(o0 / l); mix[(rb + i) * DM + 1024 + h * 128 + 64 + lane] = f2bf(o1 / l);
    } else {
        const bf16_t* qm = (const bf16_t*)(ws + WS_QM); const bf16_t* kvm = (const bf16_t*)(ws + WS_KVM);
        const float q0 = bf2f(qm[(rb + i) * QMW + h * 192 + lane]), q1 = bf2f(qm[(rb + i) * QMW + h * 192 + 64 + lane]); float q2 = bf2f(qm[(rb + i) * QMW + h * 192 + 128 + lane]);
        { const float qo = __shfl_xor(q2, 32); const int j = lane & 31; const float c = tab64[((size_t)i * 32 + j) * 2], s = tab64[((size_t)i * 32 + j) * 2 + 1];
          q2 = lane < 32 ? q2 * c - qo * s : q2 * c + qo * s; }
        float m = -1e30f, l = 0.f, o0 = 0.f, o1 = 0.f;
        for (int k = 0; k < SEQ; ++k) {
            const size_t kt = rb + k;
            const float s = wave_sum(q0 * bf2f(kvm[kt * KVW + h * 256 + lane]) + q1 * bf2f(kvm[kt * KVW + h * 256 + 64 + lane]) + q2 * bf2f(z[kt * ZP + 5120 + lane])) * 0.07216878364870322f;
            const float mn = fmaxf(m, s), al = __expf(m - mn), p = __expf(s - mn);
            l = l * al + p; o0 = o0 * al + p * bf2f(kvm[kt * KVW + h * 256 + 128 + lane]); o1 = o1 * al + p * bf2f(kvm[kt * KVW + h * 256 + 192 + lane]); m = mn;
        }
        mix[(rb + i) * DM + 1536 + h * 128 + lane] = f2bf(o0 / l); mix[(rb + i) * DM + 1536 + h * 128 + 64 + lane] = f2bf(o1 / l);
    }
}
#endif

#define QUANT_ROWS(HSRC, SSP) do { const float* ssp = (SSP); \
    for (int m = gw; m < NTOK; m += NGW) { \
        const f32x4 pa_ = *(const f32x4*)(ssp + (size_t)m * 8), pb_ = *(const f32x4*)(ssp + (size_t)m * 8 + 4); \
        const float ri = 1.0f / sqrtf((((pa_[0] + pa_[1]) + (pa_[2] + pa_[3])) + ((pb_[0] + pb_[1]) + (pb_[2] + pb_[3]))) * (1.0f / DM) + EPS); \
        const u32x2* xr = (const u32x2*)((HSRC) + (size_t)m * DM) + lane; unsigned* hq = (unsigned*)(ws + WS_HQ8 + (size_t)m * DM) + lane; \
        u32x2 w_[8]; float am = 0.f; \
        _Pragma("unroll") for (int j = 0; j < 8; ++j) { w_[j] = xr[64 * j]; am = fmaxf(am, fmaxf(fmaxf(fabsf(bflo(w_[j].x)), fabsf(bfhi(w_[j].x))), fmaxf(fabsf(bflo(w_[j].y)), fabsf(bfhi(w_[j].y))))); } \
        am = fmaxf(wave_max(am), 1e-20f); const float sq_ = 127.0f / am; \
        if (lane == 0) TRINV[m] = am * ri * (1.0f / (127.0f * 1536.0f)); \
        _Pragma("unroll") for (int j = 0; j < 8; ++j) hq[64 * j] = pk4_i8(bflo(w_[j].x) * sq_, bfhi(w_[j].x) * sq_, bflo(w_[j].y) * sq_, bfhi(w_[j].y) * sq_); \
    } } while (0)
constexpr int PH_PER_LAYER = 12, N_PHASES = 1 + DEPTH * PH_PER_LAYER;

#define INP(i) ((const float*)(const GAS float*)args.in[opaque_idx(i)])
__device__ __forceinline__ int opaque_idx(int i) { asm volatile("" : "+s"(i)); return i; }
__global__ void __launch_bounds__(NTHR, 2) fwd(Args args) {
    extern __shared__ __attribute__((aligned(16))) unsigned char lds_raw[];
    for (int u = threadIdx.x; u < 1024; u += NTHR) ((LAS unsigned*)((LAS unsigned char*)lds_raw + MISC_OFF))[u] = 0u;
    __syncthreads();
#if MK_ONE_LAUNCH
    { (void)xcd_barrier_post((unsigned*)(args.ws + WS_CTL) + CW_BAR, (volatile LAS unsigned*)((LAS unsigned char*)lds_raw + MISC_OFF) + 8, threadIdx.x == 0); }
#define GRID_BAR() do { unsigned on_ = ~0u; asm volatile("" : "+s"(on_)); int l_ = __builtin_amdgcn_mbcnt_hi(on_, __builtin_amdgcn_mbcnt_lo(on_, 0u)); XcdBarrier b_; \
    unsigned long long wsb_ = (unsigned long long)args.ws; asm volatile("" : "+s"(wsb_)); b_.bar = (unsigned*)(GAS unsigned*)(wsb_ + WS_CTL) + CW_BAR; b_.x = xb_xcc_id(); \
    b_.st = (volatile LAS unsigned*)((LAS unsigned char*)lds_raw + MISC_OFF) + 8; xcd_barrier(b_, (l_ == 0) && (wave_s == 0)); } while (0)
#else
#define GRID_BAR() do {} while (0)
#endif
    const int wave_s = __builtin_amdgcn_readfirstlane((int)threadIdx.x >> 6);
    const int lo = args.ph_lo, hi = args.ph_hi;
#ifndef PH_MASK
#define PH_MASK 0xFFFFFFFFu
#endif
#define INREL(rel) ((PH_MASK >> (rel)) & 1u)
#ifndef PROBE_REP
#define PROBE_REP -1
#endif
#define NREP(rel) ((PROBE_REP) == (rel) ? 2 : 1)
#define IN(k) (lo <= (k) && (k) < hi)
#define SEAM(k) do { if (IN(k) && IN((k) + 1)) GRID_BAR(); } while (0)
#define PH_LOCALS \
    unsigned ones_o = ~0u; asm volatile("" : "+s"(ones_o)); \
    int lane_o = __builtin_amdgcn_mbcnt_hi(ones_o, __builtin_amdgcn_mbcnt_lo(ones_o, 0u)); asm volatile("" : "+v"(lane_o)); \
    int wave_o = wave_s; asm volatile("" : "+s"(wave_o)); const int tid_o = wave_o * 64 + lane_o; \
    unsigned long long ws_q = (unsigned long long)args.ws; asm volatile("" : "+s"(ws_q)); unsigned char* ws = (unsigned char*)(GAS unsigned char*)ws_q; \
    unsigned long long out_q = (unsigned long long)args.out; asm volatile("" : "+s"(out_q)); float* OUTP = (float*)(GAS float*)out_q; \
    Frame F; F.lds = (LAS unsigned char*)lds_raw; F.MISC = (volatile LAS unsigned*)(F.lds + MISC_OFF); \
    F.tid = tid_o; F.lane = lane_o; F.wave = wave_o; F.G = gridDim.x; \
    { const int bx = blockIdx.x; F.vcu = (F.G % 8 == 0) ? (bx % 8) * (F.G / 8) + bx / 8 : bx; } \
    const int gw = F.vcu * NWAVES + F.wave, NGW = F.G * NWAVES, lane = F.lane; \
    unsigned* ctl = (unsigned*)(ws + WS_CTL); \
    bf16_t* HN = (bf16_t*)(ws + WS_HN); bf16_t* Z = (bf16_t*)(ws + WS_Z); bf16_t* MIX = (bf16_t*)(ws + WS_MIX); \
    bf16_t* QM = (bf16_t*)(ws + WS_QM); bf16_t* KVM = (bf16_t*)(ws + WS_KVM); bf16_t* PPB = (bf16_t*)(ws + WS_PP); \
    bf16_t* ACT = (bf16_t*)(ws + WS_ACT); bf16_t* XG = (bf16_t*)(ws + WS_XG); bf16_t* HB2 = (bf16_t*)(ws + WS_HB2); (void)HB2; \
    float* tab64 = (float*)(ws + WS_TAB64); float* tab128 = (float*)(ws + WS_TAB128); \
    unsigned* MOEI = (unsigned*)(ws + WS_MOEI); float* SSH = (float*)(ws + WS_SSH); float* TRINV = (float*)(ws + WS_TRINV); float* SRINV = (float*)(ws + WS_SRINV); \
    LAS float* RED = (LAS float*)(F.lds + RED_OFF); (void)SSH; (void)TRINV; (void)SRINV; (void)RED; \
    (void)gw; (void)NGW; (void)lane; (void)ctl; (void)HN; (void)Z; (void)MIX; (void)QM; (void)KVM; (void)PPB; (void)ACT; (void)XG; (void)tab64; (void)tab128; (void)MOEI; (void)OUTP;

    for (int rep_ = 0; rep_ < NREP(31); ++rep_) if (INREL(31) && IN(0)) { PH_LOCALS
        LAS float* scr = (LAS float*)(F.lds + RING_OFF + F.wave * 16384);
        for (int it = gw; it < IT_TOTAL; it += NGW) {
            int r = it;
            if (r < 2 * IT_LAYER) {
                const int L = r / IT_LAYER; r -= L * IT_LAYER;
                if (r < IT_WIN) { transpose_job(INP(I_W_IN) + (size_t)L * DM * ZC, DM, ZC, (bf16_t*)(ws + WS_WIN + L * SZ_WIN), 3, r, scr, lane, INP(I_ATTN_NORM) + L * DM, -1536.f); continue; } r -= IT_WIN;
                if (r < IT_WUQ) { transpose_job(INP(I_WUQ) + (size_t)L * 512 * QMW, 512, QMW, (bf16_t*)(ws + WS_WUQ + L * SZ_WUQ), 0, r, scr, lane, INP(I_QNORM) + L * 512); continue; } r -= IT_WUQ;
                if (r < IT_WUKV) { transpose_job(INP(I_WUKV) + (size_t)L * 512 * KVW, 512, KVW, (bf16_t*)(ws + WS_WUKV + L * SZ_WUKV), 0, r, scr, lane, INP(I_KVNORM) + L * 512); continue; } r -= IT_WUKV;
                if (r < IT_SQ) { transpose_job(INP(I_WOUT) + (size_t)L * DM * DM, DM, DM, (bf16_t*)(ws + WS_WOUT + L * SZ_WSQ), 0, r, scr, lane); continue; } r -= IT_SQ;
                if (r < IT_SQ) { transpose_job(INP(I_PLE_GATE) + (size_t)L * DM * DM, DM, DM, (bf16_t*)(ws + WS_WPG + L * SZ_WSQ), 0, r, scr, lane, INP(I_PLE_NORM) + L * DM, (L & 1) ? 4096.f : -1536.f); continue; } r -= IT_SQ;
                transpose_job(INP(I_PLE_PROJ) + (size_t)L * PLE * DM, PLE, DM, (bf16_t*)(ws + WS_WPP + L * SZ_WPP), 0, r, scr, lane); continue;
            }
            r -= 2 * IT_LAYER;
            if (r < IT_FFN) { ffn_job(INP(I_DG), INP(I_DU), INP(I_DD), (bf16_t*)(ws + WS_DGU), (bf16_t*)(ws + WS_DDN), r, scr, lane, INP(I_FFN_NORM), false); continue; }
            r -= IT_FFN;
            { const int e = r / IT_FFN; r -= e * IT_FFN; const size_t eo = (size_t)e * DM * FF;
              ffn_job(INP(I_MG) + eo, INP(I_MU) + eo, INP(I_MD) + eo, (bf16_t*)(ws + WS_MGU + e * (SZ_GU / 2)), (bf16_t*)(ws + WS_MDN + e * (SZ_DN / 2)), r, scr, lane, INP(I_FFN_NORM) + DM, true); }
        }
        { const f32x4* src = (const f32x4*)INP(I_P); u32x2* dst = (u32x2*)(ws + WS_PBF); const size_t n4 = (size_t)2 * NTOK * PLE / 4;
          for (size_t i = (size_t)blockIdx.x * NTHR + F.tid; i < n4; i += (size_t)F.G * NTHR) { const f32x4 v = src[i]; u32x2 w; w.x = cvt_pk_bf16(v.x, v.y); w.y = cvt_pk_bf16(v.z, v.w); dst[i] = w; } }
        for (int i = blockIdx.x * NTHR + F.tid; i < SEQ * 96; i += F.G * NTHR) {
            const int pos = i / 96, j = i % 96; const bool t128 = j >= 32; const int jj = t128 ? j - 32 : j; const float dim = t128 ? 128.f : 64.f;
            const float inv = (float)exp2(-(double)(2 * jj) / (double)dim * 13.287712379549449);
            const float ang = (float)pos * inv; const double a = (double)ang; const double k = rint(a * 0.15915494309189535); const float r = (float)(a - k * 6.283185307179586);
            const float c = __cosf(r), s = __sinf(r);
            float* t = t128 ? tab128 + ((size_t)pos * 64 + jj) * 2 : tab64 + ((size_t)pos * 32 + jj) * 2; t[0] = c; t[1] = s;
        }
        for (int m = gw; m < NTOK; m += NGW) { const f32x4* xr = (const f32x4*)(INP(I_X) + (size_t)m * DM) + lane; f32x4 v[8];
#pragma unroll
            for (int j = 0; j < 8; ++j) v[j] = __builtin_nontemporal_load(&xr[64 * j]);
            row_hb_ss(v, HB2 + (size_t)m * DM, SSH + (size_t)m * 8, lane);
            { float s_ = 0.f, am = 0.f;
#pragma unroll
              for (int j = 0; j < 8; ++j) { s_ += (v[j].x * v[j].x + v[j].y * v[j].y) + (v[j].z * v[j].z + v[j].w * v[j].w); am = fmaxf(am, fmaxf(fmaxf(fabsf(v[j].x), fabsf(v[j].y)), fmaxf(fabsf(v[j].z), fabsf(v[j].w)))); }
              const float ri = 1.0f / sqrtf(wave_sum(s_) * (1.0f / DM) + EPS); am = fmaxf(wave_max(am), 1e-20f); const float sq_ = 127.0f / am;
              if (lane == 0) TRINV[m] = am * ri * (1.0f / (127.0f * 1536.0f));
              unsigned* hq = (unsigned*)(ws + WS_HQ8 + (size_t)m * DM) + lane;
#pragma unroll
              for (int j = 0; j < 8; ++j) hq[64 * j] = pk4_i8(v[j].x * sq_, v[j].y * sq_, v[j].z * sq_, v[j].w * sq_); } }
    }
    SEAM(0);

    for (int L = 0; L < DEPTH; ++L) {
        const int pb = 1 + L * PH_PER_LAYER;
        for (int rep_ = 0; rep_ < NREP(0); ++rep_) if (INREL(0) && IN(pb + 0)) { PH_LOCALS
            { pg8::SchedDense S; S.o.init(NTOK / 256, ZP / 256, F.G, (int)blockIdx.x); S.A = (const char*)(ws + (L == 0 ? WS_HQ8 : WS_XG8)); S.B = (const char*)(ws + WS_WIN + L * SZ_WIN); S.tA = (size_t)256 * DM; S.tB = (size_t)256 * DM;
              pg8::Epi<pg8::EPI_Z_I> E{Z, tab64, ZP, tab128, (float*)(ws + WS_SS), L == 0 ? TRINV : SSH + (size_t)(3 * L) * NTOK * 8, L == 0 ? 2 : 3, nullptr, nullptr, RED, L == 0 ? nullptr : SSH + (size_t)(3 * L - 1) * NTOK * 8};
              pg8::gemm_phase<pg8::Epi<pg8::EPI_Z_I>, pg8::SchedDense, 2>(F.lds + RING_OFF, F.tid, DM / 2, DM / 2, DM / 2, S, E); }
            if ((L & 1) == 0) {
              const int rem_ = ((NTOK / 256) * (ZP / 256)) % F.G; const bool sh_ = (rem_ > 0 && 2 * rem_ <= F.G);
              const int gpp = sh_ ? F.G - rem_ : F.G, cpp = sh_ ? ((int)blockIdx.x >= rem_ ? (int)blockIdx.x - rem_ : (1 << 24)) : (int)blockIdx.x;
              int gpp_s = gpp, cpp_s = cpp, kpp_s = PLE; asm volatile("" : "+s"(gpp_s), "+s"(cpp_s), "+s"(kpp_s));
              pg8::SchedDense S; S.o.init(NTOK / 256, DM / 256, gpp_s, cpp_s); S.A = (const char*)(ws + WS_PBF + (size_t)L * NTOK * PLE * 2); S.B = (const char*)(ws + WS_WPP + L * SZ_WPP); S.tA = (size_t)256 * PLE * 2; S.tB = (size_t)256 * PLE * 2;
              pg8::Epi<pg8::EPI_BF16> E{PPB, nullptr, DM, nullptr, nullptr, nullptr, 0, nullptr, nullptr, RED};
              pg8::gemm_phase(F.lds + RING_OFF, F.tid, PLE, PLE, kpp_s, S, E); }
        }
        SEAM(pb + 0);
        for (int rep_ = 0; rep_ < NREP(2); ++rep_) if (INREL(2) && IN(pb + 2)) { PH_LOCALS
            { pg8::SchedDense S; S.o.init(NTOK / 256, QMW / 256, F.G, (int)blockIdx.x); S.A = (const char*)(Z + O_MLA); S.B = (const char*)(ws + WS_WUQ + L * SZ_WUQ); S.tA = (size_t)256 * ZP * 2; S.tB = (size_t)256 * 512 * 2;
              pg8::Epi<pg8::EPI_SCALE> E{QM, nullptr, QMW, nullptr, (float*)(ws + WS_SS), nullptr, 0, nullptr, nullptr, RED};
              pg8::gemm_phase(F.lds + RING_OFF, F.tid, ZP, 512, 512, S, E); }
            { pg8::SchedDense S; S.o.init(NTOK / 256, KVW / 256, F.G, (int)blockIdx.x); S.A = (const char*)(Z + O_MLA + 512); S.B = (const char*)(ws + WS_WUKV + L * SZ_WUKV); S.tA = (size_t)256 * ZP * 2; S.tB = (size_t)256 * 512 * 2;
              pg8::Epi<pg8::EPI_SCALE> E{KVM, nullptr, KVW, nullptr, (float*)(ws + WS_SS) + 8, nullptr, 0, nullptr, nullptr, RED};
              pg8::gemm_phase(F.lds + RING_OFF, F.tid, ZP, 512, 512, S, E); }
        }
        SEAM(pb + 2);
#if !NAIVE_ATTN
#define ATT_LOCALS PH_LOCALS LAS unsigned char* al = F.lds + RING_OFF; const int tid = F.tid; const int r32 = lane & 31, hi = lane >> 5; (void)r32; (void)hi;
        for (int rep_ = 0; rep_ < NREP(3); ++rep_) if (INREL(3) && IN(pb + 3)) {
            { ATT_LOCALS
            for (int u = F.vcu; u < 256; u += F.G) {
                const int b = u >> 6, h = (u >> 4) & 3, qt = u & 15; const size_t rb = (size_t)b * SEQ, q0 = rb + qt * 256;
                att::Src S; S.q[0] = QM + q0 * QMW + h * 192; S.q[1] = S.q[0] + 64; S.q[2] = S.q[0] + 128; S.ldq = QMW;
                S.k[0] = KVM + rb * KVW + h * 256; S.k[1] = S.k[0] + 64; S.k[2] = Z + rb * ZP + 5120; S.ldk[0] = KVW; S.ldk[1] = KVW; S.ldk[2] = ZP; S.v = KVM + rb * KVW + h * 256 + 128; S.ldv = KVW;
                att::Par P; P.kt0 = 0; P.nkt = SEQ / 64; P.C = 0.07216878364870322f * 1.4426950408889634f; P.thr = 3.f / 0.07216878364870322f; P.rtab = tab64;       P.qpos0 = qt * 256; P.na_r0 = 0; P.na_krlo = 0;
                float m_reg = -1e30f, l_reg = 0.f; f32x16 o[4] = {};
                int tid_u = tid; asm volatile("" : "+v"(tid_u));
                att::attn_pass_pipe<3, 8, 2, 1, 0, 1>(al, tid_u, S, P, m_reg, l_reg, o);
                asm volatile("" : "+v"(tid_u));
                att::normalize(al, tid_u, l_reg, o);
                att::store_o(MIX + q0 * DM + 1536 + h * 128, DM, tid_u, o);
            }
            }
            { ATT_LOCALS
                const float li = 0.8f - 0.6f * __expf(-0.3f * (float)L);
                float lam; { const float a = INP(I_LQ1)[L * 64 + lane] * INP(I_LK1)[L * 64 + lane], c = INP(I_LQ2)[L * 64 + lane] * INP(I_LK2)[L * 64 + lane]; lam = __expf(wave_sum(a)) - __expf(wave_sum(c)) + li; }
                const float* subln = INP(I_SUBLN) + L * 128;
                for (int u = F.vcu; u < 256; u += F.G) {
                    const int b = u >> 6, h = (u >> 4) & 3, qt = u & 15; const size_t rb = (size_t)b * SEQ, q0 = rb + qt * 256;
                    att::Src S; S.ldq = ZP; S.ldk[0] = ZP; S.ldk[1] = ZP; S.ldk[2] = ZP; S.ldv = ZP; S.v = Z + rb * ZP + 1024 + h * 128;
                    att::Par P; P.kt0 = 0; P.nkt = SEQ / 64; P.C = 0.125f * 1.4426950408889634f; P.thr = 8.f / 0.125f; P.rtab = tab64; P.qpos0 = qt * 256; P.na_r0 = 0; P.na_krlo = 0;
                    LAS unsigned* stash = (LAS unsigned*)(al + (F.wave < 4 ? att::OFF_K + (F.wave >> 1) * att::KBUF + att::KPL + (F.wave & 1) * 8192 : att::OFF_QL + (F.wave - 4) * 8192)) + lane;
                    {
                        S.q[0] = Z + q0 * ZP + h * 128; S.q[1] = S.q[0]; S.q[2] = S.q[0]; S.k[0] = Z + rb * ZP + 512 + h * 128; S.k[1] = S.k[0]; S.k[2] = S.k[0];
                        float m_reg = -1e30f, l_reg = 0.f; f32x16 o[4] = {};
                        int tid_v = tid; asm volatile("" : "+v"(tid_v));
                        att::attn_pass_pipe<1, 0, 2, 2, 0>(al, tid_v, S, P, m_reg, l_reg, o);
                        asm volatile("" : "+v"(tid_v));
                        att::normalize(al, tid_v, l_reg, o);
#pragma unroll
                        for (int d = 0; d < 4; ++d)
#pragma unroll
                            for (int r = 0; r < 8; ++r) stash[(d * 8 + r) * 64] = cvt_pk_bf16(o[d][2 * r], o[d][2 * r + 1]);
                    }
                    S.q[0] = Z + q0 * ZP + h * 128 + 64; S.q[1] = S.q[0]; S.q[2] = S.q[0]; S.k[0] = Z + rb * ZP + 512 + h * 128 + 64; S.k[1] = S.k[0]; S.k[2] = S.k[0];
                    float m_reg = -1e30f, l_reg = 0.f; f32x16 o[4] = {};
                    P.thr = 3.f / 0.125f;
                    int tid_u = tid; asm volatile("" : "+v"(tid_u));
                    att::attn_pass_pipe<1, 0, 2, 2, 0, 1>(al, tid_u, S, P, m_reg, l_reg, o);
                    asm volatile("" : "+v"(tid_u));
                    att::normalize(al, tid_u, l_reg, o);
                    const float sg[4] = {subln[r32] * (1.f - li), subln[32 + r32] * (1.f - li), subln[64 + r32] * (1.f - li), subln[96 + r32] * (1.f - li)};
#pragma unroll
                    for (int r = 0; r < 16; ++r) {
                        float ss = 0.f;
#pragma unroll
                        for (int d = 0; d < 4; ++d) { const unsigned w1 = stash[(d * 8 + (r >> 1)) * 64]; const float o1 = (r & 1) ? bfhi(w1) : bflo(w1); const float v = o1 - lam * o[d][r]; o[d][r] = v; ss += v * v; }
                        ss += swz_xor<1>(ss); ss += swz_xor<2>(ss); ss += swz_xor<4>(ss); ss += swz_xor<8>(ss); ss += swz_xor<16>(ss);
                        const float rn = 1.0f / sqrtf(ss * (1.0f / 128) + EPS);
#pragma unroll
                        for (int d = 0; d < 4; ++d) o[d][r] = o[d][r] * rn * sg[d];
                    }
                    att::store_o(MIX + q0 * DM + h * 128, DM, tid_u, o);
                }
            }
            { ATT_LOCALS
            for (int u = F.vcu; u < 256; u += F.G) {
                const int b = u >> 6, h = (u >> 4) & 3, qt = u & 15, kvh = h >> 1; const size_t rb = (size_t)b * SEQ, q0 = rb + qt * 256;
                att::Src S; S.q[0] = Z + q0 * ZP + O_SWA + h * 128; S.q[1] = S.q[0] + 64; S.q[2] = S.q[0]; S.ldq = ZP;
                S.k[0] = Z + rb * ZP + O_SWA + 512 + kvh * 128; S.k[1] = S.k[0] + 64; S.k[2] = S.k[0]; S.ldk[0] = ZP; S.ldk[1] = ZP; S.ldk[2] = ZP; S.v = Z + rb * ZP + O_SWA + 768 + kvh * 128; S.ldv = ZP;
                const int klo = max(0, qt * 256 - 128), khi = min(SEQ, qt * 256 + 384);
                att::Par P; P.kt0 = klo; P.nkt = (khi - klo) / 64; P.C = 0.08838834764831845f * 1.4426950408889634f; P.thr = 8.f / 0.08838834764831845f; P.rtab = tab128; P.qpos0 = qt * 256; P.na_r0 = 0; P.na_krlo = 0;
                float m_reg = INP(I_SINKS)[L * 4 + h] * (1.0f / 0.08838834764831845f), l_reg = 1.f; f32x16 o[4] = {};
                att::attn_pass<2, 2, 0, 4>(al, tid, S, P, m_reg, l_reg, o);
                att::normalize(al, tid, l_reg, o);
                att::store_o(MIX + q0 * DM + 1024 + h * 128, DM, tid, o);
            }
            }
            { ATT_LOCALS
            for (int u = F.vcu; u < 256; u += F.G) {
                const int b = u >> 6, h = (u >> 4) & 3, qt = u & 15; const size_t rb = (size_t)b * SEQ, q0 = rb + qt * 256;
                { const float* rpb = INP(I_RPB) + ((size_t)L * 4 + h) * 465; LAS float* bt = (LAS float*)(al + att::OFF_BIAS);
                  if (tid < 465) bt[tid] = rpb[tid] * (1.0f / 0.08838834764831845f);
                  __syncthreads(); }
                att::Src S; S.q[0] = Z + q0 * ZP + O_NA + h * 128; S.q[1] = S.q[0] + 64; S.q[2] = S.q[0]; S.ldq = ZP;
                S.k[0] = Z + rb * ZP + O_NA + 512 + h * 128; S.k[1] = S.k[0] + 64; S.k[2] = S.k[0]; S.ldk[0] = ZP; S.ldk[1] = ZP; S.ldk[2] = ZP; S.v = Z + rb * ZP + O_NA + 1024 + h * 128; S.ldv = ZP;
                const int r0 = qt * 4, krlo = min(max(r0 - 4, 0), 56), krhi = min(max(r0 + 3 - 4, 0), 56) + 7;
                att::Par P; P.kt0 = krlo * 64; P.nkt = krhi - krlo + 1; P.C = 0.08838834764831845f * 1.4426950408889634f; P.thr = 8.f / 0.08838834764831845f; P.rtab = tab64; P.qpos0 = qt * 256; P.na_r0 = r0; P.na_krlo = krlo;
                float m_reg = -1e30f, l_reg = 0.f; f32x16 o[4] = {};
                att::attn_pass<2, 1, 0, 0>(al, tid, S, P, m_reg, l_reg, o);
                att::normalize(al, tid, l_reg, o);
                att::store_o(MIX + q0 * DM + 512 + h * 128, DM, tid, o);
                __syncthreads();
            }
            }
        }
#endif
        SEAM(pb + 3);
        for (int rep_ = 0; rep_ < NREP(4); ++rep_) if (INREL(4) && IN(pb + 4)) { PH_LOCALS
            pg8::SchedDense S; S.o.init(NTOK / 256, DM / 256, F.G, (int)blockIdx.x); S.A = (const char*)MIX; S.B = (const char*)(ws + WS_WOUT + L * SZ_WSQ); S.tA = (size_t)256 * DM * 2; S.tB = (size_t)256 * DM * 2;
            if ((L & 1) == 0) {
                pg8::Epi<pg8::EPI_RESID_Q> E{ws + WS_HQ8, HB2, DM, nullptr, nullptr, SSH + (size_t)(3 * L) * NTOK * 8, 1, HN, SSH + (size_t)(3 * L + 1) * NTOK * 8, RED};
                pg8::gemm_phase(F.lds + RING_OFF, F.tid, DM, DM, DM, S, E);
            } else {
            pg8::Epi<pg8::EPI_RESID> E{nullptr, HB2, DM, nullptr, nullptr, nullptr, 0, HN, SSH + (size_t)(3 * L + 1) * NTOK * 8, RED};
            pg8::gemm_phase(F.lds + RING_OFF, F.tid, DM, DM, DM, S, E);
            }
        }
        SEAM(pb + 4);
        for (int rep_ = 0; rep_ < NREP(5); ++rep_) if (INREL(5) && IN(pb + 5)) { PH_LOCALS
            const float* g = INP(I_FFN_NORM) + L * DM;
            if (L & 1) {
                const float* wr = INP(I_ROUTER) + (size_t)(L >> 1) * DM * NE;
                LAS f32x4* wrl = (LAS f32x4*)(F.lds + RING_OFF);
                for (int p = F.tid; p < DM * 2; p += NTHR) { const int c = p >> 1, hf = p & 1; wrl[((((c >> 8) * 4 + (c & 3)) * 2 + hf) << 6) + ((c & 255) >> 2)] = *(const f32x4*)(wr + (size_t)c * 8 + hf * 4); }
                __syncthreads();
                volatile LAS unsigned* lcnt = F.MISC + 16;
                volatile LAS unsigned* lbase = F.MISC + 32;
                volatile LAS unsigned* linfo = F.MISC + 64;
                for (int chunk = blockIdx.x; chunk < NTOK / 64; chunk += F.G) {
                    if (F.tid < 8) lcnt[F.tid] = 0u;
                    __syncthreads();
                    for (int rr = 0; rr < 8; ++rr) {
                        const int lr = F.wave * 8 + rr, m = chunk * 64 + lr;
                        float ri; f32x4 v[8];
                        { const u32x2* xr = (const u32x2*)(HN + (size_t)m * DM) + lane; float s_ = 0.f;
#pragma unroll
                          for (int j = 0; j < 8; ++j) { const u32x2 w_ = xr[64 * j]; v[j] = (f32x4){bflo(w_.x), bfhi(w_.x), bflo(w_.y), bfhi(w_.y)}; s_ += (v[j].x * v[j].x + v[j].y * v[j].y) + (v[j].z * v[j].z + v[j].w * v[j].w); }
                          ri = 1.0f / sqrtf(wave_sum(s_) * (1.0f / DM) + EPS);
#pragma unroll
                          for (int j = 0; j < 8; ++j) v[j] = v[j] * ri * ((const f32x4*)g)[64 * j + lane];
                          { float am = 0.f; f32x4 x[8];
#pragma unroll
                            for (int j = 0; j < 8; ++j) { const f32x4 gg = ((const f32x4*)g)[64 * j + lane]; x[j] = (f32x4){v[j].x / gg.x, v[j].y / gg.y, v[j].z / gg.z, v[j].w / gg.w};
                                am = fmaxf(am, fmaxf(fmaxf(fabsf(x[j].x), fabsf(x[j].y)), fmaxf(fabsf(x[j].z), fabsf(x[j].w)))); }
                            am = fmaxf(wave_max(am), 1e-20f); const float sq_ = 127.0f / am;
                            if (lane == 0) TRINV[m] = am * (1.0f / (127.0f * 1536.0f));
                            unsigned* hq = (unsigned*)(ws + WS_HQ8 + (size_t)m * DM) + lane;
#pragma unroll
                            for (int j = 0; j < 8; ++j) hq[64 * j] = pk4_i8(x[j].x * sq_, x[j].y * sq_, x[j].z * sq_, x[j].w * sq_); } }
                        float lg[8];
#pragma unroll
                        for (int e = 0; e < 8; ++e) lg[e] = 0.f;
#pragma unroll
                        for (int j = 0; j < 8; ++j)
#pragma unroll
                            for (int q = 0; q < 4; ++q) { const f32x4 w0 = wrl[(((j * 4 + q) * 2 + 0) << 6) + lane], w1 = wrl[(((j * 4 + q) * 2 + 1) << 6) + lane]; const float x = v[j][q];
                                lg[0] += x * w0.x; lg[1] += x * w0.y; lg[2] += x * w0.z; lg[3] += x * w0.w; lg[4] += x * w1.x; lg[5] += x * w1.y; lg[6] += x * w1.z; lg[7] += x * w1.w; }
#pragma unroll
                        for (int e = 0; e < 8; ++e) lg[e] = wave_sum(lg[e]);
                        int e0 = 0; float v0 = lg[0];
#pragma unroll
                        for (int e = 1; e < 8; ++e) if (lg[e] > v0) { v0 = lg[e]; e0 = e; }
                        int e1 = -1; float v1 = -3.0e38f;
#pragma unroll
                        for (int e = 0; e < 8; ++e) if (e != e0 && lg[e] > v1) { v1 = lg[e]; e1 = e; }
                        if (lane == 0) {
                            const float g1 = 1.0f / (1.0f + __expf(v0 - v1)), g0 = 1.0f - g1;
                            const unsigned p0 = atomicAdd((unsigned*)&lcnt[e0], 1u), p1 = atomicAdd((unsigned*)&lcnt[e1], 1u);
                            linfo[lr * 6 + 0] = (unsigned)e0; linfo[lr * 6 + 1] = (unsigned)e1; linfo[lr * 6 + 2] = p0; linfo[lr * 6 + 3] = p1; linfo[lr * 6 + 4] = __float_as_uint(g0); linfo[lr * 6 + 5] = __float_as_uint(g1);
                        }
                    }
                    __syncthreads();
                    if (F.tid < 8) lbase[F.tid] = __hip_atomic_fetch_add(ctl + CW_MOE_CNT + 64 * F.tid, lcnt[F.tid], __ATOMIC_RELAXED, __HIP_MEMORY_SCOPE_AGENT);
                    __syncthreads();
                    if (F.tid < 64) { const int m = chunk * 64 + F.tid; const unsigned e0 = linfo[F.tid * 6], e1 = linfo[F.tid * 6 + 1];
                        unsigned* o = MOEI + (size_t)m * 8; o[0] = e0; o[1] = e1; o[2] = lbase[e0] + linfo[F.tid * 6 + 2]; o[3] = lbase[e1] + linfo[F.tid * 6 + 3]; o[4] = linfo[F.tid * 6 + 4]; o[5] = linfo[F.tid * 6 + 5]; }
                    __syncthreads();
                }
            }
        }
        if (L & 1) SEAM(pb + 5);
        for (int rep_ = 0; rep_ < NREP(6); ++rep_) if (INREL(6) && IN(pb + 6) && (L & 1)) { PH_LOCALS
            volatile LAS unsigned* tstart = F.MISC + 48;
            if (F.tid == 0) { unsigned acc = 0;
                for (int e = 0; e < 8; ++e) { tstart[e] = acc; const unsigned c = __hip_atomic_load(ctl + CW_MOE_CNT + 64 * e, __ATOMIC_RELAXED, __HIP_MEMORY_SCOPE_AGENT); acc += (c + 255u) >> 8; }
                tstart[8] = acc;
                if (blockIdx.x == 0) ctl[CW_MOE_TILES] = acc; }
            __syncthreads();
            if (blockIdx.x == 0 && F.tid < MOE_MAXT) { unsigned e = 0;
#pragma unroll
                for (int q = 1; q < 8; ++q) e += ((unsigned)F.tid >= tstart[q]) ? 1u : 0u;
                ctl[CW_MOE_TILES + 64 + F.tid] = e; }
            unsigned* STOK = (unsigned*)(ws + WS_STOK);
            for (int a = (int)blockIdx.x * NTHR + F.tid; a < NTOK * 2; a += F.G * NTHR) {
                const int m = a >> 1, k = a & 1; unsigned* inf = MOEI + (size_t)m * 8; const unsigned e = inf[k], pos = inf[2 + k]; const unsigned slot = tstart[e] * 256u + pos;
                inf[6 + k] = slot; STOK[slot] = (unsigned)m; SRINV[slot] = TRINV[m];
            }
            { unsigned char* XG8 = (unsigned char*)(ws + WS_XG8);
              for (int a = gw; a < NTOK * 2; a += NGW) { const int m = a >> 1, k = a & 1; const unsigned* inf = MOEI + (size_t)m * 8; const unsigned slot = tstart[inf[k]] * 256u + inf[2 + k];
                  const u32x4* src = (const u32x4*)(ws + WS_HQ8 + (size_t)m * DM) + lane; u32x4* dst = (u32x4*)(XG8 + (size_t)slot * DM) + lane;
                  dst[0] = src[0]; dst[64] = src[64]; } }
            if (blockIdx.x == 0) {
                for (int e = 0; e < 8; ++e) { const unsigned c = __hip_atomic_load(ctl + CW_MOE_CNT + 64 * e, __ATOMIC_RELAXED, __HIP_MEMORY_SCOPE_AGENT);
                    for (unsigned sl = tstart[e] * 256u + c + (unsigned)F.tid; sl < tstart[e + 1] * 256u; sl += NTHR) { STOK[sl] = 0u; SRINV[sl] = 0.f; } }
            }
        }
        if (L & 1) SEAM(pb + 6);
        for (int rep_ = 0; rep_ < NREP(7); ++rep_) if (INREL(7) && IN(pb + 7)) { PH_LOCALS
            if ((L & 1) == 0) {
                pg8::SchedDense S; S.o.init(NTOK / 256, 2 * FF / 256, F.G, (int)blockIdx.x); S.A = (const char*)(ws + WS_HQ8); S.B = (const char*)(ws + WS_DGU); S.tA = (size_t)256 * DM; S.tB = (size_t)256 * DM;
                pg8::Epi<pg8::EPI_SWIGLU_I> E{ACT, nullptr, FF, nullptr, nullptr, SSH + (size_t)(3 * L + 1) * NTOK * 8, 3, nullptr, nullptr, RED, SSH + (size_t)(3 * L) * NTOK * 8};
                pg8::gemm_phase<pg8::Epi<pg8::EPI_SWIGLU_I>, pg8::SchedDense, 2>(F.lds + RING_OFF, F.tid, DM / 2, DM / 2, DM / 2, S, E);
            } else {
                const int nT = __builtin_amdgcn_readfirstlane((int)__hip_atomic_load(ctl + CW_MOE_TILES, __ATOMIC_RELAXED, __HIP_MEMORY_SCOPE_AGENT));
                pg8::SchedMoe S; S.o.init(nT, 2 * FF / 256, F.G, (int)blockIdx.x); S.A = (const char*)(ws + WS_XG8); S.B = (const char*)(ws + WS_MGU); S.tA = (size_t)256 * DM; S.tB = (size_t)256 * DM; S.tE = SZ_GU / 2; S.tile_expert = ctl + CW_MOE_TILES + 64;
                pg8::Epi<pg8::EPI_SWIGLU8_I> E{ACT, nullptr, FF, nullptr, nullptr, SRINV, 2, nullptr, nullptr, RED};
                pg8::gemm_phase<pg8::Epi<pg8::EPI_SWIGLU8_I>, pg8::SchedMoe, 2>(F.lds + RING_OFF, F.tid, DM / 2, DM / 2, DM / 2, S, E);
            }
        }
        SEAM(pb + 7);
        for (int rep_ = 0; rep_ < NREP(8); ++rep_) if (INREL(8) && IN(pb + 8)) { PH_LOCALS
            if ((L & 1) == 0) {
                pg8::SchedDense S; S.o.init(NTOK / 256, DM / 256, F.G, (int)blockIdx.x); S.A = (const char*)ACT; S.B = (const char*)(ws + WS_DDN); S.tA = (size_t)256 * FF * 2; S.tB = (size_t)256 * FF * 2;
                pg8::Epi<pg8::EPI_RESID_Q> E{ws + WS_HQ8, HN, DM, nullptr, nullptr, SSH + (size_t)(3 * L + 1) * NTOK * 8, 1, HN, SSH + (size_t)(3 * L + 2) * NTOK * 8, RED};
                pg8::gemm_phase(F.lds + RING_OFF, F.tid, FF, FF, FF, S, E);
            } else {
                const int nT = __builtin_amdgcn_readfirstlane((int)__hip_atomic_load(ctl + CW_MOE_TILES, __ATOMIC_RELAXED, __HIP_MEMORY_SCOPE_AGENT));
                pg8::SchedMoe S; S.o.init(nT, DM / 256, F.G, (int)blockIdx.x); S.A = (const char*)ACT; S.B = (const char*)(ws + WS_MDN); S.tA = (size_t)256 * FF; S.tB = (size_t)256 * FF; S.tE = SZ_DN / 2; S.tile_expert = ctl + CW_MOE_TILES + 64;
                pg8::Epi<pg8::EPI_BF16S> E{XG, nullptr, DM, nullptr, nullptr, nullptr, 0, nullptr, nullptr, RED};
                pg8::gemm_phase<pg8::Epi<pg8::EPI_BF16S>, pg8::SchedMoe, 1>(F.lds + RING_OFF, F.tid, FF / 2, FF / 2, FF / 2, S, E);
            }
        }
        for (int rep_ = 0; rep_ < NREP(8); ++rep_) if (INREL(8) && IN(pb + 8) && (L & 1)) { PH_LOCALS
            const int nT = __builtin_amdgcn_readfirstlane((int)__hip_atomic_load(ctl + CW_MOE_TILES, __ATOMIC_RELAXED, __HIP_MEMORY_SCOPE_AGENT));
                { const int rem_ = (nT * (DM / 256)) % F.G; const bool sh_ = (rem_ > 0 && 2 * rem_ <= F.G);
                  const int gpp = sh_ ? F.G - rem_ : F.G, cpp = sh_ ? ((int)blockIdx.x >= rem_ ? (int)blockIdx.x - rem_ : (1 << 24)) : (int)blockIdx.x;
                  int gpp_s = gpp, cpp_s = cpp, kpp_s = PLE; asm volatile("" : "+s"(gpp_s), "+s"(cpp_s), "+s"(kpp_s));
                  pg8::SchedDense S2; S2.o.init(NTOK / 256, DM / 256, gpp_s, cpp_s); S2.A = (const char*)(ws + WS_PBF + (size_t)L * NTOK * PLE * 2); S2.B = (const char*)(ws + WS_WPP + L * SZ_WPP); S2.tA = (size_t)256 * PLE * 2; S2.tB = (size_t)256 * PLE * 2;
                  pg8::Epi<pg8::EPI_BF16> E2{PPB, nullptr, DM, nullptr, nullptr, nullptr, 0, nullptr, nullptr, RED};
                  pg8::gemm_phase(F.lds + RING_OFF, F.tid, PLE, PLE, kpp_s, S2, E2); }
        }
        SEAM(pb + 8);
        for (int rep_ = 0; rep_ < NREP(9); ++rep_) if (INREL(9) && IN(pb + 9) && (L & 1)) { PH_LOCALS
            for (int m = gw; m < NTOK; m += NGW) {
                const unsigned* inf = MOEI + (size_t)m * 8; const float g0 = __uint_as_float(inf[4]), g1 = __uint_as_float(inf[5]);
                const u32x2* y0 = (const u32x2*)(XG + (size_t)inf[6] * DM) + lane; const u32x2* y1 = (const u32x2*)(XG + (size_t)inf[7] * DM) + lane;
                const u32x2* hp = (const u32x2*)(HN + (size_t)m * DM) + lane; f32x4 v[8];
#pragma unroll
                for (int j = 0; j < 8; ++j) { const u32x2 hw = hp[64 * j], a = y0[64 * j], b = y1[64 * j];
                    f32x4 h = {bflo(hw.x), bfhi(hw.x), bflo(hw.y), bfhi(hw.y)};
                    h.x += g0 * bflo(a.x) + g1 * bflo(b.x); h.y += g0 * bfhi(a.x) + g1 * bfhi(b.x); h.z += g0 * bflo(a.y) + g1 * bflo(b.y); h.w += g0 * bfhi(a.y) + g1 * bfhi(b.y); v[j] = h; }
                row_hb_ss(v, HN + (size_t)m * DM, SSH + ((size_t)(3 * L + 2) * NTOK + m) * 8, lane);
                { float s_ = 0.f;
#pragma unroll
                  for (int j = 0; j < 8; ++j) s_ += (v[j].x * v[j].x + v[j].y * v[j].y) + (v[j].z * v[j].z + v[j].w * v[j].w);
                  const float ri = 64.0f / sqrtf(wave_sum(s_) * (1.0f / DM) + EPS); unsigned* hq = (unsigned*)(ws + WS_HQ8 + (size_t)m * DM) + lane;
#pragma unroll
                  for (int j = 0; j < 8; ++j) hq[64 * j] = pk4_fp8(v[j].x * ri, v[j].y * ri, v[j].z * ri, v[j].w * ri); }
            }
        }
        if (L & 1) SEAM(pb + 9);
        for (int rep_ = 0; rep_ < NREP(10); ++rep_) if (INREL(10) && IN(pb + 10)) { PH_LOCALS
            if (L & 1) {
                pg8::SchedDense S; S.o.init(NTOK / 256, DM / 256, F.G, (int)blockIdx.x); S.A = (const char*)(ws + WS_HQ8); S.B = (const char*)(ws + WS_WPG + L * SZ_WSQ); S.tA = (size_t)256 * DM; S.tB = (size_t)256 * DM;
                pg8::Epi<pg8::EPI_PLE8> E{nullptr, PPB, DM, HN, nullptr, nullptr, 0, HB2, (L + 1 < DEPTH) ? SSH + (size_t)(3 * (L + 1)) * NTOK * 8 : nullptr, RED};
                pg8::gemm_phase<pg8::Epi<pg8::EPI_PLE8>, pg8::SchedDense, 1>(F.lds + RING_OFF, F.tid, DM / 2, DM / 2, DM / 2, S, E);
            } else {
            pg8::SchedDense S; S.o.init(NTOK / 256, DM / 256, F.G, (int)blockIdx.x); S.A = (const char*)(ws + WS_HQ8); S.B = (const char*)(ws + WS_WPG + L * SZ_WSQ); S.tA = (size_t)256 * DM; S.tB = (size_t)256 * DM;
            pg8::Epi<pg8::EPI_PLE_I> E{(L + 1 < DEPTH) ? ws + WS_XG8 : nullptr, PPB, DM, HN, nullptr, SSH + (size_t)(3 * L + 2) * NTOK * 8, 1, HB2, (L + 1 < DEPTH) ? SSH + (size_t)(3 * (L + 1)) * NTOK * 8 : nullptr, RED, SSH + (size_t)(3 * L + 1) * NTOK * 8};
            pg8::gemm_phase<pg8::Epi<pg8::EPI_PLE_I>, pg8::SchedDense, 2>(F.lds + RING_OFF, F.tid, DM / 2, DM / 2, DM / 2, S, E);
            }
        }
        SEAM(pb + 10);
        for (int rep_ = 0; rep_ < NREP(11); ++rep_) if (INREL(11) && IN(pb + 11) && (L + 1 == DEPTH)) { PH_LOCALS
            const float* g = INP(I_FINAL_NORM);
            for (int m = gw; m < NTOK; m += NGW) { f32x4* hp = (f32x4*)(OUTP + (size_t)m * DM) + lane; const u32x2* hb = (const u32x2*)(HB2 + (size_t)m * DM) + lane; f32x4 v[8]; float s = 0.f;
#pragma unroll
                for (int j = 0; j < 8; ++j) { const u32x2 w_ = hb[64 * j]; v[j] = (f32x4){bflo(w_.x), bfhi(w_.x), bflo(w_.y), bfhi(w_.y)}; s += (v[j].x * v[j].x + v[j].y * v[j].y) + (v[j].z * v[j].z + v[j].w * v[j].w); }
                const float ri = 1.0f / sqrtf(wave_sum(s) * (1.0f / DM) + EPS);
#pragma unroll
                for (int j = 0; j < 8; ++j) __builtin_nontemporal_store(v[j] * ri * ((const f32x4*)g)[64 * j + lane], &hp[64 * j]); }
        }
    }
#undef IN
#undef SEAM
}

extern "C" void kernel_launch(void* const* d_in, const int* in_sizes, int n_in, void* d_out, int out_size, void* d_ws, size_t ws_size, hipStream_t stream) {
    static int grid = 0;
    if (grid == 0) {
        if (n_in != N_IN || out_size != NTOK * DM || ws_size < WS_END) { fprintf(stderr, "kernel_launch: shape/ws mismatch: n_in %d out %d ws %zu need %zu\n", n_in, out_size, ws_size, (size_t)WS_END); grid = -1; return; }
        int dev = 0, cus = 0, per_cu = 0;
        if (hipGetDevice(&dev) != hipSuccess || hipDeviceGetAttribute(&cus, hipDeviceAttributeMultiprocessorCount, dev) != hipSuccess) { grid = -1; return; }
        if (hipFuncSetAttribute((const void*)fwd, hipFuncAttributeMaxDynamicSharedMemorySize, LDS_BYTES) != hipSuccess) { fprintf(stderr, "hipFuncSetAttribute failed\n"); grid = -1; return; }
        if (hipOccupancyMaxActiveBlocksPerMultiprocessor(&per_cu, (const void*)fwd, NTHR, LDS_BYTES) != hipSuccess || per_cu < 1) { fprintf(stderr, "occupancy query: %d\n", per_cu); }
        (void)hipGetLastError();
        grid = cus;
    }
    if (grid < 0) return;
    (void)hipMemsetAsync((char*)d_ws + WS_CTL, 0, CTL_ZERO_BYTES, stream);
    Args a; memset(&a, 0, sizeof(a));
    for (int i = 0; i < N_IN; ++i) a.in[i] = (const float*)d_in[i];
    a.out = (float*)d_out; a.ws = (unsigned char*)d_ws;
#if MK_ONE_LAUNCH
    a.ph_lo = 0; a.ph_hi = N_PHASES;
    hipLaunchKernelGGL(fwd, dim3(grid), dim3(NTHR), LDS_BYTES, stream, a);
#else
    for (int ph = 0; ph < N_PHASES; ++ph) {
        const int rel = ph == 0 ? -1 : (ph - 1) % PH_PER_LAYER, L = ph == 0 ? 0 : (ph - 1) / PH_PER_LAYER;
        if (rel == 3) {
#if NAIVE_ATTN
            hipLaunchKernelGGL(naive_attn<0>, dim3(NB * 4 * SEQ / 4), dim3(256), 0, stream, a, L);
            hipLaunchKernelGGL(naive_attn<1>, dim3(NB * 4 * SEQ / 4), dim3(256), 0, stream, a, L);
            hipLaunchKernelGGL(naive_attn<2>, dim3(NB * 4 * SEQ / 4), dim3(256), 0, stream, a, L);
            hipLaunchKernelGGL(naive_attn<3>, dim3(NB * 4 * SEQ / 4), dim3(256), 0, stream, a, L);
            continue;
#endif
        }
        if (rel == 6 && !(L & 1)) continue;
        a.ph_lo = ph; a.ph_hi = ph + 1;
        hipLaunchKernelGGL(fwd, dim3(grid), dim3(NTHR), LDS_BYTES, stream, a);
    }
#endif
    const hipError_t le = hipPeekAtLastError();
    if (le != hipSuccess) fprintf(stderr, "kernel_launch: launch failed: %s\n", hipGetErrorName(le));
}
```

```cpp
#include <hip/hip_runtime.h>
#include <cstdio>
#include <cstdint>
#include <cstring>

#ifndef MK_ONE_LAUNCH
#define MK_ONE_LAUNCH 1
#endif
#ifndef NAIVE_ATTN
#define NAIVE_ATTN 0
#endif

#define LAS __attribute__((address_space(3)))
#define GAS __attribute__((address_space(1)))
typedef unsigned short bf16_t;
typedef short bf16x8 __attribute__((ext_vector_type(8)));
typedef short s16x4 __attribute__((ext_vector_type(4)));
typedef float f32x4 __attribute__((ext_vector_type(4)));
typedef float f32x2 __attribute__((ext_vector_type(2)));
typedef float f32x16 __attribute__((ext_vector_type(16)));
typedef unsigned u32x4 __attribute__((ext_vector_type(4)));
typedef unsigned u32x2 __attribute__((ext_vector_type(2)));

constexpr int NB = 4, SEQ = 4096, DM = 2048, NTOK = NB * SEQ, DEPTH = 2;
constexpr int ZC = 5184, ZP = 5376, FF = 7168, NE = 8, PLE = 256;
constexpr int O_NA = 1536, O_SWA = 3072, O_MLA = 4096;
constexpr int QMW = 768, KVW = 1024;
constexpr float EPS = 1e-6f;
constexpr int MOE_MAXT = 136;
constexpr int NWAVES = 8, NTHR = 512;

enum { I_X = 0, I_P, I_ATTN_NORM, I_W_IN, I_LQ1, I_LK1, I_LQ2, I_LK2, I_SUBLN, I_RPB, I_SINKS, I_QNORM, I_KVNORM, I_WUQ, I_WUKV, I_WOUT,
       I_FFN_NORM, I_DG, I_DU, I_DD, I_ROUTER, I_MG, I_MU, I_MD, I_PLE_NORM, I_PLE_GATE, I_PLE_PROJ, I_FINAL_NORM, N_IN };

constexpr size_t MiB = 1u << 20;
constexpr size_t WS_CTL = 0, CTL_ZERO_BYTES = 2 * MiB;
constexpr size_t WS_SS = 1 * MiB;
constexpr size_t SZ_WIN = (size_t)ZP * DM * 2, SZ_WUQ = (size_t)QMW * 512 * 2, SZ_WUKV = (size_t)KVW * 512 * 2, SZ_WSQ = (size_t)DM * DM * 2, SZ_WPP = (size_t)DM * PLE * 2;
constexpr size_t SZ_GU = (size_t)2 * FF * DM * 2, SZ_DN = (size_t)DM * FF * 2;
constexpr size_t WS_WIN = 2 * MiB;
constexpr size_t WS_WUQ = WS_WIN + 2 * SZ_WIN;
constexpr size_t WS_WUKV = WS_WUQ + 2 * SZ_WUQ;
constexpr size_t WS_WOUT = WS_WUKV + 2 * SZ_WUKV;
constexpr size_t WS_WPG = WS_WOUT + 2 * SZ_WSQ;
constexpr size_t WS_WPP = WS_WPG + 2 * SZ_WSQ;
constexpr size_t WS_DGU = WS_WPP + 2 * SZ_WPP;
constexpr size_t WS_DDN = WS_DGU + SZ_GU;
constexpr size_t WS_MGU = WS_DDN + SZ_DN;
constexpr size_t WS_MDN = WS_MGU + NE * SZ_GU;
constexpr size_t WS_TAB64 = WS_MDN + NE * SZ_DN;
constexpr size_t WS_TAB128 = WS_TAB64 + (size_t)SEQ * 32 * 2 * 4;
constexpr size_t WS_MOEI = WS_TAB128 + (size_t)SEQ * 64 * 2 * 4;
constexpr size_t WS_SSH = WS_MOEI + (size_t)NTOK * 8 * 4;
constexpr size_t WS_TRINV = WS_SSH + (size_t)6 * NTOK * 8 * 4;
constexpr size_t WS_SRINV = WS_TRINV + (size_t)NTOK * 4;
constexpr size_t WS_STOK = WS_SRINV + (size_t)MOE_MAXT * 256 * 4;
constexpr size_t WS_HN = WS_STOK + (size_t)MOE_MAXT * 256 * 4;
constexpr size_t WS_PBF = WS_HN + (size_t)NTOK * DM * 2;
constexpr size_t WS_PP = WS_PBF + (size_t)2 * NTOK * PLE * 2;
constexpr size_t WS_ARENA = WS_PP + (size_t)NTOK * DM * 2;
constexpr size_t WS_Z = WS_ARENA;
constexpr size_t WS_QM = WS_Z + (size_t)NTOK * ZP * 2;
constexpr size_t WS_KVM = WS_QM + (size_t)NTOK * QMW * 2;
constexpr size_t WS_MIX = WS_KVM + (size_t)NTOK * KVW * 2;
constexpr size_t WS_ATT_END = WS_MIX + (size_t)NTOK * DM * 2;
constexpr size_t WS_ACT = WS_ARENA;
constexpr size_t WS_XG = WS_ACT + (size_t)MOE_MAXT * 256 * FF * 2;
constexpr size_t WS_HB2 = WS_XG + (size_t)MOE_MAXT * 256 * DM * 2;
constexpr size_t WS_HQ8 = WS_HB2 + (size_t)NTOK * DM * 2;
constexpr size_t WS_XG8 = WS_HQ8 + (size_t)NTOK * DM;
constexpr size_t WS_END = WS_XG8 + (size_t)MOE_MAXT * 256 * DM;
static_assert(WS_ATT_END <= WS_END, "arena");
static_assert(WS_WIN % 256 == 0 && WS_HN % 256 == 0 && WS_Z % 256 == 0 && WS_XG % 256 == 0 && WS_MOEI % 256 == 0 && WS_SSH % 256 == 0 && WS_TRINV % 256 == 0 && WS_SRINV % 256 == 0 && WS_STOK % 256 == 0, "align");

constexpr int CW_BAR = 1024;
constexpr int CW_MOE_CNT = 8192;
constexpr int CW_MOE_TILES = 8192 + 1024;

__device__ __forceinline__ unsigned cvt_pk_bf16(float lo, float hi) { unsigned r; asm volatile("v_cvt_pk_bf16_f32 %0, %1, %2" : "=v"(r) : "v"(lo), "v"(hi)); return r; }
__device__ __forceinline__ float bf2f(bf16_t v) { return __uint_as_float((unsigned)v << 16); }
__device__ __forceinline__ float bflo(unsigned w) { return __uint_as_float(w << 16); }
__device__ __forceinline__ float bfhi(unsigned w) { return __uint_as_float(w & 0xffff0000u); }
__device__ __forceinline__ bf16_t f2bf(float f) { return (bf16_t)(cvt_pk_bf16(f, 0.f) & 0xffffu); }
template <int M> __device__ __forceinline__ float swz_xor(float v) { return __int_as_float(__builtin_amdgcn_ds_swizzle(__float_as_int(v), (M << 10) | 0x1f)); }
__device__ __forceinline__ float xsum32(float v) { auto r = __builtin_amdgcn_permlane32_swap(__float_as_uint(v), __float_as_uint(v), false, false); return __uint_as_float(r[0]) + __uint_as_float(r[1]); }
__device__ __forceinline__ float xsum16(float v) { return v + swz_xor<16>(v); }
__device__ __forceinline__ float wave_max(float v) {
    v = fmaxf(v, swz_xor<1>(v)); v = fmaxf(v, swz_xor<2>(v)); v = fmaxf(v, swz_xor<4>(v)); v = fmaxf(v, swz_xor<8>(v)); v = fmaxf(v, swz_xor<16>(v));
    auto r = __builtin_amdgcn_permlane32_swap(__float_as_uint(v), __float_as_uint(v), false, false); return fmaxf(__uint_as_float(r[0]), __uint_as_float(r[1]));
}
__device__ __forceinline__ float wave_sum(float v) {
    v += swz_xor<1>(v); v += swz_xor<2>(v); v += swz_xor<4>(v); v += swz_xor<8>(v); v += swz_xor<16>(v);
    return xsum32(v);
}
__device__ __forceinline__ unsigned pk4_fp8(float a, float b, float c, float d) {
    a = __builtin_amdgcn_fmed3f(a, -448.f, 448.f); b = __builtin_amdgcn_fmed3f(b, -448.f, 448.f); c = __builtin_amdgcn_fmed3f(c, -448.f, 448.f); d = __builtin_amdgcn_fmed3f(d, -448.f, 448.f);
    int w = __builtin_amdgcn_cvt_pk_fp8_f32(a, b, 0, false); w = __builtin_amdgcn_cvt_pk_fp8_f32(c, d, w, true); return (unsigned)w; }
__device__ __forceinline__ unsigned pk4_i8(float a, float b, float c, float d) {
    const int ia = (int)rintf(__builtin_amdgcn_fmed3f(a, -127.f, 127.f)), ib = (int)rintf(__builtin_amdgcn_fmed3f(b, -127.f, 127.f));
    const int ic = (int)rintf(__builtin_amdgcn_fmed3f(c, -127.f, 127.f)), id = (int)rintf(__builtin_amdgcn_fmed3f(d, -127.f, 127.f));
    return (unsigned)(ia & 255) | ((unsigned)(ib & 255) << 8) | ((unsigned)(ic & 255) << 16) | ((unsigned)id << 24); }
#define LDS_WAIT() asm volatile("s_waitcnt lgkmcnt(0)" ::: "memory")
#define VM_WAIT() asm volatile("s_waitcnt vmcnt(0)" ::: "memory")

namespace pg8 {
constexpr int BM = 256, BK = 64, HALF = 128, HTB = HALF * BK * 2, STAGE_BYTES = 8 * HTB, NXCD = 8, WGM = 8;
__host__ __device__ __forceinline__ int lds_byte(int r, int c) { const int st = (r >> 4) * 2 + (c >> 5), rr = r & 15, cc = c & 31, ob = rr * 64 + cc * 2; return st * 1024 + (ob ^ (((ob >> 9) & 1) << 5)); }
__host__ __device__ __forceinline__ void stage_rc(int b, int& R, int& C) { const int st = b / 1024, sb = b % 1024, swz = sb ^ (((sb >> 9) & 1) << 5); R = (st >> 1) * 16 + swz / 64; C = (st & 1) * 32 + (swz % 64) / 2; }
__host__ __device__ __forceinline__ int perm32(int rho) { const int n = rho >> 4, i = rho & 15; return 8 * (i >> 2) + 4 * n + (i & 3); }
struct Unit { int pm, pn; };
struct StaticOrder {
    int nM, nN, nwg, G, c;
    __device__ void init(int nM_, int nN_, int G_, int c_) { nM = nM_; nN = nN_; nwg = nM * nN; G = G_; c = c_; }
    __device__ bool next(int i, Unit& u) const {
        const long L = (long)i * G + c; if (L >= nwg) return false;
        int wgid = (int)L; { const int q = nwg / NXCD, r = nwg % NXCD, xcd = wgid % NXCD, off = wgid / NXCD; wgid = (xcd < r ? xcd * (q + 1) : r * (q + 1) + (xcd - r) * q) + off; }
        const int nig = WGM * nN, gid = wgid / nig, fm = gid * WGM, gsz = (nM - fm) < WGM ? (nM - fm) : WGM;
        u.pm = fm + ((wgid % nig) % gsz); u.pn = (wgid % nig) / gsz; return true;
    }
};
struct SchedDense {
    StaticOrder o; const char* A; const char* B; size_t tA, tB;
    __device__ __forceinline__ bool next(int i, Unit& u) const { return o.next(i, u); }
    __device__ __forceinline__ const char* aptr(const Unit& u) const { return A + (size_t)u.pm * tA; }
    __device__ __forceinline__ const char* bptr(const Unit& u) const { return B + (size_t)u.pn * tB; }
    static constexpr bool GATHER = false;
    __device__ __forceinline__ unsigned rowtok(const Unit&, int) const { return 0u; }
};
struct SchedMoe {
    StaticOrder o; const char* A; const char* B; size_t tA, tB, tE; const unsigned* tile_expert;
    __device__ __forceinline__ bool next(int i, Unit& u) const { return o.next(i, u); }
    __device__ __forceinline__ const char* aptr(const Unit& u) const { return A + (size_t)u.pm * tA; }
    __device__ __forceinline__ const char* bptr(const Unit& u) const { return B + (size_t)__builtin_amdgcn_readfirstlane((int)tile_expert[u.pm]) * tE + (size_t)u.pn * tB; }
    static constexpr bool GATHER = false;
    __device__ __forceinline__ unsigned rowtok(const Unit&, int) const { return 0u; }
};
struct SchedMoeG {
    StaticOrder o; const char* A; const char* B; size_t tB, tE; const unsigned* tile_expert; const unsigned* slot_tok;
    __device__ __forceinline__ bool next(int i, Unit& u) const { return o.next(i, u); }
    __device__ __forceinline__ const char* aptr(const Unit&) const { return A; }
    __device__ __forceinline__ const char* bptr(const Unit& u) const { return B + (size_t)__builtin_amdgcn_readfirstlane((int)tile_expert[u.pm]) * tE + (size_t)u.pn * tB; }
    static constexpr bool GATHER = true;
    __device__ __forceinline__ unsigned rowtok(const Unit& u, int r) const { return slot_tok[u.pm * 256 + r]; }
};

enum { EPI_BF16 = 0, EPI_RESID = 1, EPI_SWIGLU = 2, EPI_PLE = 3, EPI_Z = 4, EPI_SCALE = 5, EPI_SWIGLU8 = 6, EPI_BF16S = 7, EPI_PLE8 = 8, EPI_SWIGLU_I = 9, EPI_SWIGLU8_I = 10, EPI_Z_I = 11, EPI_RESID_Q = 12, EPI_PLE_I = 13, EPI_RESID_I = 19, EPI_RESID_QI = 20 };
#define ZCV(a) ((MODE == EPI_Z_I) ? (float)__float_as_int(a) : (a))
#define ZCV4(a) ((MODE == EPI_Z_I) ? (f32x4){(float)__float_as_int((a)[0]), (float)__float_as_int((a)[1]), (float)__float_as_int((a)[2]), (float)__float_as_int((a)[3])} : (a))
template <int MODE> struct Epi {
    void* O; const void* X; int ldc; const void* X2; float* SS;
    const float* RS; int rsmode;
    bf16_t* HB; float* SSO;
    LAS float* red;
    const float* RQ = nullptr;
    __device__ __forceinline__ float rowscale(const size_t row) const {
        if (rsmode == 1) { const f32x4 a = *(const f32x4*)(RS + row * 8), b = *(const f32x4*)(RS + row * 8 + 4);
            return 1.0f / sqrtf((((a[0] + a[1]) + (a[2] + a[3])) + ((b[0] + b[1]) + (b[2] + b[3]))) * (1.0f / DM) + EPS); }
        if (rsmode == 2) return RS[row];
        if (rsmode == 3) { const f32x4 a = *(const f32x4*)(RS + row * 8), b = *(const f32x4*)(RS + row * 8 + 4), c = *(const f32x4*)(RQ + row * 8), d = *(const f32x4*)(RQ + row * 8 + 4);
            return sqrtf(((((c[0] + c[1]) + (c[2] + c[3])) + ((d[0] + d[1]) + (d[2] + d[3]))) * (1.0f / DM) + EPS) / ((((a[0] + a[1]) + (a[2] + a[3])) + ((b[0] + b[1]) + (b[2] + b[3]))) * (1.0f / DM) + EPS)) * (5.0f / (127.0f * 1536.0f)); }
        return 1.0f;
    }
    __device__ __forceinline__ void operator()(const f32x4 (&acc)[2][2][4][2], const Unit& u, int wr, int wc, int fr, int fq) const {
        const int row0 = u.pm * BM + wr * 64 + fr;
        constexpr bool IS_RES = (MODE == EPI_RESID || MODE == EPI_RESID_Q || MODE == EPI_RESID_I || MODE == EPI_RESID_QI), IS_PLE = (MODE == EPI_PLE || MODE == EPI_PLE8 || MODE == EPI_PLE_I);
        if constexpr (IS_RES || IS_PLE) {
            constexpr int MG = (MODE == EPI_PLE_I) ? 2 : 4;
#pragma unroll
            for (int ai = 0; ai < 2; ++ai)
#pragma unroll
            for (int mg = 0; mg < 4; mg += MG) {
                u32x4 hin[MG][2], pin[MG][2]; float rsg[MG], rq8[MG]; (void)rq8;
#pragma unroll
                for (int mm = 0; mm < MG; ++mm) { rsg[mm] = (MODE == EPI_PLE8) ? (1.0f / 262144.0f) : 1.0f; if constexpr (MODE == EPI_PLE) rsg[mm] = rowscale((size_t)(row0 + ai * HALF + (mg + mm) * 16));
                    if constexpr (MODE == EPI_RESID_Q || MODE == EPI_RESID_QI) rsg[mm] = rowscale((size_t)(row0 + ai * HALF + (mg + mm) * 16)) * (127.0f / 5.0f);
                    if constexpr (MODE == EPI_PLE_I) { const size_t row_ = (size_t)(row0 + ai * HALF + (mg + mm) * 16); const f32x4 a_ = *(const f32x4*)(RQ + row_ * 8), b_ = *(const f32x4*)(RQ + row_ * 8 + 4);
                        const float rinv_ = rowscale(row_); rq8[mm] = rinv_ * (127.0f / 5.0f);
                        rsg[mm] = rinv_ * sqrtf((((a_[0] + a_[1]) + (a_[2] + a_[3])) + ((b_[0] + b_[1]) + (b_[2] + b_[3]))) * (1.0f / DM) + EPS) * (5.0f / (127.0f * 1536.0f)); } }
#pragma unroll
                for (int mm = 0; mm < MG; ++mm) { const int m = mg + mm; const size_t off = (size_t)(row0 + ai * HALF + m * 16) * ldc + u.pn * BM + wc * 32 + 8 * fq;
#pragma unroll
                    for (int bj = 0; bj < 2; ++bj) {
                        if constexpr (IS_RES) { hin[mm][bj] = *(const u32x4*)((const bf16_t*)X + off + bj * HALF); }
                        else { hin[mm][bj] = *(const u32x4*)((const bf16_t*)X2 + off + bj * HALF); pin[mm][bj] = *(const u32x4*)((const bf16_t*)X + off + bj * HALF); }
                    } }
#pragma unroll
                for (int mm = 0; mm < MG; ++mm) { const int m = mg + mm; const size_t off = (size_t)(row0 + ai * HALF + m * 16) * ldc + u.pn * BM + wc * 32 + 8 * fq;
                    const float rs = rsg[mm];
                    float sq = 0.f;
#pragma unroll
                    for (int bj = 0; bj < 2; ++bj) {
                        const u32x4 hw = hin[mm][bj];
                        f32x4 h0 = {bflo(hw.x), bfhi(hw.x), bflo(hw.y), bfhi(hw.y)}, h1 = {bflo(hw.z), bfhi(hw.z), bflo(hw.w), bfhi(hw.w)};
                        if constexpr (MODE == EPI_RESID_I || MODE == EPI_RESID_QI) { constexpr float as_ = 1.5f / (127.0f * 1536.0f);
#pragma unroll
                            for (int j = 0; j < 4; ++j) { h0[j] += (float)__float_as_int(acc[ai][bj][m][0][j]) * as_; h1[j] += (float)__float_as_int(acc[ai][bj][m][1][j]) * as_; } }
                        else if constexpr (IS_RES) { h0 = h0 + acc[ai][bj][m][0]; h1 = h1 + acc[ai][bj][m][1]; }
                        else { const u32x4 pw = pin[mm][bj];
                            const float pv[8] = {bflo(pw.x), bfhi(pw.x), bflo(pw.y), bfhi(pw.y), bflo(pw.z), bfhi(pw.z), bflo(pw.w), bfhi(pw.w)};
#pragma unroll
                            for (int j = 0; j < 4; ++j) { const float a0 = ((MODE == EPI_PLE_I) ? (float)__float_as_int(acc[ai][bj][m][0][j]) : acc[ai][bj][m][0][j]) * rs, a1 = ((MODE == EPI_PLE_I) ? (float)__float_as_int(acc[ai][bj][m][1][j]) : acc[ai][bj][m][1][j]) * rs;
                                h0[j] += __builtin_amdgcn_rcpf(1.0f + __builtin_amdgcn_exp2f(-1.4426950408889634f * a0)) * pv[j];
                                h1[j] += __builtin_amdgcn_rcpf(1.0f + __builtin_amdgcn_exp2f(-1.4426950408889634f * a1)) * pv[4 + j]; } }
                        { u32x4 w; w.x = cvt_pk_bf16(h0[0], h0[1]); w.y = cvt_pk_bf16(h0[2], h0[3]); w.z = cvt_pk_bf16(h1[0], h1[1]); w.w = cvt_pk_bf16(h1[2], h1[3]);
                            *(u32x4*)(HB + off + bj * HALF) = w; }
                        if constexpr (MODE == EPI_RESID_Q || MODE == EPI_RESID_QI) { u32x2 q8; q8.x = pk4_i8(h0[0] * rs, h0[1] * rs, h0[2] * rs, h0[3] * rs); q8.y = pk4_i8(h1[0] * rs, h1[1] * rs, h1[2] * rs, h1[3] * rs);
                            *(u32x2*)((unsigned char*)O + off + bj * HALF) = q8; }
                        if constexpr (MODE == EPI_PLE_I) { if (O) { const float qs_ = rq8[mm]; u32x2 q8; q8.x = pk4_i8(h0[0] * qs_, h0[1] * qs_, h0[2] * qs_, h0[3] * qs_); q8.y = pk4_i8(h1[0] * qs_, h1[1] * qs_, h1[2] * qs_, h1[3] * qs_);
                            *(u32x2*)((unsigned char*)O + off + bj * HALF) = q8; } }
                        sq += ((h0[0] * h0[0] + h0[1] * h0[1]) + (h0[2] * h0[2] + h0[3] * h0[3])) + ((h1[0] * h1[0] + h1[1] * h1[1]) + (h1[2] * h1[2] + h1[3] * h1[3]));
                    }
                    if (SSO) { sq = xsum32(xsum16(sq)); if (fq == 0) red[wc * 256 + ai * HALF + wr * 64 + m * 16 + fr] = sq; }
                }
            }
        } else
#pragma unroll
        for (int ai = 0; ai < 2; ++ai) {
            float rsv[4];
            if constexpr (MODE == EPI_Z || MODE == EPI_Z_I || MODE == EPI_SWIGLU || MODE == EPI_SWIGLU_I || MODE == EPI_SWIGLU8_I) {
#pragma unroll
                for (int m = 0; m < 4; ++m) rsv[m] = rowscale((size_t)(row0 + ai * HALF + m * 16));
            }
            if constexpr (MODE == EPI_SCALE) {
#pragma unroll
                for (int m = 0; m < 4; ++m) { const size_t row = (size_t)(row0 + ai * HALF + m * 16);
                    const f32x4 pa_ = *(const f32x4*)(SS + row * 16), pb_ = *(const f32x4*)(SS + row * 16 + 4);
                    rsv[m] = 1.0f / sqrtf((((pa_[0] + pa_[1]) + (pa_[2] + pa_[3])) + ((pb_[0] + pb_[1]) + (pb_[2] + pb_[3]))) * (1.0f / 512) + EPS); }
            }
#pragma unroll
            for (int m = 0; m < 4; ++m) {
                const size_t row = (size_t)(row0 + ai * HALF + m * 16);
                if constexpr (MODE == EPI_BF16 || MODE == EPI_BF16S) {
                    bf16_t* rowp = (bf16_t*)O + row * ldc + u.pn * BM + wc * 32 + 8 * fq;
                    constexpr float sc_ = (MODE == EPI_BF16S) ? (1.0f / 262144.0f) : 1.0f;
#pragma unroll
                    for (int bj = 0; bj < 2; ++bj) { const f32x4 v0 = acc[ai][bj][m][0] * sc_, v1 = acc[ai][bj][m][1] * sc_;
                        u32x4 w; w.x = cvt_pk_bf16(v0[0], v0[1]); w.y = cvt_pk_bf16(v0[2], v0[3]); w.z = cvt_pk_bf16(v1[0], v1[1]); w.w = cvt_pk_bf16(v1[2], v1[3]);
                        *(u32x4*)(rowp + bj * HALF) = w; }
                } else if constexpr (MODE == EPI_SCALE) {
                    const float ri = rsv[m];
                    bf16_t* rowp = (bf16_t*)O + row * ldc + u.pn * BM + wc * 32 + 8 * fq;
#pragma unroll
                    for (int bj = 0; bj < 2; ++bj) { const f32x4 v0 = acc[ai][bj][m][0] * ri, v1 = acc[ai][bj][m][1] * ri;
                        u32x4 w; w.x = cvt_pk_bf16(v0[0], v0[1]); w.y = cvt_pk_bf16(v0[2], v0[3]); w.z = cvt_pk_bf16(v1[0], v1[1]); w.w = cvt_pk_bf16(v1[2], v1[3]);
                        *(u32x4*)(rowp + bj * HALF) = w; }
                } else if constexpr (MODE == EPI_Z || MODE == EPI_Z_I) {
                    const float rs = rsv[m];
                    const int pn = u.pn; const bool r64 = (pn == 2) | (pn == 3) | (pn == 20), r128 = (pn == 14);
                    if (r64 | r128) {
                        const int pos = (int)row & (SEQ - 1); const int j0 = r64 ? 8 * fq : (wc & 1) * 32 + 8 * fq;
                        const float* tb = r64 ? (const float*)X + ((size_t)pos * 32 + j0) * 2 : (const float*)X2 + ((size_t)pos * 64 + j0) * 2;
                        const f32x4 t0 = *(const f32x4*)tb, t1 = *(const f32x4*)(tb + 4), t2 = *(const f32x4*)(tb + 8), t3 = *(const f32x4*)(tb + 12);
                        const float cs[16] = {t0[0], t0[1], t0[2], t0[3], t1[0], t1[1], t1[2], t1[3], t2[0], t2[1], t2[2], t2[3], t3[0], t3[1], t3[2], t3[3]};
                        float y1[8], y2[8];
#pragma unroll
                        for (int n = 0; n < 2; ++n)
#pragma unroll
                            for (int j = 0; j < 4; ++j) { const float x1 = ZCV(acc[ai][0][m][n][j]) * rs, x2 = ZCV(acc[ai][1][m][n][j]) * rs, c = cs[(n * 4 + j) * 2], sn = cs[(n * 4 + j) * 2 + 1];
                                y1[n * 4 + j] = x1 * c - x2 * sn; y2[n * 4 + j] = x2 * c + x1 * sn; }
                        const int c1 = pn * BM + (r64 ? wc * 64 + j0 : (wc >> 1) * 128 + j0), c2 = c1 + (r64 ? 32 : 64);
                        u32x4 w; w.x = cvt_pk_bf16(y1[0], y1[1]); w.y = cvt_pk_bf16(y1[2], y1[3]); w.z = cvt_pk_bf16(y1[4], y1[5]); w.w = cvt_pk_bf16(y1[6], y1[7]);
                        *(u32x4*)((bf16_t*)O + row * ldc + c1) = w;
                        w.x = cvt_pk_bf16(y2[0], y2[1]); w.y = cvt_pk_bf16(y2[2], y2[3]); w.z = cvt_pk_bf16(y2[4], y2[5]); w.w = cvt_pk_bf16(y2[6], y2[7]);
                        *(u32x4*)((bf16_t*)O + row * ldc + c2) = w;
                    } else {
                        bf16_t* rowp = (bf16_t*)O + row * ldc + pn * BM + wc * 32 + 8 * fq;
                        float sq = 0.f;
#pragma unroll
                        for (int bj = 0; bj < 2; ++bj) { const f32x4 v0 = ZCV4(acc[ai][bj][m][0]) * rs, v1 = ZCV4(acc[ai][bj][m][1]) * rs;
                            sq += ((v0[0] * v0[0] + v0[1] * v0[1]) + (v0[2] * v0[2] + v0[3] * v0[3])) + ((v1[0] * v1[0] + v1[1] * v1[1]) + (v1[2] * v1[2] + v1[3] * v1[3]));
                            u32x4 w; w.x = cvt_pk_bf16(v0[0], v0[1]); w.y = cvt_pk_bf16(v0[2], v0[3]); w.z = cvt_pk_bf16(v1[0], v1[1]); w.w = cvt_pk_bf16(v1[2], v1[3]);
                            *(u32x4*)(rowp + bj * HALF) = w; }
                        if (pn >= 16 && pn < 20) {
                            sq = xsum32(xsum16(sq));
                            if (fq == 0) SS[row * 16 + (pn - 16) * 4 + wc] = sq;
                        }
                    }
                } else if constexpr (MODE == EPI_SWIGLU || MODE == EPI_SWIGLU8 || MODE == EPI_SWIGLU_I || MODE == EPI_SWIGLU8_I) {
                    const float rs = (MODE == EPI_SWIGLU8) ? (1.0f / 262144.0f) : rsv[m];
                    bf16_t* rowp = (bf16_t*)O + row * ldc + u.pn * HALF + wc * 32 + 8 * fq;
                    float r[8];
#pragma unroll
                    for (int n = 0; n < 2; ++n)
#pragma unroll
                        for (int j = 0; j < 4; ++j) { constexpr bool IA = (MODE == EPI_SWIGLU_I || MODE == EPI_SWIGLU8_I);
                            const float g = (IA ? (float)__float_as_int(acc[ai][0][m][n][j]) : acc[ai][0][m][n][j]) * rs, up = (IA ? (float)__float_as_int(acc[ai][1][m][n][j]) : acc[ai][1][m][n][j]) * rs;
                            r[n * 4 + j] = g * __builtin_amdgcn_rcpf(1.0f + __builtin_amdgcn_exp2f(-1.4426950408889634f * g)) * up; }
                    if constexpr (MODE == EPI_SWIGLU8 || MODE == EPI_SWIGLU8_I) { u32x2 w8; w8.x = pk4_fp8(r[0] * 32.f, r[1] * 32.f, r[2] * 32.f, r[3] * 32.f); w8.y = pk4_fp8(r[4] * 32.f, r[5] * 32.f, r[6] * 32.f, r[7] * 32.f);
                        *(u32x2*)((unsigned char*)O + row * ldc + u.pn * HALF + wc * 32 + 8 * fq) = w8; }
                    else {
                    u32x4 w; w.x = cvt_pk_bf16(r[0], r[1]); w.y = cvt_pk_bf16(r[2], r[3]); w.z = cvt_pk_bf16(r[4], r[5]); w.w = cvt_pk_bf16(r[6], r[7]);
                    *(u32x4*)rowp = w; }
                }
            }
        }
        if constexpr (IS_RES || IS_PLE) {
            if (SSO) {
                asm volatile("s_waitcnt lgkmcnt(0)" ::: "memory"); __builtin_amdgcn_s_barrier(); asm volatile("" ::: "memory");
                unsigned on2_ = ~0u; asm volatile("" : "+s"(on2_)); const int t = (wr * 4 + wc) * 64 + __builtin_amdgcn_mbcnt_hi(on2_, __builtin_amdgcn_mbcnt_lo(on2_, 0u));
                if (t < 256) SSO[((size_t)u.pm * BM + t) * 8 + u.pn] = (red[t] + red[256 + t]) + (red[512 + t] + red[768 + t]);
            }
        }
    }
};

typedef int v4i_t __attribute__((ext_vector_type(4)));
typedef int v8i_t __attribute__((ext_vector_type(8)));
__device__ __forceinline__ v8i_t cat8(bf16x8 a, bf16x8 b) { const v4i_t x = __builtin_bit_cast(v4i_t, a), y = __builtin_bit_cast(v4i_t, b); return __builtin_shufflevector(x, y, 0, 1, 2, 3, 4, 5, 6, 7); }
__device__ __forceinline__ void mfma8_inplace(f32x4& c, const v8i_t a, const v8i_t b, const int sc) {
    asm volatile("s_nop 1\n\tv_mfma_scale_f32_16x16x128_f8f6f4 %0, %1, %2, %0, %3, %3 op_sel_hi:[0,0,0]" : "+v"(c) : "v"(a), "v"(b), "v"(sc));
}
template <class EpiT, class Sched, int QM = 0>
__device__ __forceinline__ void gemm_phase(LAS unsigned char* lds, const int tid, const int lda, const int ldb, const int K, const Sched& S, const EpiT& E) {
    constexpr bool FP8 = (QM == 1), INT8 = (QM == 2);
    const int wid = __builtin_amdgcn_readfirstlane(tid >> 6), lane = tid & 63, wr = wid >> 2, wc = wid & 3, fr = lane & 15, fq = lane >> 4;
    const int nt = K / BK;
    unsigned voffA[2], voffB[2];
#pragma unroll
    for (int i = 0; i < 2; ++i) { int R, C; stage_rc(tid * 16 + i * 8192, R, C); const int Rb = (R & ~31) + perm32(R & 31);
        voffA[i] = (unsigned)(R * lda + C) * 2u; voffB[i] = (unsigned)(Rb * ldb + C) * 2u; }
    const size_t kstep = (size_t)(BK * 2);
    const size_t hstepA = Sched::GATHER ? (size_t)0 : (size_t)HALF * lda * 2, hstepB = (size_t)HALF * ldb * 2;
    unsigned vc0[2], vc1[2], vn0[2], vn1[2];
#define PG8_ROWOFFS(u_, d0, d1) do { if constexpr (Sched::GATHER) { _Pragma("unroll") for (int i = 0; i < 2; ++i) { int R, C; stage_rc(tid * 16 + i * 8192, R, C); \
        d0[i] = S.rowtok(u_, R) * (unsigned)(lda * 2) + (unsigned)C * 2u; d1[i] = S.rowtok(u_, HALF + R) * (unsigned)(lda * 2) + (unsigned)C * 2u; } } \
        } while (0)
#define PG8_V(arr) (Sched::GATHER ? (const unsigned*)(arr) : (const unsigned*)voffA)
    const unsigned ldsw = (unsigned)wid * 1024u;
    const int aoff = lds_byte(wr * 64 + fr, fq * 8), boff = lds_byte(wc * 32 + fr, fq * 8);
#define PG8_SA(b, h) (((b) * 2 + (h)) * HTB)
#define PG8_SB(b, h) ((4 + (b) * 2 + (h)) * HTB)
#define PG8_STAGE(bufoff, gbase, voff) do { _Pragma("unroll") for (int _i = 0; _i < 2; ++_i) \
        __builtin_amdgcn_global_load_lds((const unsigned*)((const char*)(gbase) + (voff)[_i]), (LAS unsigned*)(lds + (bufoff) + ldsw + _i * 8192), 16, 0, 0); } while (0)
#define PG8_LDA(dst, b, h) do { if constexpr (FP8) { _Pragma("unroll") for (int m = 0; m < 4; ++m) dst##8[m] = cat8(*(const LAS bf16x8*)(lds + PG8_SA(b, h) + aoff + m * 2048), *(const LAS bf16x8*)(lds + PG8_SA(b, h) + aoff + m * 2048 + 1024)); } \
        else { _Pragma("unroll") for (int m = 0; m < 4; ++m) _Pragma("unroll") for (int k = 0; k < 2; ++k) dst[m][k] = *(const LAS bf16x8*)(lds + PG8_SA(b, h) + aoff + m * 2048 + k * 1024); } } while (0)
#define PG8_LDB(dst, b, h) do { if constexpr (FP8) { _Pragma("unroll") for (int n = 0; n < 2; ++n) dst##8[n] = cat8(*(const LAS bf16x8*)(lds + PG8_SB(b, h) + boff + n * 2048), *(const LAS bf16x8*)(lds + PG8_SB(b, h) + boff + n * 2048 + 1024)); } \
        else { _Pragma("unroll") for (int n = 0; n < 2; ++n) _Pragma("unroll") for (int k = 0; k < 2; ++k) dst[n][k] = *(const LAS bf16x8*)(lds + PG8_SB(b, h) + boff + n * 2048 + k * 1024); } } while (0)
#define PG8_MMA(ai, bj, At, Bt) do { __builtin_amdgcn_s_setprio(1); if constexpr (FP8) { _Pragma("unroll") for (int m = 0; m < 4; ++m) _Pragma("unroll") for (int n = 0; n < 2; ++n) \
        mfma8_inplace(acc[ai][bj][m][n], Bt##8[n], At##8[m], sc8); } else if constexpr (INT8) { \
        _Pragma("unroll") for (int m = 0; m < 4; ++m) _Pragma("unroll") for (int n = 0; n < 2; ++n) _Pragma("unroll") for (int k = 0; k < 2; ++k) \
        acc[ai][bj][m][n] = __builtin_bit_cast(f32x4, __builtin_amdgcn_mfma_i32_16x16x64_i8(__builtin_bit_cast(v4i_t, Bt[n][k]), __builtin_bit_cast(v4i_t, At[m][k]), __builtin_bit_cast(v4i_t, acc[ai][bj][m][n]), 0, 0, 0)); } else { \
        _Pragma("unroll") for (int m = 0; m < 4; ++m) _Pragma("unroll") for (int n = 0; n < 2; ++n) _Pragma("unroll") for (int k = 0; k < 2; ++k) \
        acc[ai][bj][m][n] = __builtin_amdgcn_mfma_f32_16x16x32_bf16(Bt[n][k], At[m][k], acc[ai][bj][m][n], 0, 0, 0); } __builtin_amdgcn_s_setprio(0); } while (0)
#define PG8_WAIT_V(n) asm volatile("s_waitcnt vmcnt(" #n ")" ::: "memory")
#define PG8_WAIT_L(n) asm volatile("s_waitcnt lgkmcnt(" #n ")" ::: "memory")
#define PG8_BAR __builtin_amdgcn_s_barrier()
#define PG8_SCHED __builtin_amdgcn_sched_barrier(0)
    Unit cur, nxt; int ui = 0;
    if (!S.next(0, cur)) return;
    f32x4 acc[2][2][4][2];
#pragma unroll
    for (int a = 0; a < 2; ++a)
#pragma unroll
        for (int b = 0; b < 2; ++b)
#pragma unroll
            for (int m = 0; m < 4; ++m)
#pragma unroll
                for (int n = 0; n < 2; ++n) acc[a][b][m][n] = (f32x4){0.f, 0.f, 0.f, 0.f};
    bf16x8 At[4][2], B0[2][2], B1[2][2]; v8i_t At8[4], B08[2], B18[2];
    int sc8 = 0x7f7f7f7f; (void)sc8;
    const char* cA = S.aptr(cur); const char* cB = S.bptr(cur);
    PG8_ROWOFFS(cur, vc0, vc1);
    PG8_STAGE(PG8_SB(0, 0), cB, voffB); PG8_STAGE(PG8_SB(0, 1), cB + hstepB, voffB); PG8_STAGE(PG8_SA(0, 0), cA, PG8_V(vc0)); PG8_STAGE(PG8_SA(0, 1), cA + hstepA, PG8_V(vc1));
    if (wr == 1) PG8_BAR;
    PG8_WAIT_V(2); PG8_BAR;
    PG8_STAGE(PG8_SB(1, 0), cB + kstep, voffB); PG8_STAGE(PG8_SA(1, 0), cA + kstep, PG8_V(vc0)); PG8_STAGE(PG8_SB(1, 1), cB + hstepB + kstep, voffB);
    PG8_WAIT_V(6); PG8_BAR;
    for (;;) {
        const bool has_next = S.next(ui + 1, nxt);
        const char* nA = has_next ? S.aptr(nxt) : cA; const char* nB = has_next ? S.bptr(nxt) : cB;
        if constexpr (Sched::GATHER) { if (has_next) { PG8_ROWOFFS(nxt, vn0, vn1); } else { vn0[0] = vc0[0]; vn0[1] = vc0[1]; vn1[0] = vc1[0]; vn1[1] = vc1[1]; } }
        for (int t = 0; t < nt; t += 2) {
            const bool last = (t == nt - 2);
            const char* a1 = cA + (size_t)(t + 1) * kstep;
            const char* a2 = last ? nA : cA + (size_t)(t + 2) * kstep; const char* b2 = last ? nB : cB + (size_t)(t + 2) * kstep;
            const char* a3 = a2 + kstep; const char* b3 = b2 + kstep;
            unsigned w0[2], w1[2]; if constexpr (Sched::GATHER) { w0[0] = last ? vn0[0] : vc0[0]; w0[1] = last ? vn0[1] : vc0[1]; w1[0] = last ? vn1[0] : vc1[0]; w1[1] = last ? vn1[1] : vc1[1]; }
            PG8_LDB(B0, 0, 0); PG8_LDB(B1, 0, 1); PG8_SCHED; PG8_LDA(At, 0, 0); PG8_STAGE(PG8_SA(1, 1), a1 + hstepA, PG8_V(vc1));
            PG8_WAIT_V(8); PG8_WAIT_L(0); PG8_BAR; PG8_MMA(0, 0, At, B0); PG8_MMA(0, 1, At, B1); PG8_BAR; PG8_SCHED;
            PG8_LDA(At, 0, 1); PG8_STAGE(PG8_SB(0, 0), b2, voffB); PG8_STAGE(PG8_SB(0, 1), b2 + hstepB, voffB); PG8_STAGE(PG8_SA(0, 0), a2, PG8_V(w0));
            PG8_WAIT_V(8); PG8_WAIT_L(0); PG8_BAR; PG8_MMA(1, 0, At, B0); PG8_MMA(1, 1, At, B1); PG8_BAR; PG8_SCHED;
            PG8_LDB(B0, 1, 0); PG8_LDB(B1, 1, 1); PG8_SCHED; PG8_LDA(At, 1, 0); PG8_STAGE(PG8_SA(0, 1), a2 + hstepA, PG8_V(w1));
            PG8_WAIT_V(8); PG8_WAIT_L(0); PG8_BAR; PG8_MMA(0, 0, At, B0); PG8_MMA(0, 1, At, B1); PG8_BAR; PG8_SCHED;
            PG8_LDA(At, 1, 1); PG8_STAGE(PG8_SB(1, 0), b3, voffB); PG8_STAGE(PG8_SB(1, 1), b3 + hstepB, voffB); PG8_STAGE(PG8_SA(1, 0), a3, PG8_V(w0));
            PG8_WAIT_V(8); PG8_WAIT_L(0); PG8_BAR; PG8_MMA(1, 0, At, B0); PG8_MMA(1, 1, At, B1); PG8_BAR; PG8_SCHED;
        }
        if constexpr (FP8) asm volatile("s_nop 15\n\ts_nop 15\n\ts_nop 15\n\ts_nop 15" ::: "memory");
        if (wr == 0) PG8_BAR;
        { unsigned on_ = ~0u; asm volatile("" : "+s"(on_)); const int l2_ = __builtin_amdgcn_mbcnt_hi(on_, __builtin_amdgcn_mbcnt_lo(on_, 0u)); E(acc, cur, wr, wc, l2_ & 15, l2_ >> 4); }
        if (!has_next) break;
#pragma unroll
        for (int a = 0; a < 2; ++a)
#pragma unroll
            for (int b = 0; b < 2; ++b)
#pragma unroll
                for (int m = 0; m < 4; ++m)
#pragma unroll
                    for (int n = 0; n < 2; ++n) acc[a][b][m][n] = (f32x4){0.f, 0.f, 0.f, 0.f};
        cur = nxt; cA = nA; cB = nB; ++ui; if constexpr (Sched::GATHER) { vc0[0] = vn0[0]; vc0[1] = vn0[1]; vc1[0] = vn1[0]; vc1[1] = vn1[1]; }
        if (wr == 1) PG8_BAR;
    }
    PG8_WAIT_V(0);
    PG8_BAR;
#undef PG8_SA
#undef PG8_SB
#undef PG8_STAGE
#undef PG8_LDA
#undef PG8_LDB
#undef PG8_MMA
#undef PG8_WAIT_V
#undef PG8_WAIT_L
#undef PG8_BAR
#undef PG8_SCHED
#undef PG8_ROWOFFS
#undef PG8_V
}
}

#define XB_TMO      128
#define XB_XCNT(j)  (256  + 64 * (j))
#define XB_XSUB(j)  (1280 + 64 * (j))
#define XB_XGEN(j)  (2304 + 64 * (j))
#define XB_TOP      3328
#define XB_TOPGEN   3392
#define XCD_BAR_WORDS 3456
#define XB_SPIN_CAP (1u << 18)
__device__ __forceinline__ unsigned xb_ld(unsigned* p)              { return __hip_atomic_load(p, __ATOMIC_RELAXED, __HIP_MEMORY_SCOPE_AGENT); }
__device__ __forceinline__ unsigned xb_add(unsigned* p, unsigned v) { return __hip_atomic_fetch_add(p, v, __ATOMIC_RELAXED, __HIP_MEMORY_SCOPE_AGENT); }
__device__ __forceinline__ unsigned xb_xcc_id() { return (unsigned)__builtin_amdgcn_s_getreg((3 << 11) | 20) & 0xFu; }
#define XB_SPIN(cond, bar) do { unsigned _sp = 0; while (cond) { __builtin_amdgcn_s_sleep(1); \
    if ((++_sp & 255u) == 0u) { if (xb_ld(&(bar)[XB_TMO])) break; if (_sp > XB_SPIN_CAP) { atomicAdd(&(bar)[XB_TMO], 1u); break; } } } } while (0)
struct XcdBarrier { unsigned* bar; unsigned x; volatile LAS unsigned* st; };
__device__ __forceinline__ XcdBarrier xcd_barrier_post(unsigned* bar, volatile LAS unsigned* st, const bool t0) {
    XcdBarrier b; b.bar = bar; b.x = xb_xcc_id(); b.st = st;
    if (t0) (void)xb_add(&bar[XB_XCNT(b.x)], 1u);
    return b;
}
__device__ __forceinline__ void xcd_barrier_complete(unsigned* bar, unsigned x, unsigned& nloc, unsigned& nx) {
    const unsigned G = gridDim.x * gridDim.y * gridDim.z;
    unsigned sum, cnt, mine, sp = 0u;
    for (;;) {
        sum = 0u; cnt = 0u; mine = 0u;
#pragma unroll
        for (unsigned j = 0; j < 16; ++j) { const unsigned c = xb_ld(&bar[XB_XCNT(j)]); sum += c; cnt += (c > 0u) ? 1u : 0u; mine = (j == x) ? c : mine; }
        if (sum == G) break;
        __builtin_amdgcn_s_sleep(1);
        if ((++sp & 255u) == 0u) { if (xb_ld(&bar[XB_TMO])) break; if (sp > XB_SPIN_CAP) { atomicAdd(&bar[XB_TMO], 1u); break; } }
    }
    nloc = mine > 0u ? mine : 1u; nx = cnt > 0u ? cnt : 1u;
}
__device__ __forceinline__ void xcd_barrier(const XcdBarrier& b, const bool t0) {
    asm volatile("s_waitcnt vmcnt(0)" ::: "memory");
    __syncthreads();
    if (t0) {
        unsigned* bar = b.bar;
        __builtin_amdgcn_s_waitcnt(0);
        unsigned nloc = b.st[0], nx = b.st[1];
        if (nloc == 0u) { xcd_barrier_complete(bar, b.x, nloc, nx); b.st[0] = nloc; b.st[1] = nx; }
        const unsigned old = xb_add(&bar[XB_XSUB(b.x)], 1u);
        const unsigned gen = old / nloc;
        if (old + 1u == (gen + 1u) * nloc) {
            __builtin_amdgcn_fence(__ATOMIC_RELEASE, "agent");
            asm volatile("s_waitcnt vmcnt(0)" ::: "memory");
            const unsigned og = xb_add(&bar[XB_TOP], 1u);
            const unsigned tg = og / nx;
            if (og + 1u == (tg + 1u) * nx) xb_add(&bar[XB_TOPGEN], 1u);
            else XB_SPIN(xb_ld(&bar[XB_TOPGEN]) == tg, bar);
            __builtin_amdgcn_fence(__ATOMIC_ACQUIRE, "agent");
            xb_add(&bar[XB_XGEN(b.x)], 1u);
            asm volatile("s_waitcnt vmcnt(0)" ::: "memory");
        } else {
            XB_SPIN(xb_ld(&bar[XB_XGEN(b.x)]) == gen, bar);
            __builtin_amdgcn_fence(__ATOMIC_ACQUIRE, "agent");
            asm volatile("s_waitcnt vmcnt(0)" ::: "memory");
        }
    }
    __syncthreads();
}

constexpr int RING_OFF = 0, RING_BYTES = pg8::STAGE_BYTES;
constexpr int MISC_OFF = RING_BYTES;
constexpr int RED_OFF = RING_BYTES + 4096;
constexpr int LDS_BYTES = RING_BYTES + 8192;

struct Args { const float* in[N_IN]; float* out; unsigned char* ws; int ph_lo, ph_hi; };

struct Frame {
    LAS unsigned char* lds; volatile LAS unsigned* MISC;
    int tid, lane, wave, vcu, G;
    unsigned char* ws; float* out;
};

__device__ __forceinline__ void transpose_item(const float* W, int K, int N, bf16_t* WT, int dstrow0, int k0, int n0, LAS float* scr, int lane, const float* gk, const float qs = 0.f) {
    if (gk) {
#pragma unroll 8
        for (int i = 0; i < 32; ++i) { const int kk = 2 * i + (lane >> 5); scr[kk * 33 + (lane & 31)] = __builtin_nontemporal_load(&W[(size_t)(k0 + kk) * N + n0 + (lane & 31)]) * gk[k0 + kk]; }
    } else {
#pragma unroll 8
    for (int i = 0; i < 32; ++i) { const int kk = 2 * i + (lane >> 5); scr[kk * 33 + (lane & 31)] = __builtin_nontemporal_load(&W[(size_t)(k0 + kk) * N + n0 + (lane & 31)]); }
    }
    LDS_WAIT(); asm volatile("" ::: "memory");
    const int c = lane & 7;
#pragma unroll
    for (int j = 0; j < 4; ++j) { const int n = (lane >> 3) + 8 * j; const LAS float* s = scr + (8 * c) * 33 + n;
        if (qs < 0.f) { const float q_ = -qs; u32x2 o8; o8.x = pk4_i8(s[0 * 33] * q_, s[1 * 33] * q_, s[2 * 33] * q_, s[3 * 33] * q_); o8.y = pk4_i8(s[4 * 33] * q_, s[5 * 33] * q_, s[6 * 33] * q_, s[7 * 33] * q_);
            *(u32x2*)((unsigned char*)WT + (size_t)(dstrow0 + n) * K + k0 + 8 * c) = o8; }
        else if (qs > 0.f) { u32x2 o8; o8.x = pk4_fp8(s[0 * 33] * qs, s[1 * 33] * qs, s[2 * 33] * qs, s[3 * 33] * qs); o8.y = pk4_fp8(s[4 * 33] * qs, s[5 * 33] * qs, s[6 * 33] * qs, s[7 * 33] * qs);
            *(u32x2*)((unsigned char*)WT + (size_t)(dstrow0 + n) * K + k0 + 8 * c) = o8; }
        else {
        u32x4 o; o.x = cvt_pk_bf16(s[0 * 33], s[1 * 33]); o.y = cvt_pk_bf16(s[2 * 33], s[3 * 33]); o.z = cvt_pk_bf16(s[4 * 33], s[5 * 33]); o.w = cvt_pk_bf16(s[6 * 33], s[7 * 33]);
        *(u32x4*)(WT + (size_t)(dstrow0 + n) * K + k0 + 8 * c) = o; } }
    LDS_WAIT(); asm volatile("" ::: "memory");
}
__device__ __forceinline__ int win_drow(int n0) {
    const int tile = n0 >> 8, pt = n0 & 255;
    if (tile == 2 || tile == 3 || tile == 20) return tile * 256 + ((pt >> 5) & 1) * 128 + (pt >> 6) * 32;
    if (tile == 14) return tile * 256 + ((pt >> 6) & 1) * 128 + (pt >> 7) * 64 + (pt & 63);
    return n0;
}
__device__ __forceinline__ void transpose_job(const float* W, int K, int N, bf16_t* WT, int mode, int item, LAS float* scr, int lane, const float* gk = nullptr, const float qs = 0.f) {
    const int nblk = N / 32, kb = item / nblk, nb = item % nblk, n0 = nb * 32;
    const int drow = mode == 0 ? n0 : (mode == 3 ? win_drow(n0) : ((n0 >> 7) * 256 + (n0 & 127) + (mode == 2 ? 128 : 0)));
    transpose_item(W, K, N, WT, drow, kb * 64, n0, scr, lane, gk, qs);
}
constexpr int IT_WIN = 32 * 162, IT_WUQ = 8 * 24, IT_WUKV = 8 * 32, IT_SQ = 32 * 64, IT_PP = 4 * 64, IT_LAYER = IT_WIN + IT_WUQ + IT_WUKV + 2 * IT_SQ + IT_PP;
constexpr int IT_FF = 32 * 224, IT_FFN = 3 * IT_FF;
constexpr int IT_TOTAL = 2 * IT_LAYER + IT_FFN + NE * IT_FFN;

__device__ __forceinline__ void ffn_job(const float* wg, const float* wu, const float* wd, bf16_t* gu, bf16_t* dn, int r, LAS float* scr, int lane, const float* gk, const bool moe) {
    if (r < IT_FF) { transpose_job(wg, DM, FF, gu, 1, r, scr, lane, gk, -1536.f); return; } r -= IT_FF;
    if (r < IT_FF) { transpose_job(wu, DM, FF, gu, 2, r, scr, lane, gk, -1536.f); return; } r -= IT_FF;
    transpose_job(wd, FF, DM, dn, 0, r, scr, lane, nullptr, moe ? 8192.f : 0.f);
}

__device__ __forceinline__ void rms_row_to_bf16(const float* xrow, const float* g, bf16_t* orow, int lane, float& rinv_out, f32x4 (&v)[8]) {
    const f32x4* xr = (const f32x4*)xrow + lane; float s = 0.f;
#pragma unroll
    for (int j = 0; j < 8; ++j) { v[j] = xr[64 * j]; s += (v[j].x * v[j].x + v[j].y * v[j].y) + (v[j].z * v[j].z + v[j].w * v[j].w); }
    const float rinv = 1.0f / sqrtf(wave_sum(s) * (1.0f / DM) + EPS); rinv_out = rinv;
    u32x2* o8 = (u32x2*)orow + lane;
#pragma unroll
    for (int j = 0; j < 8; ++j) { const f32x4 gg = ((const f32x4*)g)[64 * j + lane]; v[j] = v[j] * rinv * gg;
        u32x2 w; w.x = cvt_pk_bf16(v[j].x, v[j].y); w.y = cvt_pk_bf16(v[j].z, v[j].w); o8[64 * j] = w; }
}


__device__ __forceinline__ void row_hb_ss(const f32x4 (&v)[8], bf16_t* hbrow, float* ssp, int lane) {
    float s = 0.f; u32x2* o8 = (u32x2*)hbrow + lane;
#pragma unroll
    for (int j = 0; j < 8; ++j) { s += (v[j].x * v[j].x + v[j].y * v[j].y) + (v[j].z * v[j].z + v[j].w * v[j].w); u32x2 w; w.x = cvt_pk_bf16(v[j].x, v[j].y); w.y = cvt_pk_bf16(v[j].z, v[j].w); o8[64 * j] = w; }
    s = wave_sum(s);
    if (lane < 8) ssp[lane] = lane == 0 ? s : 0.f;
}

namespace att {
typedef int v4i_t __attribute__((ext_vector_type(4)));
typedef int v8i_t __attribute__((ext_vector_type(8)));
constexpr int KPL = 8192;
constexpr int KBUF = 3 * KPL;
constexpr int VT = 16384;
constexpr int OFF_K = 0, OFF_V = 2 * KBUF, OFF_WS = OFF_V + 2 * VT, OFF_BIAS = OFF_WS + 8 * 256, OFF_QL = OFF_BIAS + 2048, LDS_END = OFF_QL + 8 * 4096;
#define SBAR() __builtin_amdgcn_sched_barrier(0)
__device__ __forceinline__ int crow(int r, int hi) { return (r & 3) + 8 * (r >> 2) + 4 * hi; }
__device__ __forceinline__ int v_st(int k, int c) { const int kk = (k & ~0xC) | ((k & 4) << 1) | ((k & 8) >> 1); return ((kk >> 3) * 4 + (c >> 5)) * 512 + ((kk & 7) * 32 + (c & 31)) * 2; }
__device__ __forceinline__ int v_rd_base(int lane) { return ((lane & 3) << 3) | (((lane >> 2) & 3) << 6) | (((lane >> 4) & 1) << 5) | (((lane >> 5) & 1) << 8); }
constexpr int v_rd_off(int d0, int ks, int half) { return d0 * 512 + ks * 4096 + half * 2048; }
template <int OFF> __device__ __forceinline__ s16x4 tr_read(int vb) {
    s16x4 r; asm volatile("ds_read_b64_tr_b16 %0, %1 offset:%2" : "=&v"(r) : "v"(vb), "i"(OFF) : "memory"); return r;
}
template <int D0> __device__ __forceinline__ void pv_one(f32x16& od, int vb, bf16x8 pa0, bf16x8 pa1, bf16x8 pa2, bf16x8 pa3) {
    const s16x4 l0 = tr_read<v_rd_off(D0, 0, 0)>(vb), h0 = tr_read<v_rd_off(D0, 0, 1)>(vb), l1 = tr_read<v_rd_off(D0, 1, 0)>(vb), h1 = tr_read<v_rd_off(D0, 1, 1)>(vb);
    const s16x4 l2 = tr_read<v_rd_off(D0, 2, 0)>(vb), h2 = tr_read<v_rd_off(D0, 2, 1)>(vb), l3 = tr_read<v_rd_off(D0, 3, 0)>(vb), h3 = tr_read<v_rd_off(D0, 3, 1)>(vb);
    asm volatile("s_waitcnt lgkmcnt(0)" ::: "memory"); SBAR();
#define PK(L, H) (bf16x8){L[0], L[1], L[2], L[3], H[0], H[1], H[2], H[3]}
    od = __builtin_amdgcn_mfma_f32_32x32x16_bf16(pa0, PK(l0, h0), od, 0, 0, 0);
    od = __builtin_amdgcn_mfma_f32_32x32x16_bf16(pa1, PK(l1, h1), od, 0, 0, 0);
    od = __builtin_amdgcn_mfma_f32_32x32x16_bf16(pa2, PK(l2, h2), od, 0, 0, 0);
    od = __builtin_amdgcn_mfma_f32_32x32x16_bf16(pa3, PK(l3, h3), od, 0, 0, 0);
#undef PK
}
__device__ __forceinline__ void partialSM(f32x16& p0, f32x16& p1, float& m_reg, float& alpha, const float C, const float thr) {
    float pmax = p0[0];
#pragma unroll
    for (int r = 1; r < 16; ++r) pmax = fmaxf(pmax, p0[r]);
#pragma unroll
    for (int r = 0; r < 16; ++r) pmax = fmaxf(pmax, p1[r]);
    { auto rr = __builtin_amdgcn_permlane32_swap(__float_as_uint(pmax), __float_as_uint(pmax), false, false);
      pmax = fmaxf(__uint_as_float(rr[0]), __uint_as_float(rr[1])); }
    float mn;
    if (__builtin_expect(__all(pmax - m_reg <= thr), 1)) { mn = m_reg; alpha = 1.f; }
    else { mn = fmaxf(m_reg, pmax); alpha = __builtin_amdgcn_exp2f((m_reg - mn) * C); m_reg = mn; }
    const float mnC = -mn * C;
#pragma unroll
    for (int r = 0; r < 16; ++r) p0[r] = __builtin_amdgcn_exp2f(fmaf(p0[r], C, mnC));
#pragma unroll
    for (int r = 0; r < 16; ++r) p1[r] = __builtin_amdgcn_exp2f(fmaf(p1[r], C, mnC));
}
__device__ __forceinline__ void finishSM(const f32x16& p0, const f32x16& p1, float alpha, float& l_reg, bf16x8& pa0, bf16x8& pa1, bf16x8& pa2, bf16x8& pa3) {
    float ps = 0;
#pragma unroll
    for (int r = 0; r < 16; ++r) ps += p0[r];
#pragma unroll
    for (int r = 0; r < 16; ++r) ps += p1[r];
    { auto rr = __builtin_amdgcn_permlane32_swap(__float_as_uint(ps), __float_as_uint(ps), false, false);
      ps = __uint_as_float(rr[0]) + __uint_as_float(rr[1]); }
    l_reg = l_reg * alpha + ps;
#define PK4(P, BASE, OUT) do { unsigned a0 = cvt_pk_bf16(P[BASE + 0], P[BASE + 1]), a1 = cvt_pk_bf16(P[BASE + 2], P[BASE + 3]);   \
    unsigned b0 = cvt_pk_bf16(P[BASE + 4], P[BASE + 5]), b1 = cvt_pk_bf16(P[BASE + 6], P[BASE + 7]);                              \
    auto r0 = __builtin_amdgcn_permlane32_swap(a0, b0, false, false); auto r1 = __builtin_amdgcn_permlane32_swap(a1, b1, false, false); \
    u32x4 w = {r0[0], r1[0], r0[1], r1[1]}; OUT = *reinterpret_cast<bf16x8*>(&w); } while (0)
    PK4(p0, 0, pa0); PK4(p0, 8, pa1); PK4(p1, 0, pa2); PK4(p1, 8, pa3);
#undef PK4
}

struct Src { const bf16_t* q[3]; const bf16_t* k[3]; const bf16_t* v; int ldq, ldk[3], ldv; };
struct Par { int kt0, nkt; float C, thr; const float* rtab; int qpos0; int na_r0, na_krlo; };

template <int NCH, int MODE, int ROPE_D0S, int ROPE_HW>
__device__ __forceinline__ void attn_pass(LAS unsigned char* lds, const int tid, const Src& S, const Par& P, float& m_reg, float& l_reg, f32x16 (&o)[4]) {
    const int wid = __builtin_amdgcn_readfirstlane(tid >> 6), lane = tid & 63, r32 = lane & 31, hi = lane >> 5;
    LAS float* al_l = (LAS float*)(lds + OFF_WS + wid * 256);
    bf16x8 qr[NCH * 4];
#pragma unroll
    for (int c = 0; c < NCH; ++c)
#pragma unroll
        for (int d = 0; d < 4; ++d) qr[c * 4 + d] = *(const bf16x8*)(S.q[c] + (size_t)(wid * 32 + r32) * S.ldq + d * 16 + hi * 8);
    if constexpr (ROPE_HW > 0) {
        const float* tb = P.rtab + (size_t)(P.qpos0 + wid * 32 + r32) * (ROPE_HW * 32) + hi * 16;
#pragma unroll
        for (int d = 0; d < ROPE_HW; ++d) {
            const f32x4 t0 = *(const f32x4*)(tb + d * 32), t1 = *(const f32x4*)(tb + d * 32 + 4), t2 = *(const f32x4*)(tb + d * 32 + 8), t3 = *(const f32x4*)(tb + d * 32 + 12);
            const float cs[16] = {t0[0], t0[1], t0[2], t0[3], t1[0], t1[1], t1[2], t1[3], t2[0], t2[1], t2[2], t2[3], t3[0], t3[1], t3[2], t3[3]};
            const u32x4 a = *reinterpret_cast<const u32x4*>(&qr[ROPE_D0S + d]), b = *reinterpret_cast<const u32x4*>(&qr[ROPE_D0S + ROPE_HW + d]);
            u32x4 ya, yb;
#pragma unroll
            for (int w = 0; w < 4; ++w) {
                const float x1l = bflo(a[w]), x1h = bfhi(a[w]), x2l = bflo(b[w]), x2h = bfhi(b[w]);
                const float cl = cs[4 * w], sl = cs[4 * w + 1], ch = cs[4 * w + 2], sh = cs[4 * w + 3];
                ya[w] = cvt_pk_bf16(x1l * cl - x2l * sl, x1h * ch - x2h * sh); yb[w] = cvt_pk_bf16(x2l * cl + x1l * sl, x2h * ch + x1h * sh);
            }
            qr[ROPE_D0S + d] = *reinterpret_cast<bf16x8*>(&ya); qr[ROPE_D0S + ROPE_HW + d] = *reinterpret_cast<bf16x8*>(&yb);
        }
    }
    const int krow = tid >> 3, kpc = tid & 7, kst = krow * 128 + ((kpc ^ ((krow >> 1) & 7)) << 4);
    const int sr = tid >> 4, sc = (tid & 15) * 8, vst0 = v_st(sr, sc), vst1 = v_st(32 + sr, sc);
    const int vb0 = (int)(unsigned)(uintptr_t)(lds + OFF_V) + v_rd_base(lane);
    const int ksw = (r32 >> 1) & 7; int kro[4];
#pragma unroll
    for (int d = 0; d < 4; ++d) kro[d] = r32 * 128 + (((d * 2 + hi) ^ ksw) << 4);
    bf16x8 ks[NCH], vs0, vs1;
    unsigned koff[NCH];
#pragma unroll
    for (int c = 0; c < NCH; ++c) koff[c] = (unsigned)(krow * S.ldk[c] + kpc * 8) * 2u;
    const unsigned voff0 = (unsigned)(sr * S.ldv + sc) * 2u, voff1 = (unsigned)((32 + sr) * S.ldv + sc) * 2u;
#define A_SLOAD(k0) do { const int k0_ = __builtin_amdgcn_readfirstlane(k0); _Pragma("unroll") for (int c = 0; c < NCH; ++c) ks[c] = *(const bf16x8*)((const char*)S.k[c] + (size_t)k0_ * S.ldk[c] * 2 + koff[c]); \
        const char* vb_ = (const char*)S.v + (size_t)k0_ * S.ldv * 2; vs0 = *(const bf16x8*)(vb_ + voff0); vs1 = *(const bf16x8*)(vb_ + voff1); } while (0)
#define A_SWRITE(b) do { _Pragma("unroll") for (int c = 0; c < NCH; ++c) *(LAS bf16x8*)(lds + OFF_K + (b) * KBUF + c * KPL + kst) = ks[c]; \
        *(LAS bf16x8*)(lds + OFF_V + (b) * VT + vst0) = vs0; *(LAS bf16x8*)(lds + OFF_V + (b) * VT + vst1) = vs1; } while (0)
    A_SLOAD(P.kt0); VM_WAIT(); A_SWRITE(0); __syncthreads();
    int na_rw = 0, na_rs = 0, na_cq = 0, na_ws = 0, sw_base = 0;
    if constexpr (MODE == 1) { na_rw = P.na_r0 + (wid >> 1); na_rs = min(max(na_rw - 4, 0), 56); na_cq = (wid & 1) * 32 + r32; na_ws = min(max(na_cq - 8, 0), 48); }
    if constexpr (MODE == 2) { sw_base = P.kt0 - (P.qpos0 + wid * 32 + r32) + 128; }
    for (int j = 0; j < P.nkt; ++j) {
        const int b = j & 1;
        if (j + 1 < P.nkt) A_SLOAD(P.kt0 + (j + 1) * 64);
        bool act = true;
        if constexpr (MODE == 1) { const int kr = P.na_krlo + j; act = (kr >= na_rs) && (kr < na_rs + 8); }
        if (act) {
            f32x16 p0 = {}, p1 = {};
            const LAS unsigned char* Kb = lds + OFF_K + b * KBUF;
#pragma unroll
            for (int c = 0; c < NCH; ++c)
#pragma unroll
                for (int d = 0; d < 4; ++d) {
                    const bf16x8 k0v = *(const LAS bf16x8*)(Kb + c * KPL + kro[d]), k1v = *(const LAS bf16x8*)(Kb + c * KPL + 4096 + kro[d]);
                    p0 = __builtin_amdgcn_mfma_f32_32x32x16_bf16(k0v, qr[c * 4 + d], p0, 0, 0, 0);
                    p1 = __builtin_amdgcn_mfma_f32_32x32x16_bf16(k1v, qr[c * 4 + d], p1, 0, 0, 0);
                }
            if constexpr (MODE == 1) {
                const LAS float* bt = (const LAS float*)(lds + OFF_BIAS) + (P.na_krlo + j - na_rw + 7) * 31 + 15;
#pragma unroll
                for (int r = 0; r < 16; ++r) {
                    const int kc0 = crow(r, hi), kc1 = 32 + kc0;
                    const int dc0 = min(max(kc0 - na_cq, -15), 15), dc1 = min(max(kc1 - na_cq, -15), 15);
                    const float b0 = bt[dc0], b1 = bt[dc1];
                    p0[r] = ((unsigned)(kc0 - na_ws) < 16u) ? p0[r] + b0 : -__builtin_inff();
                    p1[r] = ((unsigned)(kc1 - na_ws) < 16u) ? p1[r] + b1 : -__builtin_inff();
                }
            }
            if constexpr (MODE == 2) {
                const int base = sw_base + j * 64;
#pragma unroll
                for (int r = 0; r < 16; ++r) {
                    const int kc0 = crow(r, hi);
                    p0[r] = ((unsigned)(base + kc0) <= 256u) ? p0[r] : -__builtin_inff();
                    p1[r] = ((unsigned)(base + kc0 + 32) <= 256u) ? p1[r] : -__builtin_inff();
                }
            }
            float alpha;
            partialSM(p0, p1, m_reg, alpha, P.C, P.thr);
            if (__any(alpha < 1.f)) {
                if (hi == 0) al_l[r32] = alpha;
                asm volatile("s_waitcnt lgkmcnt(0)" ::: "memory");
#pragma unroll
                for (int r = 0; r < 16; ++r) { const float a = al_l[crow(r, hi)];
#pragma unroll
                    for (int d = 0; d < 4; ++d) o[d][r] *= a; }
            }
            bf16x8 pa0, pa1, pa2, pa3;
            finishSM(p0, p1, alpha, l_reg, pa0, pa1, pa2, pa3); SBAR();
            const int vb = vb0 + b * VT;
            pv_one<0>(o[0], vb, pa0, pa1, pa2, pa3); pv_one<1>(o[1], vb, pa0, pa1, pa2, pa3); pv_one<2>(o[2], vb, pa0, pa1, pa2, pa3); pv_one<3>(o[3], vb, pa0, pa1, pa2, pa3);
        }
        if (j + 1 < P.nkt) { VM_WAIT(); A_SWRITE(b ^ 1); }
        __syncthreads();
    }
#undef A_SLOAD
#undef A_SWRITE
}

__device__ __forceinline__ void partialSM2(f32x16& p0, f32x16& p1, float& m_reg, float& alpha, const float C, const float thr, const float pofs = 0.f) {
    float pmax = p0[0];
#pragma unroll
    for (int r = 1; r < 16; ++r) pmax = fmaxf(pmax, p0[r]);
#pragma unroll
    for (int r = 0; r < 16; ++r) pmax = fmaxf(pmax, p1[r]);
    { auto rr = __builtin_amdgcn_permlane32_swap(__float_as_uint(pmax), __float_as_uint(pmax), false, false);
      pmax = fmaxf(__uint_as_float(rr[0]), __uint_as_float(rr[1])); }
    float mn;
    if (__builtin_expect(__all(pmax - m_reg <= thr), 1)) { mn = m_reg; alpha = 1.f; }
    else { mn = fmaxf(m_reg, pmax); alpha = __builtin_amdgcn_exp2f((m_reg - mn) * C); m_reg = mn; }
    const float mnC = -mn * C + pofs;
#pragma unroll
    for (int r = 0; r < 16; ++r) p0[r] = fmaf(p0[r], C, mnC);
#pragma unroll
    for (int r = 0; r < 16; ++r) p1[r] = fmaf(p1[r], C, mnC);
#pragma unroll
    for (int r = 0; r < 16; ++r) p0[r] = __builtin_amdgcn_exp2f(p0[r]);
}
__device__ __forceinline__ void finishSM2(f32x16& p0, f32x16& p1, float alpha, float& l_reg, bf16x8& pa0, bf16x8& pa1, bf16x8& pa2, bf16x8& pa3) {
#pragma unroll
    for (int r = 0; r < 16; ++r) p1[r] = __builtin_amdgcn_exp2f(p1[r]);
    finishSM(p0, p1, alpha, l_reg, pa0, pa1, pa2, pa3);
}
typedef __bf16 bf16x2_t __attribute__((ext_vector_type(2)));
typedef short s16x2_t __attribute__((ext_vector_type(2)));
__device__ __forceinline__ unsigned cvt4_fp8_bf16(unsigned a, unsigned b) {
    s16x2_t r = {0, 0}; r = __builtin_amdgcn_cvt_scalef32_pk_fp8_bf16(r, __builtin_bit_cast(bf16x2_t, a), 1.0f, false); r = __builtin_amdgcn_cvt_scalef32_pk_fp8_bf16(r, __builtin_bit_cast(bf16x2_t, b), 1.0f, true);
    return __builtin_bit_cast(unsigned, r); }
__device__ __forceinline__ u32x2 cvt8_fp8_bf16(const u32x4 w) { u32x2 e; e.x = cvt4_fp8_bf16(w.x, w.y); e.y = cvt4_fp8_bf16(w.z, w.w); return e; }
__device__ __forceinline__ void finishSM8(f32x16& p0, f32x16& p1, float alpha, float& l_reg, v8i_t& pa8) {
#pragma unroll
    for (int r = 0; r < 16; ++r) p1[r] = __builtin_amdgcn_exp2f(p1[r]);
    float ps = 0;
#pragma unroll
    for (int r = 0; r < 16; ++r) ps += p0[r];
#pragma unroll
    for (int r = 0; r < 16; ++r) ps += p1[r];
    { auto rr = __builtin_amdgcn_permlane32_swap(__float_as_uint(ps), __float_as_uint(ps), false, false);
      ps = __uint_as_float(rr[0]) + __uint_as_float(rr[1]); }
    l_reg = l_reg * alpha + ps;
#pragma unroll
    for (int k = 0; k < 4; ++k) {
        pa8[k] = __builtin_amdgcn_cvt_pk_fp8_f32(p0[4 * k + 2], p0[4 * k + 3], __builtin_amdgcn_cvt_pk_fp8_f32(p0[4 * k], p0[4 * k + 1], 0, false), true);
        pa8[4 + k] = __builtin_amdgcn_cvt_pk_fp8_f32(p1[4 * k + 2], p1[4 * k + 3], __builtin_amdgcn_cvt_pk_fp8_f32(p1[4 * k], p1[4 * k + 1], 0, false), true); }
}
template <int OFF> __device__ __forceinline__ u32x2 tr8_read(int vb) {
    u32x2 r; asm volatile("ds_read_b64_tr_b8 %0, %1 offset:%2" : "=&v"(r) : "v"(vb), "i"(OFF) : "memory"); return r;
}
template <int D0> __device__ __forceinline__ void pv8_one(f32x16& od, int vb, const v8i_t pa8) {
    const u32x2 t0 = tr8_read<D0 * 256>(vb), t1 = tr8_read<D0 * 256 + 2048>(vb), t2 = tr8_read<D0 * 256 + 4096>(vb), t3 = tr8_read<D0 * 256 + 6144>(vb);
    asm volatile("s_waitcnt lgkmcnt(0)" ::: "memory"); SBAR();
    const v8i_t vf = {(int)t0.x, (int)t0.y, (int)t1.x, (int)t1.y, (int)t2.x, (int)t2.y, (int)t3.x, (int)t3.y};
    od = __builtin_amdgcn_mfma_scale_f32_32x32x64_f8f6f4(pa8, vf, od, 0, 0, 0, 0x7f7f7f7f, 0, 0x7f7f7f7f);
}
template <int NCH, int ROPE_D0S, int ROPE_HW, int SDEPTH, int QLDS, int K8 = 0>
__device__ __forceinline__ void attn_pass_pipe(LAS unsigned char* lds, const int tid, const Src& S, const Par& P, float& m_reg, float& l_reg, f32x16 (&o)[4]) {
    const int wid = __builtin_amdgcn_readfirstlane(tid >> 6), lane = tid & 63, r32 = lane & 31, hi = lane >> 5;
    LAS float* al_l = (LAS float*)(lds + OFF_WS + wid * 256);
    bf16x8 qr[NCH * 4];
#pragma unroll
    for (int c = 0; c < NCH; ++c)
#pragma unroll
        for (int d = 0; d < 4; ++d) qr[c * 4 + d] = *(const bf16x8*)(S.q[c] + (size_t)(wid * 32 + r32) * S.ldq + d * 16 + hi * 8);
    v8i_t q8[K8 ? NCH : 1]; (void)q8;
#define P_Q8(c) do { _Pragma("unroll") for (int d = 0; d < 4; ++d) { const u32x2 e_ = cvt8_fp8_bf16(*reinterpret_cast<const u32x4*>(&qr[(c) * 4 + d])); q8[c][d * 2] = (int)e_.x; q8[c][d * 2 + 1] = (int)e_.y; } } while (0)
    if constexpr (K8) {
#pragma unroll
        for (int c = 0; c < NCH; ++c) if (ROPE_HW == 0 || c * 4 + 3 < ROPE_D0S) P_Q8(c);
    }
    if constexpr (ROPE_HW > 0) {
        const float* tb = P.rtab + (size_t)(P.qpos0 + wid * 32 + r32) * (ROPE_HW * 32) + hi * 16;
#pragma unroll
        for (int d = 0; d < ROPE_HW; ++d) {
            const f32x4 t0 = *(const f32x4*)(tb + d * 32), t1 = *(const f32x4*)(tb + d * 32 + 4), t2 = *(const f32x4*)(tb + d * 32 + 8), t3 = *(const f32x4*)(tb + d * 32 + 12);
            const float cs[16] = {t0[0], t0[1], t0[2], t0[3], t1[0], t1[1], t1[2], t1[3], t2[0], t2[1], t2[2], t2[3], t3[0], t3[1], t3[2], t3[3]};
            const u32x4 a = *reinterpret_cast<const u32x4*>(&qr[ROPE_D0S + d]), b = *reinterpret_cast<const u32x4*>(&qr[ROPE_D0S + ROPE_HW + d]);
            u32x4 ya, yb;
#pragma unroll
            for (int w = 0; w < 4; ++w) {
                const float x1l = bflo(a[w]), x1h = bfhi(a[w]), x2l = bflo(b[w]), x2h = bfhi(b[w]);
                const float cl = cs[4 * w], sl = cs[4 * w + 1], ch = cs[4 * w + 2], sh = cs[4 * w + 3];
                ya[w] = cvt_pk_bf16(x1l * cl - x2l * sl, x1h * ch - x2h * sh); yb[w] = cvt_pk_bf16(x2l * cl + x1l * sl, x2h * ch + x1h * sh);
            }
            qr[ROPE_D0S + d] = *reinterpret_cast<bf16x8*>(&ya); qr[ROPE_D0S + ROPE_HW + d] = *reinterpret_cast<bf16x8*>(&yb);
        }
    }
    const int krow = tid >> 3, kpc = tid & 7, kst = krow * 128 + ((kpc ^ ((krow >> 1) & 7)) << 4);
    const int sr = tid >> 4, sc = (tid & 15) * 8, vst0 = v_st(sr, sc), vst1 = v_st(32 + sr, sc);
    const int vb0 = (int)(unsigned)(uintptr_t)(lds + OFF_V) + v_rd_base(lane);
    const int ksw = (r32 >> 1) & 7; int kro[4];
#pragma unroll
    for (int d = 0; d < 4; ++d) kro[d] = r32 * 128 + (((d * 2 + hi) ^ ksw) << 4);
    LAS unsigned char* qlds = lds + OFF_QL + wid * (QLDS > 0 ? QLDS : 1) * 4096 + lane * 16;
    if constexpr (QLDS > 0) {
#pragma unroll
        for (int c = NCH - QLDS; c < NCH; ++c)
#pragma unroll
            for (int d = 0; d < 4; ++d) *(LAS bf16x8*)(qlds + ((c - (NCH - QLDS)) * 4 + d) * 1024) = qr[c * 4 + d];
        asm volatile("s_waitcnt lgkmcnt(0)" ::: "memory");
    }
    if constexpr (K8) {
        static_assert(QLDS == 0, "K8: Q stays in registers");
#pragma unroll
        for (int c = 0; c < NCH; ++c) if (!(ROPE_HW == 0 || c * 4 + 3 < ROPE_D0S)) P_Q8(c);
    }
#undef P_Q8
    constexpr int KS8 = (NCH == 1) ? 80 : 208;
    const int kst8 = krow * KS8 + (kpc & 1) * 32 + (kpc >> 1) * 8, kro8 = r32 * KS8 + hi * 32; (void)kst8; (void)kro8;
    const int vst8 = (((sr >> 4) * 2 + ((sr >> 2) & 1)) * 8 + (sc >> 4)) * 128 + ((sr & 3) | (((sr >> 3) & 1) << 2)) * 16 + ((sc >> 3) & 1) * 8;
    const int vb8 = (int)(unsigned)(uintptr_t)(lds + OFF_V) + (lane >> 5) * 1024 + ((lane >> 4) & 1) * 128 + ((lane & 15) >> 1) * 16 + (lane & 1) * 8; (void)vst8; (void)vb8;
    v8i_t pa8; (void)pa8;
    struct Slot { bf16x8 ks[NCH], vs0, vs1; } st[SDEPTH];
    constexpr int SE = 0, SO = SDEPTH - 1;
    unsigned koff[NCH];
#pragma unroll
    for (int c = 0; c < NCH; ++c) koff[c] = (unsigned)(krow * S.ldk[c] + kpc * 8) * 2u;
    const unsigned voff0 = (unsigned)(sr * S.ldv + sc) * 2u, voff1 = (unsigned)((32 + sr) * S.ldv + sc) * 2u;
#define P_SLOAD(i, k0) do { const int k0_ = __builtin_amdgcn_readfirstlane(k0); _Pragma("unroll") for (int c = 0; c < NCH; ++c) st[i].ks[c] = *(const bf16x8*)((const char*)S.k[c] + (size_t)k0_ * S.ldk[c] * 2 + koff[c]); \
        const char* vb_ = (const char*)S.v + (size_t)k0_ * S.ldv * 2; st[i].vs0 = *(const bf16x8*)(vb_ + voff0); st[i].vs1 = *(const bf16x8*)(vb_ + voff1); } while (0)
#define P_SWRITE(b, i) do { if constexpr (K8) { _Pragma("unroll") for (int c = 0; c < NCH; ++c) { *(LAS u32x2*)(lds + OFF_K + (b) * KBUF + c * 64 + kst8) = cvt8_fp8_bf16(*reinterpret_cast<const u32x4*>(&st[i].ks[c])); } } \
        else { _Pragma("unroll") for (int c = 0; c < NCH; ++c) *(LAS bf16x8*)(lds + OFF_K + (b) * KBUF + c * KPL + kst) = st[i].ks[c]; } \
        if constexpr (K8) { *(LAS u32x2*)(lds + OFF_V + (b) * VT + vst8) = cvt8_fp8_bf16(*reinterpret_cast<const u32x4*>(&st[i].vs0)); *(LAS u32x2*)(lds + OFF_V + (b) * VT + vst8 + 4096) = cvt8_fp8_bf16(*reinterpret_cast<const u32x4*>(&st[i].vs1)); } \
        else { *(LAS bf16x8*)(lds + OFF_V + (b) * VT + vst0) = st[i].vs0; *(LAS bf16x8*)(lds + OFF_V + (b) * VT + vst1) = st[i].vs1; } } while (0)
#define P_SWAIT() do { if constexpr (SDEPTH == 2) { if constexpr (NCH == 1) asm volatile("s_waitcnt vmcnt(3)" ::: "memory"); else if constexpr (NCH == 2) asm volatile("s_waitcnt vmcnt(4)" ::: "memory"); else asm volatile("s_waitcnt vmcnt(5)" ::: "memory"); } \
        else asm volatile("s_waitcnt vmcnt(0)" ::: "memory"); } while (0)
#define P_QKT(p0, p1, b) do { p0 = f32x16{}; p1 = f32x16{}; const LAS unsigned char* Kb_ = lds + OFF_K + (b) * KBUF; \
        if constexpr (K8) { _Pragma("unroll") for (int c = 0; c < NCH; ++c) { \
            const v4i_t a0_ = *(const LAS v4i_t*)(Kb_ + c * 64 + kro8), a1_ = *(const LAS v4i_t*)(Kb_ + c * 64 + kro8 + 16), b0_ = *(const LAS v4i_t*)(Kb_ + 32 * KS8 + c * 64 + kro8), b1_ = *(const LAS v4i_t*)(Kb_ + 32 * KS8 + c * 64 + kro8 + 16); \
            p0 = __builtin_amdgcn_mfma_scale_f32_32x32x64_f8f6f4(__builtin_shufflevector(a0_, a1_, 0, 1, 2, 3, 4, 5, 6, 7), q8[c], p0, 0, 0, 0, 0x7f7f7f7f, 0, 0x7f7f7f7f); \
            p1 = __builtin_amdgcn_mfma_scale_f32_32x32x64_f8f6f4(__builtin_shufflevector(b0_, b1_, 0, 1, 2, 3, 4, 5, 6, 7), q8[c], p1, 0, 0, 0, 0x7f7f7f7f, 0, 0x7f7f7f7f); } } else \
        _Pragma("unroll") for (int c = 0; c < NCH; ++c) _Pragma("unroll") for (int d = 0; d < 4; ++d) { \
            const bf16x8 k0v = *(const LAS bf16x8*)(Kb_ + c * KPL + kro[d]), k1v = *(const LAS bf16x8*)(Kb_ + c * KPL + 4096 + kro[d]); \
            const bf16x8 qv_ = (c < NCH - QLDS) ? qr[c * 4 + d] : *(const LAS bf16x8*)(qlds + ((c - (NCH - QLDS)) * 4 + d) * 1024); \
            p0 = __builtin_amdgcn_mfma_f32_32x32x16_bf16(k0v, qv_, p0, 0, 0, 0); p1 = __builtin_amdgcn_mfma_f32_32x32x16_bf16(k1v, qv_, p1, 0, 0, 0); } } while (0)
#define P_FIN(pX0, pX1, alX) do { if constexpr (K8) finishSM8(pX0, pX1, alX, l_reg, pa8); else finishSM2(pX0, pX1, alX, l_reg, pa0, pa1, pa2, pa3); } while (0)
#define P_PV(b) do { if constexpr (K8) { const int vb_ = vb8 + (b) * VT; pv8_one<0>(o[0], vb_, pa8); pv8_one<1>(o[1], vb_, pa8); pv8_one<2>(o[2], vb_, pa8); pv8_one<3>(o[3], vb_, pa8); } else { const int vb_ = vb0 + (b) * VT; pv_one<0>(o[0], vb_, pa0, pa1, pa2, pa3); pv_one<1>(o[1], vb_, pa0, pa1, pa2, pa3); pv_one<2>(o[2], vb_, pa0, pa1, pa2, pa3); pv_one<3>(o[3], vb_, pa0, pa1, pa2, pa3); } } while (0)
#define P_RESC(a) do { if (__any((a) < 1.f)) { if (hi == 0) al_l[r32] = (a); asm volatile("s_waitcnt lgkmcnt(0)" ::: "memory"); \
        _Pragma("unroll") for (int r = 0; r < 16; ++r) { const float a_ = al_l[crow(r, hi)]; _Pragma("unroll") for (int d = 0; d < 4; ++d) o[d][r] *= a_; } } } while (0)
    f32x16 pA0, pA1, pB0, pB1; float alA, alB; bf16x8 pa0, pa1, pa2, pa3; const int NT = P.nkt, kt0 = P.kt0;
    __syncthreads();
    P_SLOAD(SE, kt0); VM_WAIT(); P_SWRITE(0, SE); __syncthreads();
    P_QKT(pA0, pA1, 0); partialSM2(pA0, pA1, m_reg, alA, P.C, P.thr, K8 ? 4.0f : 0.f);
    P_SLOAD(SO, kt0 + 64); if constexpr (SDEPTH == 2) { P_SLOAD(SE, kt0 + 128); }
    P_SWAIT(); P_SWRITE(1, SO); __syncthreads();
    for (int j = 1; j + 1 < NT; j += 2) {
        SBAR(); P_QKT(pB0, pB1, 1);
        P_FIN(pA0, pA1, alA); SBAR();
        P_SLOAD(SO, kt0 + (j + SDEPTH) * 64); SBAR();
        P_PV(0); partialSM2(pB0, pB1, m_reg, alB, P.C, P.thr, K8 ? 4.0f : 0.f);
        __syncthreads(); P_SWAIT(); P_SWRITE(0, SE);
        P_RESC(alB); __syncthreads();
        SBAR(); P_QKT(pA0, pA1, 0);
        P_FIN(pB0, pB1, alB); SBAR();
        if (SDEPTH == 1 || j + 3 < NT) P_SLOAD(SE, kt0 + (j + 1 + SDEPTH) * 64); SBAR();
        P_PV(1); partialSM2(pA0, pA1, m_reg, alA, P.C, P.thr, K8 ? 4.0f : 0.f);
        __syncthreads(); P_SWAIT(); P_SWRITE(1, SO);
        P_RESC(alA); __syncthreads();
    }
    SBAR(); P_QKT(pB0, pB1, 1);
    P_FIN(pA0, pA1, alA); SBAR();
    P_PV(0); partialSM2(pB0, pB1, m_reg, alB, P.C, P.thr, K8 ? 4.0f : 0.f);
    P_RESC(alB);
    P_FIN(pB0, pB1, alB); SBAR();
    P_PV(1);
#undef P_SLOAD
#undef P_SWRITE
#undef P_SWAIT
#undef P_QKT
#undef P_PV
#undef P_FIN
#undef P_RESC
}
__device__ __forceinline__ void normalize(LAS unsigned char* lds, const int tid, const float l_reg, f32x16 (&o)[4]) {
    const int wid = __builtin_amdgcn_readfirstlane(tid >> 6), lane = tid & 63, r32 = lane & 31, hi = lane >> 5;
    LAS float* li_l = (LAS float*)(lds + OFF_WS + wid * 256) + 32;
    if (hi == 0) li_l[r32] = l_reg;
    asm volatile("s_waitcnt lgkmcnt(0)" ::: "memory");
#pragma unroll
    for (int r = 0; r < 16; ++r) { const float rl = __builtin_amdgcn_rcpf(li_l[crow(r, hi)]);
#pragma unroll
        for (int d = 0; d < 4; ++d) o[d][r] *= rl; }
    asm volatile("s_waitcnt lgkmcnt(0)" ::: "memory");
}
__device__ __forceinline__ void store_o(bf16_t* O, const int ldo, const int tid, const f32x16 (&o)[4]) {
    const int wid = __builtin_amdgcn_readfirstlane(tid >> 6), lane = tid & 63, r32 = lane & 31, hi = lane >> 5;
#pragma unroll
    for (int r = 0; r < 16; ++r) { bf16_t* rowp = O + (size_t)(wid * 32 + crow(r, hi)) * ldo + r32;
#pragma unroll
        for (int d = 0; d < 4; ++d) rowp[d * 32] = f2bf(o[d][r]); }
}
__device__ __forceinline__ void store_o8(unsigned char* O8, const int ldo, const int tid, const f32x16 (&o)[4]) {
    const int wid = __builtin_amdgcn_readfirstlane(tid >> 6), lane = tid & 63, r32 = lane & 31, hi = lane >> 5;
#pragma unroll
    for (int r = 0; r < 16; ++r) { unsigned char* rowp = O8 + (size_t)(wid * 32 + crow(r, hi)) * ldo + r32;
#pragma unroll
        for (int d = 0; d < 4; ++d) rowp[d * 32] = (unsigned char)(signed char)(int)rintf(__builtin_amdgcn_fmed3f(o[d][r] * (127.0f / 1.5f), -127.f, 127.f)); }
}
}

#if NAIVE_ATTN
template <int MODE>
__global__ void __launch_bounds__(256) naive_attn(Args args, int layer) {
    unsigned char* ws = args.ws;
    const bf16_t* z = (const bf16_t*)(ws + WS_Z); bf16_t* mix = (bf16_t*)(ws + WS_MIX);
    const float* tab64 = (const float*)(ws + WS_TAB64); const float* tab128 = (const float*)(ws + WS_TAB128);
    const int lane = threadIdx.x & 63; const int gw = blockIdx.x * 4 + (threadIdx.x >> 6);
    const int b = gw / (4 * SEQ), h = (gw / SEQ) & 3, i = gw % SEQ; const size_t rb = (size_t)b * SEQ;
    if constexpr (MODE == 0) {
        float lam; { float a = lane < 64 ? args.in[I_LQ1][layer * 64 + lane] * args.in[I_LK1][layer * 64 + lane] : 0.f, c = args.in[I_LQ2][layer * 64 + lane] * args.in[I_LK2][layer * 64 + lane];
            const float li = 0.8f - 0.6f * expf(-0.3f * layer); lam = expf(wave_sum(a)) - expf(wave_sum(c)) + li; }
        const float li = 0.8f - 0.6f * expf(-0.3f * layer);
        float oc[2][2];
        for (int comp = 0; comp < 2; ++comp) {
            float q = bf2f(z[(rb + i) * ZP + h * 128 + comp * 64 + lane]);
            { const float qo = __shfl_xor(q, 32); const int j = lane & 31; const float c = tab64[((size_t)i * 32 + j) * 2], s = tab64[((size_t)i * 32 + j) * 2 + 1];
              q = lane < 32 ? q * c - qo * s : q * c + qo * s; }
            float m = -1e30f, l = 0.f, o0 = 0.f, o1 = 0.f;
            for (int k = 0; k < SEQ; ++k) {
                const float kk = bf2f(z[(rb + k) * ZP + 512 + h * 128 + comp * 64 + lane]);
                const float s = wave_sum(q * kk) * 0.125f;
                const float mn = fmaxf(m, s), al = __expf(m - mn), p = __expf(s - mn);
                l = l * al + p; o0 = o0 * al + p * bf2f(z[(rb + k) * ZP + 1024 + h * 128 + lane]); o1 = o1 * al + p * bf2f(z[(rb + k) * ZP + 1024 + h * 128 + 64 + lane]); m = mn;
            }
            oc[comp][0] = o0 / l; oc[comp][1] = o1 / l;
        }
        const float a0 = oc[0][0] - lam * oc[1][0], a1 = oc[0][1] - lam * oc[1][1];
        const float r = 1.0f / sqrtf(wave_sum(a0 * a0 + a1 * a1) * (1.0f / 128) + EPS);
        mix[(rb + i) * DM + h * 128 + lane] = f2bf(a0 * r * args.in[I_SUBLN][layer * 128 + lane] * (1.f - li));
        mix[(rb + i) * DM + h * 128 + 64 + lane] = f2bf(a1 * r * args.in[I_SUBLN][layer * 128 + 64 + lane] * (1.f - li));
    } else if constexpr (MODE == 1) {
        const float* rpb = args.in[I_RPB] + ((size_t)layer * 4 + h) * 15 * 31;
        const int r = i >> 6, c = i & 63, rs = min(max(r - 4, 0), 56), wsx = min(max(c - 8, 0), 48);
        const float q0 = bf2f(z[(rb + i) * ZP + O_NA + h * 128 + lane]), q1 = bf2f(z[(rb + i) * ZP + O_NA + h * 128 + 64 + lane]);
        float m = -1e30f, l = 0.f, o0 = 0.f, o1 = 0.f;
        for (int a = 0; a < 8; ++a) for (int cc = 0; cc < 16; ++cc) {
            const int kr = rs + a, kc = wsx + cc; const size_t kt = rb + kr * 64 + kc;
            const float s = wave_sum(q0 * bf2f(z[kt * ZP + O_NA + 512 + h * 128 + lane]) + q1 * bf2f(z[kt * ZP + O_NA + 512 + h * 128 + 64 + lane])) * 0.08838834764831845f + rpb[(kr - r + 7) * 31 + (kc - c + 15)];
            const float mn = fmaxf(m, s), al = __expf(m - mn), p = __expf(s - mn);
            l = l * al + p; o0 = o0 * al + p * bf2f(z[kt * ZP + O_NA + 1024 + h * 128 + lane]); o1 = o1 * al + p * bf2f(z[kt * ZP + O_NA + 1024 + h * 128 + 64 + lane]); m = mn;
        }
        mix[(rb + i) * DM + 512 + h * 128 + lane] = f2bf(o0 / l); mix[(rb + i) * DM + 512 + h * 128 + 64 + lane] = f2bf(o1 / l);
    } else if constexpr (MODE == 2) {
        const int kvh = h >> 1;
        float q0 = bf2f(z[(rb + i) * ZP + O_SWA + h * 128 + lane]), q1 = bf2f(z[(rb + i) * ZP + O_SWA + h * 128 + 64 + lane]);
        { const float c = tab128[((size_t)i * 64 + lane) * 2], s = tab128[((size_t)i * 64 + lane) * 2 + 1]; const float a = q0 * c - q1 * s, d = q1 * c + q0 * s; q0 = a; q1 = d; }
        float m = args.in[I_SINKS][layer * 4 + h], l = 1.f, o0 = 0.f, o1 = 0.f;
        for (int k = max(0, i - 128); k <= min(SEQ - 1, i + 128); ++k) {
            const size_t kt = rb + k;
            const float s = wave_sum(q0 * bf2f(z[kt * ZP + O_SWA + 512 + kvh * 128 + lane]) + q1 * bf2f(z[kt * ZP + O_SWA + 512 + kvh * 128 + 64 + lane])) * 0.08838834764831845f;
            const float mn = fmaxf(m, s), al = __expf(m - mn), p = __expf(s - mn);
            l = l * al + p; o0 = o0 * al + p * bf2f(z[kt * ZP + O_SWA + 768 + kvh * 128 + lane]); o1 = o1 * al + p * bf2f(z[kt * ZP + O_SWA + 768 + kvh * 128 + 64 + lane]); m = mn;
        }
        mix[(rb + i) * DM + 1024 + h * 128 + lane] = f2bf(o0 / l); mix[(rb + i) * DM + 1024 + h * 128 + 64 + lane] = f2bf(o1 / l);
    } else {
        const bf16_t* qm = (const bf16_t*)(ws + WS_QM); const bf16_t* kvm = (const bf16_t*)(ws + WS_KVM);
        const float q0 = bf2f(qm[(rb + i) * QMW + h * 192 + lane]), q1 = bf2f(qm[(rb + i) * QMW + h * 192 + 64 + lane]); float q2 = bf2f(qm[(rb + i) * QMW + h * 192 + 128 + lane]);
        { const float qo = __shfl_xor(q2, 32); const int j = lane & 31; const float c = tab64[((size_t)i * 32 + j) * 2], s = tab64[((size_t)i * 32 + j) * 2 + 1];
          q2 = lane < 32 ? q2 * c - qo * s : q2 * c + qo * s; }
        float m = -1e30f, l = 0.f, o0 = 0.f, o1 = 0.f;
        for (int k = 0; k < SEQ; ++k) {
            const size_t kt = rb + k;
            const float s = wave_sum(q0 * bf2f(kvm[kt * KVW + h * 256 + lane]) + q1 * bf2f(kvm[kt * KVW + h * 256 + 64 + lane]) + q2 * bf2f(z[kt * ZP + 5120 + lane])) * 0.07216878364870322f;
            const float mn = fmaxf(m, s), al = __expf(m - mn), p = __expf(s - mn);
            l = l * al + p; o0 = o0 * al + p * bf2f(kvm[kt * KVW + h * 256 + 128 + lane]); o1 = o1 * al + p * bf2f(kvm[kt * KVW + h * 256 + 192 + lane]); m = mn;
        }
        mix[(rb + i) * DM + 1536 + h * 128 + lane] = f2bf(o0 / l); mix[(rb + i) * DM + 1536 + h * 128 + 64 + lane] = f2bf(o1 / l);
    }
}
#endif

#define QUANT_ROWS(HSRC, SSP) do { const float* ssp = (SSP); \
    for (int m = gw; m < NTOK; m += NGW) { \
        const f32x4 pa_ = *(const f32x4*)(ssp + (size_t)m * 8), pb_ = *(const f32x4*)(ssp + (size_t)m * 8 + 4); \
        const float ri = 1.0f / sqrtf((((pa_[0] + pa_[1]) + (pa_[2] + pa_[3])) + ((pb_[0] + pb_[1]) + (pb_[2] + pb_[3]))) * (1.0f / DM) + EPS); \
        const u32x2* xr = (const u32x2*)((HSRC) + (size_t)m * DM) + lane; unsigned* hq = (unsigned*)(ws + WS_HQ8 + (size_t)m * DM) + lane; \
        u32x2 w_[8]; float am = 0.f; \
        _Pragma("unroll") for (int j = 0; j < 8; ++j) { w_[j] = xr[64 * j]; am = fmaxf(am, fmaxf(fmaxf(fabsf(bflo(w_[j].x)), fabsf(bfhi(w_[j].x))), fmaxf(fabsf(bflo(w_[j].y)), fabsf(bfhi(w_[j].y))))); } \
        am = fmaxf(wave_max(am), 1e-20f); const float sq_ = 127.0f / am; \
        if (lane == 0) TRINV[m] = am * ri * (1.0f / (127.0f * 1536.0f)); \
        _Pragma("unroll") for (int j = 0; j < 8; ++j) hq[64 * j] = pk4_i8(bflo(w_[j].x) * sq_, bfhi(w_[j].x) * sq_, bflo(w_[j].y) * sq_, bfhi(w_[j].y) * sq_); \
    } } while (0)
constexpr int PH_PER_LAYER = 12, N_PHASES = 1 + DEPTH * PH_PER_LAYER;

#define INP(i) ((const float*)(const GAS float*)args.in[opaque_idx(i)])
__device__ __forceinline__ int opaque_idx(int i) { asm volatile("" : "+s"(i)); return i; }
__global__ void __launch_bounds__(NTHR, 2) fwd(Args args) {
    extern __shared__ __attribute__((aligned(16))) unsigned char lds_raw[];
    for (int u = threadIdx.x; u < 1024; u += NTHR) ((LAS unsigned*)((LAS unsigned char*)lds_raw + MISC_OFF))[u] = 0u;
    __syncthreads();
#if MK_ONE_LAUNCH
    { (void)xcd_barrier_post((unsigned*)(args.ws + WS_CTL) + CW_BAR, (volatile LAS unsigned*)((LAS unsigned char*)lds_raw + MISC_OFF) + 8, threadIdx.x == 0); }
#define GRID_BAR() do { unsigned on_ = ~0u; asm volatile("" : "+s"(on_)); int l_ = __builtin_amdgcn_mbcnt_hi(on_, __builtin_amdgcn_mbcnt_lo(on_, 0u)); XcdBarrier b_; \
    unsigned long long wsb_ = (unsigned long long)args.ws; asm volatile("" : "+s"(wsb_)); b_.bar = (unsigned*)(GAS unsigned*)(wsb_ + WS_CTL) + CW_BAR; b_.x = xb_xcc_id(); \
    b_.st = (volatile LAS unsigned*)((LAS unsigned char*)lds_raw + MISC_OFF) + 8; xcd_barrier(b_, (l_ == 0) && (wave_s == 0)); } while (0)
#else
#define GRID_BAR() do {} while (0)
#endif
    const int wave_s = __builtin_amdgcn_readfirstlane((int)threadIdx.x >> 6);
    const int lo = args.ph_lo, hi = args.ph_hi;
#ifndef PH_MASK
#define PH_MASK 0xFFFFFFFFu
#endif
#define INREL(rel) ((PH_MASK >> (rel)) & 1u)
#ifndef PROBE_REP
#define PROBE_REP -1
#endif
#define NREP(rel) ((PROBE_REP) == (rel) ? 2 : 1)
#define IN(k) (lo <= (k) && (k) < hi)
#define SEAM(k) do { if (IN(k) && IN((k) + 1)) GRID_BAR(); } while (0)
#define PH_LOCALS \
    unsigned ones_o = ~0u; asm volatile("" : "+s"(ones_o)); \
    int lane_o = __builtin_amdgcn_mbcnt_hi(ones_o, __builtin_amdgcn_mbcnt_lo(ones_o, 0u)); asm volatile("" : "+v"(lane_o)); \
    int wave_o = wave_s; asm volatile("" : "+s"(wave_o)); const int tid_o = wave_o * 64 + lane_o; \
    unsigned long long ws_q = (unsigned long long)args.ws; asm volatile("" : "+s"(ws_q)); unsigned char* ws = (unsigned char*)(GAS unsigned char*)ws_q; \
    unsigned long long out_q = (unsigned long long)args.out; asm volatile("" : "+s"(out_q)); float* OUTP = (float*)(GAS float*)out_q; \
    Frame F; F.lds = (LAS unsigned char*)lds_raw; F.MISC = (volatile LAS unsigned*)(F.lds + MISC_OFF); \
    F.tid = tid_o; F.lane = lane_o; F.wave = wave_o; F.G = gridDim.x; \
    { const int bx = blockIdx.x; F.vcu = (F.G % 8 == 0) ? (bx % 8) * (F.G / 8) + bx / 8 : bx; } \
    const int gw = F.vcu * NWAVES + F.wave, NGW = F.G * NWAVES, lane = F.lane; \
    unsigned* ctl = (unsigned*)(ws + WS_CTL); \
    bf16_t* HN = (bf16_t*)(ws + WS_HN); bf16_t* Z = (bf16_t*)(ws + WS_Z); bf16_t* MIX = (bf16_t*)(ws + WS_MIX); \
    bf16_t* QM = (bf16_t*)(ws + WS_QM); bf16_t* KVM = (bf16_t*)(ws + WS_KVM); bf16_t* PPB = (bf16_t*)(ws + WS_PP); \
    bf16_t* ACT = (bf16_t*)(ws + WS_ACT); bf16_t* XG = (bf16_t*)(ws + WS_XG); bf16_t* HB2 = (bf16_t*)(ws + WS_HB2); (void)HB2; \
    float* tab64 = (float*)(ws + WS_TAB64); float* tab128 = (float*)(ws + WS_TAB128); \
    unsigned* MOEI = (unsigned*)(ws + WS_MOEI); float* SSH = (float*)(ws + WS_SSH); float* TRINV = (float*)(ws + WS_TRINV); float* SRINV = (float*)(ws + WS_SRINV); \
    LAS float* RED = (LAS float*)(F.lds + RED_OFF); (void)SSH; (void)TRINV; (void)SRINV; (void)RED; \
    (void)gw; (void)NGW; (void)lane; (void)ctl; (void)HN; (void)Z; (void)MIX; (void)QM; (void)KVM; (void)PPB; (void)ACT; (void)XG; (void)tab64; (void)tab128; (void)MOEI; (void)OUTP;

    for (int rep_ = 0; rep_ < NREP(31); ++rep_) if (INREL(31) && IN(0)) { PH_LOCALS
        LAS float* scr = (LAS float*)(F.lds + RING_OFF + F.wave * 16384);
        for (int it = gw; it < IT_TOTAL; it += NGW) {
            int r = it;
            if (r < 2 * IT_LAYER) {
                const int L = r / IT_LAYER; r -= L * IT_LAYER;
                if (r < IT_WIN) { transpose_job(INP(I_W_IN) + (size_t)L * DM * ZC, DM, ZC, (bf16_t*)(ws + WS_WIN + L * SZ_WIN), 3, r, scr, lane, INP(I_ATTN_NORM) + L * DM, -1536.f); continue; } r -= IT_WIN;
                if (r < IT_WUQ) { transpose_job(INP(I_WUQ) + (size_t)L * 512 * QMW, 512, QMW, (bf16_t*)(ws + WS_WUQ + L * SZ_WUQ), 0, r, scr, lane, INP(I_QNORM) + L * 512); continue; } r -= IT_WUQ;
                if (r < IT_WUKV) { transpose_job(INP(I_WUKV) + (size_t)L * 512 * KVW, 512, KVW, (bf16_t*)(ws + WS_WUKV + L * SZ_WUKV), 0, r, scr, lane, INP(I_KVNORM) + L * 512); continue; } r -= IT_WUKV;
                if (r < IT_SQ) { const int kb_ = r / (DM / 32), n0_ = (r % (DM / 32)) * 32;
                    if (kb_ < 8) transpose_item(INP(I_WOUT) + (size_t)L * DM * DM, DM, DM, (bf16_t*)(ws + WS_WOUT + L * SZ_WSQ), n0_, kb_ * 64, n0_, scr, lane, nullptr);
                    else transpose_item(INP(I_WOUT) + (size_t)L * DM * DM, DM * 2, DM, (bf16_t*)(ws + WS_WOUT + L * SZ_WSQ + 512), n0_, kb_ * 64, n0_, scr, lane, nullptr, -1536.f);
                    continue; } r -= IT_SQ;
                if (r < IT_SQ) { transpose_job(INP(I_PLE_GATE) + (size_t)L * DM * DM, DM, DM, (bf16_t*)(ws + WS_WPG + L * SZ_WSQ), 0, r, scr, lane, INP(I_PLE_NORM) + L * DM, (L & 1) ? 4096.f : -1536.f); continue; } r -= IT_SQ;
                transpose_job(INP(I_PLE_PROJ) + (size_t)L * PLE * DM, PLE, DM, (bf16_t*)(ws + WS_WPP + L * SZ_WPP), 0, r, scr, lane); continue;
            }
            r -= 2 * IT_LAYER;
            if (r < IT_FFN) { ffn_job(INP(I_DG), INP(I_DU), INP(I_DD), (bf16_t*)(ws + WS_DGU), (bf16_t*)(ws + WS_DDN), r, scr, lane, INP(I_FFN_NORM), false); continue; }
            r -= IT_FFN;
            { const int e = r / IT_FFN; r -= e * IT_FFN; const size_t eo = (size_t)e * DM * FF;
              ffn_job(INP(I_MG) + eo, INP(I_MU) + eo, INP(I_MD) + eo, (bf16_t*)(ws + WS_MGU + e * (SZ_GU / 2)), (bf16_t*)(ws + WS_MDN + e * (SZ_DN / 2)), r, scr, lane, INP(I_FFN_NORM) + DM, true); }
        }
        { const f32x4* src = (const f32x4*)INP(I_P); u32x2* dst = (u32x2*)(ws + WS_PBF); const size_t n4 = (size_t)2 * NTOK * PLE / 4;
          for (size_t i = (size_t)blockIdx.x * NTHR + F.tid; i < n4; i += (size_t)F.G * NTHR) { const f32x4 v = src[i]; u32x2 w; w.x = cvt_pk_bf16(v.x, v.y); w.y = cvt_pk_bf16(v.z, v.w); dst[i] = w; } }
        for (int i = blockIdx.x * NTHR + F.tid; i < SEQ * 96; i += F.G * NTHR) {
            const int pos = i / 96, j = i % 96; const bool t128 = j >= 32; const int jj = t128 ? j - 32 : j; const float dim = t128 ? 128.f : 64.f;
            const float inv = (float)exp2(-(double)(2 * jj) / (double)dim * 13.287712379549449);
            const float ang = (float)pos * inv; const double a = (double)ang; const double k = rint(a * 0.15915494309189535); const float r = (float)(a - k * 6.283185307179586);
            const float c = __cosf(r), s = __sinf(r);
            float* t = t128 ? tab128 + ((size_t)pos * 64 + jj) * 2 : tab64 + ((size_t)pos * 32 + jj) * 2; t[0] = c; t[1] = s;
        }
        for (int m = gw; m < NTOK; m += NGW) { const f32x4* xr = (const f32x4*)(INP(I_X) + (size_t)m * DM) + lane; f32x4 v[8];
#pragma unroll
            for (int j = 0; j < 8; ++j) v[j] = __builtin_nontemporal_load(&xr[64 * j]);
            row_hb_ss(v, HB2 + (size_t)m * DM, SSH + (size_t)m * 8, lane);
            { float s_ = 0.f, am = 0.f;
#pragma unroll
              for (int j = 0; j < 8; ++j) { s_ += (v[j].x * v[j].x + v[j].y * v[j].y) + (v[j].z * v[j].z + v[j].w * v[j].w); am = fmaxf(am, fmaxf(fmaxf(fabsf(v[j].x), fabsf(v[j].y)), fmaxf(fabsf(v[j].z), fabsf(v[j].w)))); }
              const float ri = 1.0f / sqrtf(wave_sum(s_) * (1.0f / DM) + EPS); am = fmaxf(wave_max(am), 1e-20f); const float sq_ = 127.0f / am;
              if (lane == 0) TRINV[m] = am * ri * (1.0f / (127.0f * 1536.0f));
              unsigned* hq = (unsigned*)(ws + WS_HQ8 + (size_t)m * DM) + lane;
#pragma unroll
              for (int j = 0; j < 8; ++j) hq[64 * j] = pk4_i8(v[j].x * sq_, v[j].y * sq_, v[j].z * sq_, v[j].w * sq_); } }
    }
    SEAM(0);

    for (int L = 0; L < DEPTH; ++L) {
        const int pb = 1 + L * PH_PER_LAYER;
        for (int rep_ = 0; rep_ < NREP(0); ++rep_) if (INREL(0) && IN(pb + 0)) { PH_LOCALS
            { pg8::SchedDense S; S.o.init(NTOK / 256, ZP / 256, F.G, (int)blockIdx.x); S.A = (const char*)(ws + (L == 0 ? WS_HQ8 : WS_XG8)); S.B = (const char*)(ws + WS_WIN + L * SZ_WIN); S.tA = (size_t)256 * DM; S.tB = (size_t)256 * DM;
              pg8::Epi<pg8::EPI_Z_I> E{Z, tab64, ZP, tab128, (float*)(ws + WS_SS), L == 0 ? TRINV : SSH + (size_t)(3 * L) * NTOK * 8, L == 0 ? 2 : 3, nullptr, nullptr, RED, L == 0 ? nullptr : SSH + (size_t)(3 * L - 1) * NTOK * 8};
              pg8::gemm_phase<pg8::Epi<pg8::EPI_Z_I>, pg8::SchedDense, 2>(F.lds + RING_OFF, F.tid, DM / 2, DM / 2, DM / 2, S, E); }
            if ((L & 1) == 0) {
              const int rem_ = ((NTOK / 256) * (ZP / 256)) % F.G; const bool sh_ = (rem_ > 0 && 2 * rem_ <= F.G);
              const int gpp = sh_ ? F.G - rem_ : F.G, cpp = sh_ ? ((int)blockIdx.x >= rem_ ? (int)blockIdx.x - rem_ : (1 << 24)) : (int)blockIdx.x;
              int gpp_s = gpp, cpp_s = cpp, kpp_s = PLE; asm volatile("" : "+s"(gpp_s), "+s"(cpp_s), "+s"(kpp_s));
              pg8::SchedDense S; S.o.init(NTOK / 256, DM / 256, gpp_s, cpp_s); S.A = (const char*)(ws + WS_PBF + (size_t)L * NTOK * PLE * 2); S.B = (const char*)(ws + WS_WPP + L * SZ_WPP); S.tA = (size_t)256 * PLE * 2; S.tB = (size_t)256 * PLE * 2;
              pg8::Epi<pg8::EPI_BF16> E{PPB, nullptr, DM, nullptr, nullptr, nullptr, 0, nullptr, nullptr, RED};
              pg8::gemm_phase(F.lds + RING_OFF, F.tid, PLE, PLE, kpp_s, S, E); }
        }
        SEAM(pb + 0);
        for (int rep_ = 0; rep_ < NREP(2); ++rep_) if (INREL(2) && IN(pb + 2)) { PH_LOCALS
            { pg8::SchedDense S; S.o.init(NTOK / 256, QMW / 256, F.G, (int)blockIdx.x); S.A = (const char*)(Z + O_MLA); S.B = (const char*)(ws + WS_WUQ + L * SZ_WUQ); S.tA = (size_t)256 * ZP * 2; S.tB = (size_t)256 * 512 * 2;
              pg8::Epi<pg8::EPI_SCALE> E{QM, nullptr, QMW, nullptr, (float*)(ws + WS_SS), nullptr, 0, nullptr, nullptr, RED};
              pg8::gemm_phase(F.lds + RING_OFF, F.tid, ZP, 512, 512, S, E); }
            { pg8::SchedDense S; S.o.init(NTOK / 256, KVW / 256, F.G, (int)blockIdx.x); S.A = (const char*)(Z + O_MLA + 512); S.B = (const char*)(ws + WS_WUKV + L * SZ_WUKV); S.tA = (size_t)256 * ZP * 2; S.tB = (size_t)256 * 512 * 2;
              pg8::Epi<pg8::EPI_SCALE> E{KVM, nullptr, KVW, nullptr, (float*)(ws + WS_SS) + 8, nullptr, 0, nullptr, nullptr, RED};
              pg8::gemm_phase(F.lds + RING_OFF, F.tid, ZP, 512, 512, S, E); }
        }
        SEAM(pb + 2);
#if !NAIVE_ATTN
#define ATT_LOCALS PH_LOCALS LAS unsigned char* al = F.lds + RING_OFF; const int tid = F.tid; const int r32 = lane & 31, hi = lane >> 5; (void)r32; (void)hi;
        for (int rep_ = 0; rep_ < NREP(3); ++rep_) if (INREL(3) && IN(pb + 3)) {
            { ATT_LOCALS
            for (int u = F.vcu; u < 256; u += F.G) {
                const int b = u >> 6, h = (u >> 4) & 3, qt = u & 15; const size_t rb = (size_t)b * SEQ, q0 = rb + qt * 256;
                att::Src S; S.q[0] = QM + q0 * QMW + h * 192; S.q[1] = S.q[0] + 64; S.q[2] = S.q[0] + 128; S.ldq = QMW;
                S.k[0] = KVM + rb * KVW + h * 256; S.k[1] = S.k[0] + 64; S.k[2] = Z + rb * ZP + 5120; S.ldk[0] = KVW; S.ldk[1] = KVW; S.ldk[2] = ZP; S.v = KVM + rb * KVW + h * 256 + 128; S.ldv = KVW;
                att::Par P; P.kt0 = 0; P.nkt = SEQ / 64; P.C = 0.07216878364870322f * 1.4426950408889634f; P.thr = 3.f / 0.07216878364870322f; P.rtab = tab64;       P.qpos0 = qt * 256; P.na_r0 = 0; P.na_krlo = 0;
                float m_reg = -1e30f, l_reg = 0.f; f32x16 o[4] = {};
                int tid_u = tid; asm volatile("" : "+v"(tid_u));
                att::attn_pass_pipe<3, 8, 2, 1, 0, 1>(al, tid_u, S, P, m_reg, l_reg, o);
                asm volatile("" : "+v"(tid_u));
                att::normalize(al, tid_u, l_reg, o);
                att::store_o8((unsigned char*)MIX + q0 * (DM * 2) + 1024 + 1024 + h * 128, DM * 2, tid_u, o);
            }
            }
            { ATT_LOCALS
                const float li = 0.8f - 0.6f * __expf(-0.3f * (float)L);
                float lam; { const float a = INP(I_LQ1)[L * 64 + lane] * INP(I_LK1)[L * 64 + lane], c = INP(I_LQ2)[L * 64 + lane] * INP(I_LK2)[L * 64 + lane]; lam = __expf(wave_sum(a)) - __expf(wave_sum(c)) + li; }
                const float* subln = INP(I_SUBLN) + L * 128;
                for (int u = F.vcu; u < 256; u += F.G) {
                    const int b = u >> 6, h = (u >> 4) & 3, qt = u & 15; const size_t rb = (size_t)b * SEQ, q0 = rb + qt * 256;
                    att::Src S; S.ldq = ZP; S.ldk[0] = ZP; S.ldk[1] = ZP; S.ldk[2] = ZP; S.ldv = ZP; S.v = Z + rb * ZP + 1024 + h * 128;
                    att::Par P; P.kt0 = 0; P.nkt = SEQ / 64; P.C = 0.125f * 1.4426950408889634f; P.thr = 8.f / 0.125f; P.rtab = tab64; P.qpos0 = qt * 256; P.na_r0 = 0; P.na_krlo = 0;
                    LAS unsigned* stash = (LAS unsigned*)(al + (F.wave < 4 ? att::OFF_K + (F.wave >> 1) * att::KBUF + att::KPL + (F.wave & 1) * 8192 : att::OFF_QL + (F.wave - 4) * 8192)) + lane;
                    {
                        S.q[0] = Z + q0 * ZP + h * 128; S.q[1] = S.q[0]; S.q[2] = S.q[0]; S.k[0] = Z + rb * ZP + 512 + h * 128; S.k[1] = S.k[0]; S.k[2] = S.k[0];
                        float m_reg = -1e30f, l_reg = 0.f; f32x16 o[4] = {};
                        int tid_v = tid; asm volatile("" : "+v"(tid_v));
                        att::attn_pass_pipe<1, 0, 2, 2, 0>(al, tid_v, S, P, m_reg, l_reg, o);
                        asm volatile("" : "+v"(tid_v));
                        att::normalize(al, tid_v, l_reg, o);
#pragma unroll
                        for (int d = 0; d < 4; ++d)
#pragma unroll
                            for (int r = 0; r < 8; ++r) stash[(d * 8 + r) * 64] = cvt_pk_bf16(o[d][2 * r], o[d][2 * r + 1]);
                    }
                    S.q[0] = Z + q0 * ZP + h * 128 + 64; S.q[1] = S.q[0]; S.q[2] = S.q[0]; S.k[0] = Z + rb * ZP + 512 + h * 128 + 64; S.k[1] = S.k[0]; S.k[2] = S.k[0];
                    float m_reg = -1e30f, l_reg = 0.f; f32x16 o[4] = {};
                    P.thr = 3.f / 0.125f;
                    int tid_u = tid; asm volatile("" : "+v"(tid_u));
                    att::attn_pass_pipe<1, 0, 2, 2, 0, 1>(al, tid_u, S, P, m_reg, l_reg, o);
                    asm volatile("" : "+v"(tid_u));
                    att::normalize(al, tid_u, l_reg, o);
                    const float sg[4] = {subln[r32] * (1.f - li), subln[32 + r32] * (1.f - li), subln[64 + r32] * (1.f - li), subln[96 + r32] * (1.f - li)};
#pragma unroll
                    for (int r = 0; r < 16; ++r) {
                        float ss = 0.f;
#pragma unroll
                        for (int d = 0; d < 4; ++d) { const unsigned w1 = stash[(d * 8 + (r >> 1)) * 64]; const float o1 = (r & 1) ? bfhi(w1) : bflo(w1); const float v = o1 - lam * o[d][r]; o[d][r] = v; ss += v * v; }
                        ss += swz_xor<1>(ss); ss += swz_xor<2>(ss); ss += swz_xor<4>(ss); ss += swz_xor<8>(ss); ss += swz_xor<16>(ss);
                        const float rn = 1.0f / sqrtf(ss * (1.0f / 128) + EPS);
#pragma unroll
                        for (int d = 0; d < 4; ++d) o[d][r] = o[d][r] * rn * sg[d];
                    }
                    att::store_o(MIX + q0 * DM + h * 128, DM, tid_u, o);
                }
            }
            { ATT_LOCALS
            for (int u = F.vcu; u < 256; u += F.G) {
                const int b = u >> 6, h = (u >> 4) & 3, qt = u & 15, kvh = h >> 1; const size_t rb = (size_t)b * SEQ, q0 = rb + qt * 256;
                att::Src S; S.q[0] = Z + q0 * ZP + O_SWA + h * 128; S.q[1] = S.q[0] + 64; S.q[2] = S.q[0]; S.ldq = ZP;
                S.k[0] = Z + rb * ZP + O_SWA + 512 + kvh * 128; S.k[1] = S.k[0] + 64; S.k[2] = S.k[0]; S.ldk[0] = ZP; S.ldk[1] = ZP; S.ldk[2] = ZP; S.v = Z + rb * ZP + O_SWA + 768 + kvh * 128; S.ldv = ZP;
                const int klo = max(0, qt * 256 - 128), khi = min(SEQ, qt * 256 + 384);
                att::Par P; P.kt0 = klo; P.nkt = (khi - klo) / 64; P.C = 0.08838834764831845f * 1.4426950408889634f; P.thr = 8.f / 0.08838834764831845f; P.rtab = tab128; P.qpos0 = qt * 256; P.na_r0 = 0; P.na_krlo = 0;
                float m_reg = INP(I_SINKS)[L * 4 + h] * (1.0f / 0.08838834764831845f), l_reg = 1.f; f32x16 o[4] = {};
                att::attn_pass<2, 2, 0, 4>(al, tid, S, P, m_reg, l_reg, o);
                att::normalize(al, tid, l_reg, o);
                att::store_o8((unsigned char*)MIX + q0 * (DM * 2) + 1024 + 512 + h * 128, DM * 2, tid, o);
            }
            }
            { ATT_LOCALS
            for (int u = F.vcu; u < 256; u += F.G) {
                const int b = u >> 6, h = (u >> 4) & 3, qt = u & 15; const size_t rb = (size_t)b * SEQ, q0 = rb + qt * 256;
                { const float* rpb = INP(I_RPB) + ((size_t)L * 4 + h) * 465; LAS float* bt = (LAS float*)(al + att::OFF_BIAS);
                  if (tid < 465) bt[tid] = rpb[tid] * (1.0f / 0.08838834764831845f);
                  __syncthreads(); }
                att::Src S; S.q[0] = Z + q0 * ZP + O_NA + h * 128; S.q[1] = S.q[0] + 64; S.q[2] = S.q[0]; S.ldq = ZP;
                S.k[0] = Z + rb * ZP + O_NA + 512 + h * 128; S.k[1] = S.k[0] + 64; S.k[2] = S.k[0]; S.ldk[0] = ZP; S.ldk[1] = ZP; S.ldk[2] = ZP; S.v = Z + rb * ZP + O_NA + 1024 + h * 128; S.ldv = ZP;
                const int r0 = qt * 4, krlo = min(max(r0 - 4, 0), 56), krhi = min(max(r0 + 3 - 4, 0), 56) + 7;
                att::Par P; P.kt0 = krlo * 64; P.nkt = krhi - krlo + 1; P.C = 0.08838834764831845f * 1.4426950408889634f; P.thr = 8.f / 0.08838834764831845f; P.rtab = tab64; P.qpos0 = qt * 256; P.na_r0 = r0; P.na_krlo = krlo;
                float m_reg = -1e30f, l_reg = 0.f; f32x16 o[4] = {};
                att::attn_pass<2, 1, 0, 0>(al, tid, S, P, m_reg, l_reg, o);
                att::normalize(al, tid, l_reg, o);
                att::store_o8((unsigned char*)MIX + q0 * (DM * 2) + 1024 + h * 128, DM * 2, tid, o);
                __syncthreads();
            }
            }
        }
#endif
        SEAM(pb + 3);
        for (int rep_ = 0; rep_ < NREP(4); ++rep_) if (INREL(4) && IN(pb + 4)) { PH_LOCALS
            { pg8::SchedDense S; S.o.init(NTOK / 256, DM / 256, F.G, (int)blockIdx.x); S.A = (const char*)MIX; S.B = (const char*)(ws + WS_WOUT + L * SZ_WSQ); S.tA = (size_t)256 * DM * 2; S.tB = (size_t)256 * DM * 2;
              pg8::Epi<pg8::EPI_RESID> E{nullptr, HB2, DM, nullptr, nullptr, nullptr, 0, HN, nullptr, RED};
              int k_ = 512; asm volatile("" : "+s"(k_)); pg8::gemm_phase(F.lds + RING_OFF, F.tid, DM, DM, k_, S, E); }
            { pg8::SchedDense S; S.o.init(NTOK / 256, DM / 256, F.G, (int)blockIdx.x); S.A = (const char*)MIX + 1024; S.B = (const char*)(ws + WS_WOUT + L * SZ_WSQ + 1024); S.tA = (size_t)256 * DM * 2; S.tB = (size_t)256 * DM * 2;
              int k_ = 768; asm volatile("" : "+s"(k_));
              if ((L & 1) == 0) {
                pg8::Epi<pg8::EPI_RESID_QI> E{ws + WS_HQ8, HN, DM, nullptr, nullptr, SSH + (size_t)(3 * L) * NTOK * 8, 1, HN, SSH + (size_t)(3 * L + 1) * NTOK * 8, RED};
                pg8::gemm_phase<pg8::Epi<pg8::EPI_RESID_QI>, pg8::SchedDense, 2>(F.lds + RING_OFF, F.tid, DM, DM, k_, S, E);
              } else {
                pg8::Epi<pg8::EPI_RESID_I> E{nullptr, HN, DM, nullptr, nullptr, nullptr, 0, HN, SSH + (size_t)(3 * L + 1) * NTOK * 8, RED};
                pg8::gemm_phase<pg8::Epi<pg8::EPI_RESID_I>, pg8::SchedDense, 2>(F.lds + RING_OFF, F.tid, DM, DM, k_, S, E);
              } }
        }
        SEAM(pb + 4);
        for (int rep_ = 0; rep_ < NREP(5); ++rep_) if (INREL(5) && IN(pb + 5)) { PH_LOCALS
            const float* g = INP(I_FFN_NORM) + L * DM;
            if (L & 1) {
                const float* wr = INP(I_ROUTER) + (size_t)(L >> 1) * DM * NE;
                LAS f32x4* wrl = (LAS f32x4*)(F.lds + RING_OFF);
                for (int p = F.tid; p < DM * 2; p += NTHR) { const int c = p >> 1, hf = p & 1; wrl[((((c >> 8) * 4 + (c & 3)) * 2 + hf) << 6) + ((c & 255) >> 2)] = *(const f32x4*)(wr + (size_t)c * 8 + hf * 4); }
                __syncthreads();
                volatile LAS unsigned* lcnt = F.MISC + 16;
                volatile LAS unsigned* lbase = F.MISC + 32;
                volatile LAS unsigned* linfo = F.MISC + 64;
                for (int chunk = blockIdx.x; chunk < NTOK / 64; chunk += F.G) {
                    if (F.tid < 8) lcnt[F.tid] = 0u;
                    __syncthreads();
                    for (int rr = 0; rr < 8; ++rr) {
                        const int lr = F.wave * 8 + rr, m = chunk * 64 + lr;
                        float ri; f32x4 v[8];
                        { const u32x2* xr = (const u32x2*)(HN + (size_t)m * DM) + lane; float s_ = 0.f;
#pragma unroll
                          for (int j = 0; j < 8; ++j) { const u32x2 w_ = xr[64 * j]; v[j] = (f32x4){bflo(w_.x), bfhi(w_.x), bflo(w_.y), bfhi(w_.y)}; s_ += (v[j].x * v[j].x + v[j].y * v[j].y) + (v[j].z * v[j].z + v[j].w * v[j].w); }
                          ri = 1.0f / sqrtf(wave_sum(s_) * (1.0f / DM) + EPS);
#pragma unroll
                          for (int j = 0; j < 8; ++j) v[j] = v[j] * ri * ((const f32x4*)g)[64 * j + lane];
                          { float am = 0.f; f32x4 x[8];
#pragma unroll
                            for (int j = 0; j < 8; ++j) { const f32x4 gg = ((const f32x4*)g)[64 * j + lane]; x[j] = (f32x4){v[j].x / gg.x, v[j].y / gg.y, v[j].z / gg.z, v[j].w / gg.w};
                                am = fmaxf(am, fmaxf(fmaxf(fabsf(x[j].x), fabsf(x[j].y)), fmaxf(fabsf(x[j].z), fabsf(x[j].w)))); }
                            am = fmaxf(wave_max(am), 1e-20f); const float sq_ = 127.0f / am;
                            if (lane == 0) TRINV[m] = am * (1.0f / (127.0f * 1536.0f));
                            unsigned* hq = (unsigned*)(ws + WS_HQ8 + (size_t)m * DM) + lane;
#pragma unroll
                            for (int j = 0; j < 8; ++j) hq[64 * j] = pk4_i8(x[j].x * sq_, x[j].y * sq_, x[j].z * sq_, x[j].w * sq_); } }
                        float lg[8];
#pragma unroll
                        for (int e = 0; e < 8; ++e) lg[e] = 0.f;
#pragma unroll
                        for (int j = 0; j < 8; ++j)
#pragma unroll
                            for (int q = 0; q < 4; ++q) { const f32x4 w0 = wrl[(((j * 4 + q) * 2 + 0) << 6) + lane], w1 = wrl[(((j * 4 + q) * 2 + 1) << 6) + lane]; const float x = v[j][q];
                                lg[0] += x * w0.x; lg[1] += x * w0.y; lg[2] += x * w0.z; lg[3] += x * w0.w; lg[4] += x * w1.x; lg[5] += x * w1.y; lg[6] += x * w1.z; lg[7] += x * w1.w; }
#pragma unroll
                        for (int e = 0; e < 8; ++e) lg[e] = wave_sum(lg[e]);
                        int e0 = 0; float v0 = lg[0];
#pragma unroll
                        for (int e = 1; e < 8; ++e) if (lg[e] > v0) { v0 = lg[e]; e0 = e; }
                        int e1 = -1; float v1 = -3.0e38f;
#pragma unroll
                        for (int e = 0; e < 8; ++e) if (e != e0 && lg[e] > v1) { v1 = lg[e]; e1 = e; }
                        if (lane == 0) {
                            const float g1 = 1.0f / (1.0f + __expf(v0 - v1)), g0 = 1.0f - g1;
                            const unsigned p0 = atomicAdd((unsigned*)&lcnt[e0], 1u), p1 = atomicAdd((unsigned*)&lcnt[e1], 1u);
                            linfo[lr * 6 + 0] = (unsigned)e0; linfo[lr * 6 + 1] = (unsigned)e1; linfo[lr * 6 + 2] = p0; linfo[lr * 6 + 3] = p1; linfo[lr * 6 + 4] = __float_as_uint(g0); linfo[lr * 6 + 5] = __float_as_uint(g1);
                        }
                    }
                    __syncthreads();
                    if (F.tid < 8) lbase[F.tid] = __hip_atomic_fetch_add(ctl + CW_MOE_CNT + 64 * F.tid, lcnt[F.tid], __ATOMIC_RELAXED, __HIP_MEMORY_SCOPE_AGENT);
                    __syncthreads();
                    if (F.tid < 64) { const int m = chunk * 64 + F.tid; const unsigned e0 = linfo[F.tid * 6], e1 = linfo[F.tid * 6 + 1];
                        unsigned* o = MOEI + (size_t)m * 8; o[0] = e0; o[1] = e1; o[2] = lbase[e0] + linfo[F.tid * 6 + 2]; o[3] = lbase[e1] + linfo[F.tid * 6 + 3]; o[4] = linfo[F.tid * 6 + 4]; o[5] = linfo[F.tid * 6 + 5]; }
                    __syncthreads();
                }
            }
        }
        if (L & 1) SEAM(pb + 5);
        for (int rep_ = 0; rep_ < NREP(6); ++rep_) if (INREL(6) && IN(pb + 6) && (L & 1)) { PH_LOCALS
            volatile LAS unsigned* tstart = F.MISC + 48;
            if (F.tid == 0) { unsigned acc = 0;
                for (int e = 0; e < 8; ++e) { tstart[e] = acc; const unsigned c = __hip_atomic_load(ctl + CW_MOE_CNT + 64 * e, __ATOMIC_RELAXED, __HIP_MEMORY_SCOPE_AGENT); acc += (c + 255u) >> 8; }
                tstart[8] = acc;
                if (blockIdx.x == 0) ctl[CW_MOE_TILES] = acc; }
            __syncthreads();
            if (blockIdx.x == 0 && F.tid < MOE_MAXT) { unsigned e = 0;
#pragma unroll
                for (int q = 1; q < 8; ++q) e += ((unsigned)F.tid >= tstart[q]) ? 1u : 0u;
                ctl[CW_MOE_TILES + 64 + F.tid] = e; }
            unsigned* STOK = (unsigned*)(ws + WS_STOK);
            for (int a = (int)blockIdx.x * NTHR + F.tid; a < NTOK * 2; a += F.G * NTHR) {
                const int m = a >> 1, k = a & 1; unsigned* inf = MOEI + (size_t)m * 8; const unsigned e = inf[k], pos = inf[2 + k]; const unsigned slot = tstart[e] * 256u + pos;
                inf[6 + k] = slot; STOK[slot] = (unsigned)m; SRINV[slot] = TRINV[m];
            }
            { unsigned char* XG8 = (unsigned char*)(ws + WS_XG8);
              for (int a = gw; a < NTOK * 2; a += NGW) { const int m = a >> 1, k = a & 1; const unsigned* inf = MOEI + (size_t)m * 8; const unsigned slot = tstart[inf[k]] * 256u + inf[2 + k];
                  const u32x4* src = (const u32x4*)(ws + WS_HQ8 + (size_t)m * DM) + lane; u32x4* dst = (u32x4*)(XG8 + (size_t)slot * DM) + lane;
                  dst[0] = src[0]; dst[64] = src[64]; } }
            if (blockIdx.x == 0) {
                for (int e = 0; e < 8; ++e) { const unsigned c = __hip_atomic_load(ctl + CW_MOE_CNT + 64 * e, __ATOMIC_RELAXED, __HIP_MEMORY_SCOPE_AGENT);
                    for (unsigned sl = tstart[e] * 256u + c + (unsigned)F.tid; sl < tstart[e + 1] * 256u; sl += NTHR) { STOK[sl] = 0u; SRINV[sl] = 0.f; } }
            }
        }
        if (L & 1) SEAM(pb + 6);
        for (int rep_ = 0; rep_ < NREP(7); ++rep_) if (INREL(7) && IN(pb + 7)) { PH_LOCALS
            if ((L & 1) == 0) {
                pg8::SchedDense S; S.o.init(NTOK / 256, 2 * FF / 256, F.G, (int)blockIdx.x); S.A = (const char*)(ws + WS_HQ8); S.B = (const char*)(ws + WS_DGU); S.tA = (size_t)256 * DM; S.tB = (size_t)256 * DM;
                pg8::Epi<pg8::EPI_SWIGLU_I> E{ACT, nullptr, FF, nullptr, nullptr, SSH + (size_t)(3 * L + 1) * NTOK * 8, 3, nullptr, nullptr, RED, SSH + (size_t)(3 * L) * NTOK * 8};
                pg8::gemm_phase<pg8::Epi<pg8::EPI_SWIGLU_I>, pg8::SchedDense, 2>(F.lds + RING_OFF, F.tid, DM / 2, DM / 2, DM / 2, S, E);
            } else {
                const int nT = __builtin_amdgcn_readfirstlane((int)__hip_atomic_load(ctl + CW_MOE_TILES, __ATOMIC_RELAXED, __HIP_MEMORY_SCOPE_AGENT));
                pg8::SchedMoe S; S.o.init(nT, 2 * FF / 256, F.G, (int)blockIdx.x); S.A = (const char*)(ws + WS_XG8); S.B = (const char*)(ws + WS_MGU); S.tA = (size_t)256 * DM; S.tB = (size_t)256 * DM; S.tE = SZ_GU / 2; S.tile_expert = ctl + CW_MOE_TILES + 64;
                pg8::Epi<pg8::EPI_SWIGLU8_I> E{ACT, nullptr, FF, nullptr, nullptr, SRINV, 2, nullptr, nullptr, RED};
                pg8::gemm_phase<pg8::Epi<pg8::EPI_SWIGLU8_I>, pg8::SchedMoe, 2>(F.lds + RING_OFF, F.tid, DM / 2, DM / 2, DM / 2, S, E);
            }
        }
        SEAM(pb + 7);
        for (int rep_ = 0; rep_ < NREP(8); ++rep_) if (INREL(8) && IN(pb + 8)) { PH_LOCALS
            if ((L & 1) == 0) {
                pg8::SchedDense S; S.o.init(NTOK / 256, DM / 256, F.G, (int)blockIdx.x); S.A = (const char*)ACT; S.B = (const char*)(ws + WS_DDN); S.tA = (size_t)256 * FF * 2; S.tB = (size_t)256 * FF * 2;
                pg8::Epi<pg8::EPI_RESID_Q> E{ws + WS_HQ8, HN, DM, nullptr, nullptr, SSH + (size_t)(3 * L + 1) * NTOK * 8, 1, HN, SSH + (size_t)(3 * L + 2) * NTOK * 8, RED};
                pg8::gemm_phase(F.lds + RING_OFF, F.tid, FF, FF, FF, S, E);
            } else {
                const int nT = __builtin_amdgcn_readfirstlane((int)__hip_atomic_load(ctl + CW_MOE_TILES, __ATOMIC_RELAXED, __HIP_MEMORY_SCOPE_AGENT));
                pg8::SchedMoe S; S.o.init(nT, DM / 256, F.G, (int)blockIdx.x); S.A = (const char*)ACT; S.B = (const char*)(ws + WS_MDN); S.tA = (size_t)256 * FF; S.tB = (size_t)256 * FF; S.tE = SZ_DN / 2; S.tile_expert = ctl + CW_MOE_TILES + 64;
                pg8::Epi<pg8::EPI_BF16S> E{XG, nullptr, DM, nullptr, nullptr, nullptr, 0, nullptr, nullptr, RED};
                pg8::gemm_phase<pg8::Epi<pg8::EPI_BF16S>, pg8::SchedMoe, 1>(F.lds + RING_OFF, F.tid, FF / 2, FF / 2, FF / 2, S, E);
            }
        }
        for (int rep_ = 0; rep_ < NREP(8); ++rep_) if (INREL(8) && IN(pb + 8) && (L & 1)) { PH_LOCALS
            const int nT = __builtin_amdgcn_readfirstlane((int)__hip_atomic_load(ctl + CW_MOE_TILES, __ATOMIC_RELAXED, __HIP_MEMORY_SCOPE_AGENT));
                { const int rem_ = (nT * (DM / 256)) % F.G; const bool sh_ = (rem_ > 0 && 2 * rem_ <= F.G);
                  const int gpp = sh_ ? F.G - rem_ : F.G, cpp = sh_ ? ((int)blockIdx.x >= rem_ ? (int)blockIdx.x - rem_ : (1 << 24)) : (int)blockIdx.x;
                  int gpp_s = gpp, cpp_s = cpp, kpp_s = PLE; asm volatile("" : "+s"(gpp_s), "+s"(cpp_s), "+s"(kpp_s));
                  pg8::SchedDense S2; S2.o.init(NTOK / 256, DM / 256, gpp_s, cpp_s); S2.A = (const char*)(ws + WS_PBF + (size_t)L * NTOK * PLE * 2); S2.B = (const char*)(ws + WS_WPP + L * SZ_WPP); S2.tA = (size_t)256 * PLE * 2; S2.tB = (size_t)256 * PLE * 2;
                  pg8::Epi<pg8::EPI_BF16> E2{PPB, nullptr, DM, nullptr, nullptr, nullptr, 0, nullptr, nullptr, RED};
                  pg8::gemm_phase(F.lds + RING_OFF, F.tid, PLE, PLE, kpp_s, S2, E2); }
        }
        SEAM(pb + 8);
        for (int rep_ = 0; rep_ < NREP(9); ++rep_) if (INREL(9) && IN(pb + 9) && (L & 1)) { PH_LOCALS
            for (int m = gw; m < NTOK; m += NGW) {
                const unsigned* inf = MOEI + (size_t)m * 8; const float g0 = __uint_as_float(inf[4]), g1 = __uint_as_float(inf[5]);
                const u32x2* y0 = (const u32x2*)(XG + (size_t)inf[6] * DM) + lane; const u32x2* y1 = (const u32x2*)(XG + (size_t)inf[7] * DM) + lane;
                const u32x2* hp = (const u32x2*)(HN + (size_t)m * DM) + lane; f32x4 v[8];
#pragma unroll
                for (int j = 0; j < 8; ++j) { const u32x2 hw = hp[64 * j], a = y0[64 * j], b = y1[64 * j];
                    f32x4 h = {bflo(hw.x), bfhi(hw.x), bflo(hw.y), bfhi(hw.y)};
                    h.x += g0 * bflo(a.x) + g1 * bflo(b.x); h.y += g0 * bfhi(a.x) + g1 * bfhi(b.x); h.z += g0 * bflo(a.y) + g1 * bflo(b.y); h.w += g0 * bfhi(a.y) + g1 * bfhi(b.y); v[j] = h; }
                row_hb_ss(v, HN + (size_t)m * DM, SSH + ((size_t)(3 * L + 2) * NTOK + m) * 8, lane);
                { float s_ = 0.f;
#pragma unroll
                  for (int j = 0; j < 8; ++j) s_ += (v[j].x * v[j].x + v[j].y * v[j].y) + (v[j].z * v[j].z + v[j].w * v[j].w);
                  const float ri = 64.0f / sqrtf(wave_sum(s_) * (1.0f / DM) + EPS); unsigned* hq = (unsigned*)(ws + WS_HQ8 + (size_t)m * DM) + lane;
#pragma unroll
                  for (int j = 0; j < 8; ++j) hq[64 * j] = pk4_fp8(v[j].x * ri, v[j].y * ri, v[j].z * ri, v[j].w * ri); }
            }
        }
        if (L & 1) SEAM(pb + 9);
        for (int rep_ = 0; rep_ < NREP(10); ++rep_) if (INREL(10) && IN(pb + 10)) { PH_LOCALS
            if (L & 1) {
                pg8::SchedDense S; S.o.init(NTOK / 256, DM / 256, F.G, (int)blockIdx.x); S.A = (const char*)(ws + WS_HQ8); S.B = (const char*)(ws + WS_WPG + L * SZ_WSQ); S.tA = (size_t)256 * DM; S.tB = (size_t)256 * DM;
                pg8::Epi<pg8::EPI_PLE8> E{nullptr, PPB, DM, HN, nullptr, nullptr, 0, HB2, (L + 1 < DEPTH) ? SSH + (size_t)(3 * (L + 1)) * NTOK * 8 : nullptr, RED};
                pg8::gemm_phase<pg8::Epi<pg8::EPI_PLE8>, pg8::SchedDense, 1>(F.lds + RING_OFF, F.tid, DM / 2, DM / 2, DM / 2, S, E);
            } else {
            pg8::SchedDense S; S.o.init(NTOK / 256, DM / 256, F.G, (int)blockIdx.x); S.A = (const char*)(ws + WS_HQ8); S.B = (const char*)(ws + WS_WPG + L * SZ_WSQ); S.tA = (size_t)256 * DM; S.tB = (size_t)256 * DM;
            pg8::Epi<pg8::EPI_PLE_I> E{(L + 1 < DEPTH) ? ws + WS_XG8 : nullptr, PPB, DM, HN, nullptr, SSH + (size_t)(3 * L + 2) * NTOK * 8, 1, HB2, (L + 1 < DEPTH) ? SSH + (size_t)(3 * (L + 1)) * NTOK * 8 : nullptr, RED, SSH + (size_t)(3 * L + 1) * NTOK * 8};
            pg8::gemm_phase<pg8::Epi<pg8::EPI_PLE_I>, pg8::SchedDense, 2>(F.lds + RING_OFF, F.tid, DM / 2, DM / 2, DM / 2, S, E);
            }
        }
        SEAM(pb + 10);
        for (int rep_ = 0; rep_ < NREP(11); ++rep_) if (INREL(11) && IN(pb + 11) && (L + 1 == DEPTH)) { PH_LOCALS
            const float* g = INP(I_FINAL_NORM);
            for (int m = gw; m < NTOK; m += NGW) { f32x4* hp = (f32x4*)(OUTP + (size_t)m * DM) + lane; const u32x2* hb = (const u32x2*)(HB2 + (size_t)m * DM) + lane; f32x4 v[8]; float s = 0.f;
#pragma unroll
                for (int j = 0; j < 8; ++j) { const u32x2 w_ = hb[64 * j]; v[j] = (f32x4){bflo(w_.x), bfhi(w_.x), bflo(w_.y), bfhi(w_.y)}; s += (v[j].x * v[j].x + v[j].y * v[j].y) + (v[j].z * v[j].z + v[j].w * v[j].w); }
                const float ri = 1.0f / sqrtf(wave_sum(s) * (1.0f / DM) + EPS);
#pragma unroll
                for (int j = 0; j < 8; ++j) __builtin_nontemporal_store(v[j] * ri * ((const f32x4*)g)[64 * j + lane], &hp[64 * j]); }
        }
    }
#undef IN
#undef SEAM
}

extern "C" void kernel_launch(void* const* d_in, const int* in_sizes, int n_in, void* d_out, int out_size, void* d_ws, size_t ws_size, hipStream_t stream) {
    static int grid = 0;
    if (grid == 0) {
        if (n_in != N_IN || out_size != NTOK * DM || ws_size < WS_END) { fprintf(stderr, "kernel_launch: shape/ws mismatch: n_in %d out %d ws %zu need %zu\n", n_in, out_size, ws_size, (size_t)WS_END); grid = -1; return; }
        int dev = 0, cus = 0, per_cu = 0;
        if (hipGetDevice(&dev) != hipSuccess || hipDeviceGetAttribute(&cus, hipDeviceAttributeMultiprocessorCount, dev) != hipSuccess) { grid = -1; return; }
        if (hipFuncSetAttribute((const void*)fwd, hipFuncAttributeMaxDynamicSharedMemorySize, LDS_BYTES) != hipSuccess) { fprintf(stderr, "hipFuncSetAttribute failed\n"); grid = -1; return; }
        if (hipOccupancyMaxActiveBlocksPerMultiprocessor(&per_cu, (const void*)fwd, NTHR, LDS_BYTES) != hipSuccess || per_cu < 1) { fprintf(stderr, "occupancy query: %d\n", per_cu); }
        (void)hipGetLastError();
        grid = cus;
    }
    if (grid < 0) return;
    (void)hipMemsetAsync((char*)d_ws + WS_CTL, 0, CTL_ZERO_BYTES, stream);
    Args a; memset(&a, 0, sizeof(a));
    for (int i = 0; i < N_IN; ++i) a.in[i] = (const float*)d_in[i];
    a.out = (float*)d_out; a.ws = (unsigned char*)d_ws;
#if MK_ONE_LAUNCH
    a.ph_lo = 0; a.ph_hi = N_PHASES;
    hipLaunchKernelGGL(fwd, dim3(grid), dim3(NTHR), LDS_BYTES, stream, a);
#else
    for (int ph = 0; ph < N_PHASES; ++ph) {
        const int rel = ph == 0 ? -1 : (ph - 1) % PH_PER_LAYER, L = ph == 0 ? 0 : (ph - 1) / PH_PER_LAYER;
        if (rel == 3) {
#if NAIVE_ATTN
            hipLaunchKernelGGL(naive_attn<0>, dim3(NB * 4 * SEQ / 4), dim3(256), 0, stream, a, L);
            hipLaunchKernelGGL(naive_attn<1>, dim3(NB * 4 * SEQ / 4), dim3(256), 0, stream, a, L);
            hipLaunchKernelGGL(naive_attn<2>, dim3(NB * 4 * SEQ / 4), dim3(256), 0, stream, a, L);
            hipLaunchKernelGGL(naive_attn<3>, dim3(NB * 4 * SEQ / 4), dim3(256), 0, stream, a, L);
            continue;
#endif
        }
        if (rel == 6 && !(L & 1)) continue;
        a.ph_lo = ph; a.ph_hi = ph + 1;
        hipLaunchKernelGGL(fwd, dim3(grid), dim3(NTHR), LDS_BYTES, stream, a);
    }
#endif
    const hipError_t le = hipPeekAtLastError();
    if (le != hipSuccess) fprintf(stderr, "kernel_launch: launch failed: %s\n", hipGetErrorName(le));
}
```

```cpp
#include <hip/hip_runtime.h>
#include <cstdio>
#include <cstdint>
#include <cstring>

#ifndef MK_ONE_LAUNCH
#define MK_ONE_LAUNCH 1
#endif
#ifndef NAIVE_ATTN
#define NAIVE_ATTN 0
#endif

#define LAS __attribute__((address_space(3)))
#define GAS __attribute__((address_space(1)))
typedef unsigned short bf16_t;
typedef short bf16x8 __attribute__((ext_vector_type(8)));
typedef short s16x4 __attribute__((ext_vector_type(4)));
typedef float f32x4 __attribute__((ext_vector_type(4)));
typedef float f32x2 __attribute__((ext_vector_type(2)));
typedef float f32x16 __attribute__((ext_vector_type(16)));
typedef unsigned u32x4 __attribute__((ext_vector_type(4)));
typedef unsigned u32x2 __attribute__((ext_vector_type(2)));

constexpr int NB = 4, SEQ = 4096, DM = 2048, NTOK = NB * SEQ, DEPTH = 2;
constexpr int ZC = 5184, ZP = 5376, FF = 7168, NE = 8, PLE = 256;
constexpr int O_NA = 1536, O_SWA = 3072, O_MLA = 4096;
constexpr int QMW = 768, KVW = 1024;
constexpr float EPS = 1e-6f;
constexpr int MOE_MAXT = 136;
constexpr int NWAVES = 8, NTHR = 512;

enum { I_X = 0, I_P, I_ATTN_NORM, I_W_IN, I_LQ1, I_LK1, I_LQ2, I_LK2, I_SUBLN, I_RPB, I_SINKS, I_QNORM, I_KVNORM, I_WUQ, I_WUKV, I_WOUT,
       I_FFN_NORM, I_DG, I_DU, I_DD, I_ROUTER, I_MG, I_MU, I_MD, I_PLE_NORM, I_PLE_GATE, I_PLE_PROJ, I_FINAL_NORM, N_IN };

constexpr size_t MiB = 1u << 20;
constexpr size_t WS_CTL = 0, CTL_ZERO_BYTES = 2 * MiB;
constexpr size_t WS_SS = 1 * MiB;
constexpr size_t SZ_WIN = (size_t)ZP * DM * 2, SZ_WUQ = (size_t)QMW * 512 * 2, SZ_WUKV = (size_t)KVW * 512 * 2, SZ_WSQ = (size_t)DM * DM * 2, SZ_WPP = (size_t)DM * PLE * 2;
constexpr size_t SZ_GU = (size_t)2 * FF * DM * 2, SZ_DN = (size_t)DM * FF * 2;
constexpr size_t WS_WIN = 2 * MiB;
constexpr size_t WS_WUQ = WS_WIN + 2 * SZ_WIN;
constexpr size_t WS_WUKV = WS_WUQ + 2 * SZ_WUQ;
constexpr size_t WS_WOUT = WS_WUKV + 2 * SZ_WUKV;
constexpr size_t WS_WPG = WS_WOUT + 2 * SZ_WSQ;
constexpr size_t WS_WPP = WS_WPG + 2 * SZ_WSQ;
constexpr size_t WS_DGU = WS_WPP + 2 * SZ_WPP;
constexpr size_t WS_DDN = WS_DGU + SZ_GU;
constexpr size_t WS_MGU = WS_DDN + SZ_DN;
constexpr size_t WS_MDN = WS_MGU + NE * SZ_GU;
constexpr size_t WS_TAB64 = WS_MDN + NE * SZ_DN;
constexpr size_t WS_TAB128 = WS_TAB64 + (size_t)SEQ * 32 * 2 * 4;
constexpr size_t WS_MOEI = WS_TAB128 + (size_t)SEQ * 64 * 2 * 4;
constexpr size_t WS_SSH = WS_MOEI + (size_t)NTOK * 8 * 4;
constexpr size_t WS_TRINV = WS_SSH + (size_t)6 * NTOK * 8 * 4;
constexpr size_t WS_SRINV = WS_TRINV + (size_t)NTOK * 4;
constexpr size_t WS_STOK = WS_SRINV + (size_t)MOE_MAXT * 256 * 4;
constexpr size_t WS_HN = WS_STOK + (size_t)MOE_MAXT * 256 * 4;
constexpr size_t WS_PBF = WS_HN + (size_t)NTOK * DM * 2;
constexpr size_t WS_PP = WS_PBF + (size_t)2 * NTOK * PLE * 2;
constexpr size_t WS_ARENA = WS_PP + (size_t)NTOK * DM * 2;
constexpr size_t WS_Z = WS_ARENA;
constexpr size_t WS_QM = WS_Z + (size_t)NTOK * ZP * 2;
constexpr size_t WS_KVM = WS_QM + (size_t)NTOK * QMW * 2;
constexpr size_t WS_MIX = WS_KVM + (size_t)NTOK * KVW * 2;
constexpr size_t WS_ATT_END = WS_MIX + (size_t)NTOK * DM * 2;
constexpr size_t WS_ACT = WS_ARENA;
constexpr size_t WS_XG = WS_ACT + (size_t)MOE_MAXT * 256 * FF * 2;
constexpr size_t WS_HB2 = WS_XG + (size_t)MOE_MAXT * 256 * DM * 2;
constexpr size_t WS_HQ8 = WS_HB2 + (size_t)NTOK * DM * 2;
constexpr size_t WS_XG8 = WS_HQ8 + (size_t)NTOK * DM;
constexpr size_t WS_END = WS_XG8 + (size_t)MOE_MAXT * 256 * DM;
static_assert(WS_ATT_END <= WS_END, "arena");
static_assert(WS_WIN % 256 == 0 && WS_HN % 256 == 0 && WS_Z % 256 == 0 && WS_XG % 256 == 0 && WS_MOEI % 256 == 0 && WS_SSH % 256 == 0 && WS_TRINV % 256 == 0 && WS_SRINV % 256 == 0 && WS_STOK % 256 == 0, "align");

constexpr int CW_BAR = 1024;
constexpr int CW_MOE_CNT = 8192;
constexpr int CW_MOE_TILES = 8192 + 1024;

__device__ __forceinline__ unsigned cvt_pk_bf16(float lo, float hi) { unsigned r; asm volatile("v_cvt_pk_bf16_f32 %0, %1, %2" : "=v"(r) : "v"(lo), "v"(hi)); return r; }
__device__ __forceinline__ float bf2f(bf16_t v) { return __uint_as_float((unsigned)v << 16); }
__device__ __forceinline__ float bflo(unsigned w) { return __uint_as_float(w << 16); }
__device__ __forceinline__ float bfhi(unsigned w) { return __uint_as_float(w & 0xffff0000u); }
__device__ __forceinline__ bf16_t f2bf(float f) { return (bf16_t)(cvt_pk_bf16(f, 0.f) & 0xffffu); }
template <int M> __device__ __forceinline__ float swz_xor(float v) { return __int_as_float(__builtin_amdgcn_ds_swizzle(__float_as_int(v), (M << 10) | 0x1f)); }
__device__ __forceinline__ float xsum32(float v) { auto r = __builtin_amdgcn_permlane32_swap(__float_as_uint(v), __float_as_uint(v), false, false); return __uint_as_float(r[0]) + __uint_as_float(r[1]); }
__device__ __forceinline__ float xsum16(float v) { return v + swz_xor<16>(v); }
__device__ __forceinline__ float wave_max(float v) {
    v = fmaxf(v, swz_xor<1>(v)); v = fmaxf(v, swz_xor<2>(v)); v = fmaxf(v, swz_xor<4>(v)); v = fmaxf(v, swz_xor<8>(v)); v = fmaxf(v, swz_xor<16>(v));
    auto r = __builtin_amdgcn_permlane32_swap(__float_as_uint(v), __float_as_uint(v), false, false); return fmaxf(__uint_as_float(r[0]), __uint_as_float(r[1]));
}
__device__ __forceinline__ float wave_sum(float v) {
    v += swz_xor<1>(v); v += swz_xor<2>(v); v += swz_xor<4>(v); v += swz_xor<8>(v); v += swz_xor<16>(v);
    return xsum32(v);
}
__device__ __forceinline__ unsigned pk4_fp8(float a, float b, float c, float d) {
    a = __builtin_amdgcn_fmed3f(a, -448.f, 448.f); b = __builtin_amdgcn_fmed3f(b, -448.f, 448.f); c = __builtin_amdgcn_fmed3f(c, -448.f, 448.f); d = __builtin_amdgcn_fmed3f(d, -448.f, 448.f);
    int w = __builtin_amdgcn_cvt_pk_fp8_f32(a, b, 0, false); w = __builtin_amdgcn_cvt_pk_fp8_f32(c, d, w, true); return (unsigned)w; }
__device__ __forceinline__ unsigned pk4_i8(float a, float b, float c, float d) {
    const int ia = (int)rintf(__builtin_amdgcn_fmed3f(a, -127.f, 127.f)), ib = (int)rintf(__builtin_amdgcn_fmed3f(b, -127.f, 127.f));
    const int ic = (int)rintf(__builtin_amdgcn_fmed3f(c, -127.f, 127.f)), id = (int)rintf(__builtin_amdgcn_fmed3f(d, -127.f, 127.f));
    return (unsigned)(ia & 255) | ((unsigned)(ib & 255) << 8) | ((unsigned)(ic & 255) << 16) | ((unsigned)id << 24); }
#define LDS_WAIT() asm volatile("s_waitcnt lgkmcnt(0)" ::: "memory")
#define VM_WAIT() asm volatile("s_waitcnt vmcnt(0)" ::: "memory")

namespace pg8 {
constexpr int BM = 256, BK = 64, HALF = 128, HTB = HALF * BK * 2, STAGE_BYTES = 8 * HTB, NXCD = 8, WGM = 8;
__host__ __device__ __forceinline__ int lds_byte(int r, int c) { const int st = (r >> 4) * 2 + (c >> 5), rr = r & 15, cc = c & 31, ob = rr * 64 + cc * 2; return st * 1024 + (ob ^ (((ob >> 9) & 1) << 5)); }
__host__ __device__ __forceinline__ void stage_rc(int b, int& R, int& C) { const int st = b / 1024, sb = b % 1024, swz = sb ^ (((sb >> 9) & 1) << 5); R = (st >> 1) * 16 + swz / 64; C = (st & 1) * 32 + (swz % 64) / 2; }
__host__ __device__ __forceinline__ int perm32(int rho) { const int n = rho >> 4, i = rho & 15; return 8 * (i >> 2) + 4 * n + (i & 3); }
struct Unit { int pm, pn; };
struct StaticOrder {
    int nM, nN, nwg, G, c;
    __device__ void init(int nM_, int nN_, int G_, int c_) { nM = nM_; nN = nN_; nwg = nM * nN; G = G_; c = c_; }
    __device__ bool next(int i, Unit& u) const {
        const long L = (long)i * G + c; if (L >= nwg) return false;
        int wgid = (int)L; { const int q = nwg / NXCD, r = nwg % NXCD, xcd = wgid % NXCD, off = wgid / NXCD; wgid = (xcd < r ? xcd * (q + 1) : r * (q + 1) + (xcd - r) * q) + off; }
        const int nig = WGM * nN, gid = wgid / nig, fm = gid * WGM, gsz = (nM - fm) < WGM ? (nM - fm) : WGM;
        u.pm = fm + ((wgid % nig) % gsz); u.pn = (wgid % nig) / gsz; return true;
    }
};
struct SchedDense {
    StaticOrder o; const char* A; const char* B; size_t tA, tB;
    __device__ __forceinline__ bool next(int i, Unit& u) const { return o.next(i, u); }
    __device__ __forceinline__ const char* aptr(const Unit& u) const { return A + (size_t)u.pm * tA; }
    __device__ __forceinline__ const char* bptr(const Unit& u) const { return B + (size_t)u.pn * tB; }
    static constexpr bool GATHER = false;
    __device__ __forceinline__ unsigned rowtok(const Unit&, int) const { return 0u; }
};
struct SchedMoe {
    StaticOrder o; const char* A; const char* B; size_t tA, tB, tE; const unsigned* tile_expert;
    __device__ __forceinline__ bool next(int i, Unit& u) const { return o.next(i, u); }
    __device__ __forceinline__ const char* aptr(const Unit& u) const { return A + (size_t)u.pm * tA; }
    __device__ __forceinline__ const char* bptr(const Unit& u) const { return B + (size_t)__builtin_amdgcn_readfirstlane((int)tile_expert[u.pm]) * tE + (size_t)u.pn * tB; }
    static constexpr bool GATHER = false;
    __device__ __forceinline__ unsigned rowtok(const Unit&, int) const { return 0u; }
};
struct SchedMoeG {
    StaticOrder o; const char* A; const char* B; size_t tB, tE; const unsigned* tile_expert; const unsigned* slot_tok;
    __device__ __forceinline__ bool next(int i, Unit& u) const { return o.next(i, u); }
    __device__ __forceinline__ const char* aptr(const Unit&) const { return A; }
    __device__ __forceinline__ const char* bptr(const Unit& u) const { return B + (size_t)__builtin_amdgcn_readfirstlane((int)tile_expert[u.pm]) * tE + (size_t)u.pn * tB; }
    static constexpr bool GATHER = true;
    __device__ __forceinline__ unsigned rowtok(const Unit& u, int r) const { return slot_tok[u.pm * 256 + r]; }
};

enum { EPI_BF16 = 0, EPI_RESID = 1, EPI_SWIGLU = 2, EPI_PLE = 3, EPI_Z = 4, EPI_SCALE = 5, EPI_SWIGLU8 = 6, EPI_BF16S = 7, EPI_PLE8 = 8, EPI_SWIGLU_I = 9, EPI_SWIGLU8_I = 10, EPI_Z_I = 11, EPI_RESID_Q = 12, EPI_PLE_I = 13, EPI_RESID_Q8 = 15, EPI_RESID_I = 19, EPI_RESID_QI = 20 };
#define ZCV(a) ((MODE == EPI_Z_I) ? (float)__float_as_int(a) : (a))
#define ZCV4(a) ((MODE == EPI_Z_I) ? (f32x4){(float)__float_as_int((a)[0]), (float)__float_as_int((a)[1]), (float)__float_as_int((a)[2]), (float)__float_as_int((a)[3])} : (a))
template <int MODE> struct Epi {
    void* O; const void* X; int ldc; const void* X2; float* SS;
    const float* RS; int rsmode;
    bf16_t* HB; float* SSO;
    LAS float* red;
    const float* RQ = nullptr;
    __device__ __forceinline__ float rowscale(const size_t row) const {
        if (rsmode == 1) { const f32x4 a = *(const f32x4*)(RS + row * 8), b = *(const f32x4*)(RS + row * 8 + 4);
            return 1.0f / sqrtf((((a[0] + a[1]) + (a[2] + a[3])) + ((b[0] + b[1]) + (b[2] + b[3]))) * (1.0f / DM) + EPS); }
        if (rsmode == 2) return RS[row];
        if (rsmode == 3) { const f32x4 a = *(const f32x4*)(RS + row * 8), b = *(const f32x4*)(RS + row * 8 + 4), c = *(const f32x4*)(RQ + row * 8), d = *(const f32x4*)(RQ + row * 8 + 4);
            return sqrtf(((((c[0] + c[1]) + (c[2] + c[3])) + ((d[0] + d[1]) + (d[2] + d[3]))) * (1.0f / DM) + EPS) / ((((a[0] + a[1]) + (a[2] + a[3])) + ((b[0] + b[1]) + (b[2] + b[3]))) * (1.0f / DM) + EPS)) * (5.0f / (127.0f * 1536.0f)); }
        return 1.0f;
    }
    __device__ __forceinline__ void operator()(const f32x4 (&acc)[2][2][4][2], const Unit& u, int wr, int wc, int fr, int fq) const {
        const int row0 = u.pm * BM + wr * 64 + fr;
        constexpr bool IS_RES = (MODE == EPI_RESID || MODE == EPI_RESID_Q || MODE == EPI_RESID_Q8 || MODE == EPI_RESID_I || MODE == EPI_RESID_QI), IS_PLE = (MODE == EPI_PLE || MODE == EPI_PLE8 || MODE == EPI_PLE_I);
        if constexpr (IS_RES || IS_PLE) {
            constexpr int MG = (MODE == EPI_PLE_I) ? 2 : 4;
#pragma unroll
            for (int ai = 0; ai < 2; ++ai)
#pragma unroll
            for (int mg = 0; mg < 4; mg += MG) {
                u32x4 hin[MG][2], pin[MG][2]; float rsg[MG], rq8[MG]; (void)rq8;
#pragma unroll
                for (int mm = 0; mm < MG; ++mm) { rsg[mm] = (MODE == EPI_PLE8) ? (1.0f / 262144.0f) : 1.0f; if constexpr (MODE == EPI_PLE) rsg[mm] = rowscale((size_t)(row0 + ai * HALF + (mg + mm) * 16));
                    if constexpr (MODE == EPI_RESID_Q || MODE == EPI_RESID_Q8 || MODE == EPI_RESID_QI) rsg[mm] = rowscale((size_t)(row0 + ai * HALF + (mg + mm) * 16)) * (127.0f / 5.0f);
                    if constexpr (MODE == EPI_PLE_I) { const size_t row_ = (size_t)(row0 + ai * HALF + (mg + mm) * 16); const f32x4 a_ = *(const f32x4*)(RQ + row_ * 8), b_ = *(const f32x4*)(RQ + row_ * 8 + 4);
                        const float rinv_ = rowscale(row_); rq8[mm] = rinv_ * (127.0f / 5.0f);
                        rsg[mm] = rinv_ * sqrtf((((a_[0] + a_[1]) + (a_[2] + a_[3])) + ((b_[0] + b_[1]) + (b_[2] + b_[3]))) * (1.0f / DM) + EPS) * (5.0f / (127.0f * 1536.0f)); } }
#pragma unroll
                for (int mm = 0; mm < MG; ++mm) { const int m = mg + mm; const size_t off = (size_t)(row0 + ai * HALF + m * 16) * ldc + u.pn * BM + wc * 32 + 8 * fq;
#pragma unroll
                    for (int bj = 0; bj < 2; ++bj) {
                        if constexpr (IS_RES) { hin[mm][bj] = *(const u32x4*)((const bf16_t*)X + off + bj * HALF); }
                        else { hin[mm][bj] = *(const u32x4*)((const bf16_t*)X2 + off + bj * HALF); pin[mm][bj] = *(const u32x4*)((const bf16_t*)X + off + bj * HALF); }
                    } }
#pragma unroll
                for (int mm = 0; mm < MG; ++mm) { const int m = mg + mm; const size_t off = (size_t)(row0 + ai * HALF + m * 16) * ldc + u.pn * BM + wc * 32 + 8 * fq;
                    const float rs = rsg[mm];
                    float sq = 0.f;
#pragma unroll
                    for (int bj = 0; bj < 2; ++bj) {
                        const u32x4 hw = hin[mm][bj];
                        f32x4 h0 = {bflo(hw.x), bfhi(hw.x), bflo(hw.y), bfhi(hw.y)}, h1 = {bflo(hw.z), bfhi(hw.z), bflo(hw.w), bfhi(hw.w)};
                        if constexpr (MODE == EPI_RESID_I || MODE == EPI_RESID_QI) { constexpr float as_ = 1.5f / (127.0f * 1536.0f);
#pragma unroll
                            for (int j = 0; j < 4; ++j) { h0[j] += (float)__float_as_int(acc[ai][bj][m][0][j]) * as_; h1[j] += (float)__float_as_int(acc[ai][bj][m][1][j]) * as_; } }
                        else if constexpr (IS_RES) { constexpr float as_ = (MODE == EPI_RESID_Q8) ? (1.0f / 262144.0f) : 1.0f; h0 = h0 + acc[ai][bj][m][0] * as_; h1 = h1 + acc[ai][bj][m][1] * as_; }
                        else { const u32x4 pw = pin[mm][bj];
                            const float pv[8] = {bflo(pw.x), bfhi(pw.x), bflo(pw.y), bfhi(pw.y), bflo(pw.z), bfhi(pw.z), bflo(pw.w), bfhi(pw.w)};
#pragma unroll
                            for (int j = 0; j < 4; ++j) { const float a0 = ((MODE == EPI_PLE_I) ? (float)__float_as_int(acc[ai][bj][m][0][j]) : acc[ai][bj][m][0][j]) * rs, a1 = ((MODE == EPI_PLE_I) ? (float)__float_as_int(acc[ai][bj][m][1][j]) : acc[ai][bj][m][1][j]) * rs;
                                h0[j] += __builtin_amdgcn_rcpf(1.0f + __builtin_amdgcn_exp2f(-1.4426950408889634f * a0)) * pv[j];
                                h1[j] += __builtin_amdgcn_rcpf(1.0f + __builtin_amdgcn_exp2f(-1.4426950408889634f * a1)) * pv[4 + j]; } }
                        { u32x4 w; w.x = cvt_pk_bf16(h0[0], h0[1]); w.y = cvt_pk_bf16(h0[2], h0[3]); w.z = cvt_pk_bf16(h1[0], h1[1]); w.w = cvt_pk_bf16(h1[2], h1[3]);
                            *(u32x4*)(HB + off + bj * HALF) = w; }
                        if constexpr (MODE == EPI_RESID_Q || MODE == EPI_RESID_Q8 || MODE == EPI_RESID_QI) { u32x2 q8; q8.x = pk4_i8(h0[0] * rs, h0[1] * rs, h0[2] * rs, h0[3] * rs); q8.y = pk4_i8(h1[0] * rs, h1[1] * rs, h1[2] * rs, h1[3] * rs);
                            *(u32x2*)((unsigned char*)O + off + bj * HALF) = q8; }
                        if constexpr (MODE == EPI_PLE_I) { if (O) { const float qs_ = rq8[mm]; u32x2 q8; q8.x = pk4_i8(h0[0] * qs_, h0[1] * qs_, h0[2] * qs_, h0[3] * qs_); q8.y = pk4_i8(h1[0] * qs_, h1[1] * qs_, h1[2] * qs_, h1[3] * qs_);
                            *(u32x2*)((unsigned char*)O + off + bj * HALF) = q8; } }
                        sq += ((h0[0] * h0[0] + h0[1] * h0[1]) + (h0[2] * h0[2] + h0[3] * h0[3])) + ((h1[0] * h1[0] + h1[1] * h1[1]) + (h1[2] * h1[2] + h1[3] * h1[3]));
                    }
                    if (SSO) { sq = xsum32(xsum16(sq)); if (fq == 0) red[wc * 256 + ai * HALF + wr * 64 + m * 16 + fr] = sq; }
                }
            }
        } else
#pragma unroll
        for (int ai = 0; ai < 2; ++ai) {
            float rsv[4];
            if constexpr (MODE == EPI_Z || MODE == EPI_Z_I || MODE == EPI_SWIGLU || MODE == EPI_SWIGLU_I || MODE == EPI_SWIGLU8_I) {
#pragma unroll
                for (int m = 0; m < 4; ++m) rsv[m] = rowscale((size_t)(row0 + ai * HALF + m * 16));
            }
            if constexpr (MODE == EPI_SCALE) {
#pragma unroll
                for (int m = 0; m < 4; ++m) { const size_t row = (size_t)(row0 + ai * HALF + m * 16);
                    const f32x4 pa_ = *(const f32x4*)(SS + row * 16), pb_ = *(const f32x4*)(SS + row * 16 + 4);
                    rsv[m] = 1.0f / sqrtf((((pa_[0] + pa_[1]) + (pa_[2] + pa_[3])) + ((pb_[0] + pb_[1]) + (pb_[2] + pb_[3]))) * (1.0f / 512) + EPS); }
            }
#pragma unroll
            for (int m = 0; m < 4; ++m) {
                const size_t row = (size_t)(row0 + ai * HALF + m * 16);
                if constexpr (MODE == EPI_BF16 || MODE == EPI_BF16S) {
                    bf16_t* rowp = (bf16_t*)O + row * ldc + u.pn * BM + wc * 32 + 8 * fq;
                    constexpr float sc_ = (MODE == EPI_BF16S) ? (1.0f / 262144.0f) : 1.0f;
#pragma unroll
                    for (int bj = 0; bj < 2; ++bj) { const f32x4 v0 = acc[ai][bj][m][0] * sc_, v1 = acc[ai][bj][m][1] * sc_;
                        u32x4 w; w.x = cvt_pk_bf16(v0[0], v0[1]); w.y = cvt_pk_bf16(v0[2], v0[3]); w.z = cvt_pk_bf16(v1[0], v1[1]); w.w = cvt_pk_bf16(v1[2], v1[3]);
                        *(u32x4*)(rowp + bj * HALF) = w; }
                } else if constexpr (MODE == EPI_SCALE) {
                    const float ri = rsv[m];
                    bf16_t* rowp = (bf16_t*)O + row * ldc + u.pn * BM + wc * 32 + 8 * fq;
#pragma unroll
                    for (int bj = 0; bj < 2; ++bj) { const f32x4 v0 = acc[ai][bj][m][0] * ri, v1 = acc[ai][bj][m][1] * ri;
                        u32x4 w; w.x = cvt_pk_bf16(v0[0], v0[1]); w.y = cvt_pk_bf16(v0[2], v0[3]); w.z = cvt_pk_bf16(v1[0], v1[1]); w.w = cvt_pk_bf16(v1[2], v1[3]);
                        *(u32x4*)(rowp + bj * HALF) = w; }
                } else if constexpr (MODE == EPI_Z || MODE == EPI_Z_I) {
                    const float rs = rsv[m];
                    const int pn = u.pn; const bool r64 = (pn == 2) | (pn == 3) | (pn == 20), r128 = (pn == 14);
                    if (r64 | r128) {
                        const int pos = (int)row & (SEQ - 1); const int j0 = r64 ? 8 * fq : (wc & 1) * 32 + 8 * fq;
                        const float* tb = r64 ? (const float*)X + ((size_t)pos * 32 + j0) * 2 : (const float*)X2 + ((size_t)pos * 64 + j0) * 2;
                        const f32x4 t0 = *(const f32x4*)tb, t1 = *(const f32x4*)(tb + 4), t2 = *(const f32x4*)(tb + 8), t3 = *(const f32x4*)(tb + 12);
                        const float cs[16] = {t0[0], t0[1], t0[2], t0[3], t1[0], t1[1], t1[2], t1[3], t2[0], t2[1], t2[2], t2[3], t3[0], t3[1], t3[2], t3[3]};
                        float y1[8], y2[8];
#pragma unroll
                        for (int n = 0; n < 2; ++n)
#pragma unroll
                            for (int j = 0; j < 4; ++j) { const float x1 = ZCV(acc[ai][0][m][n][j]) * rs, x2 = ZCV(acc[ai][1][m][n][j]) * rs, c = cs[(n * 4 + j) * 2], sn = cs[(n * 4 + j) * 2 + 1];
                                y1[n * 4 + j] = x1 * c - x2 * sn; y2[n * 4 + j] = x2 * c + x1 * sn; }
                        const int c1 = pn * BM + (r64 ? wc * 64 + j0 : (wc >> 1) * 128 + j0), c2 = c1 + (r64 ? 32 : 64);
                        u32x4 w; w.x = cvt_pk_bf16(y1[0], y1[1]); w.y = cvt_pk_bf16(y1[2], y1[3]); w.z = cvt_pk_bf16(y1[4], y1[5]); w.w = cvt_pk_bf16(y1[6], y1[7]);
                        *(u32x4*)((bf16_t*)O + row * ldc + c1) = w;
                        w.x = cvt_pk_bf16(y2[0], y2[1]); w.y = cvt_pk_bf16(y2[2], y2[3]); w.z = cvt_pk_bf16(y2[4], y2[5]); w.w = cvt_pk_bf16(y2[6], y2[7]);
                        *(u32x4*)((bf16_t*)O + row * ldc + c2) = w;
                    } else {
                        bf16_t* rowp = (bf16_t*)O + row * ldc + pn * BM + wc * 32 + 8 * fq;
                        float sq = 0.f;
#pragma unroll
                        for (int bj = 0; bj < 2; ++bj) { const f32x4 v0 = ZCV4(acc[ai][bj][m][0]) * rs, v1 = ZCV4(acc[ai][bj][m][1]) * rs;
                            sq += ((v0[0] * v0[0] + v0[1] * v0[1]) + (v0[2] * v0[2] + v0[3] * v0[3])) + ((v1[0] * v1[0] + v1[1] * v1[1]) + (v1[2] * v1[2] + v1[3] * v1[3]));
                            u32x4 w; w.x = cvt_pk_bf16(v0[0], v0[1]); w.y = cvt_pk_bf16(v0[2], v0[3]); w.z = cvt_pk_bf16(v1[0], v1[1]); w.w = cvt_pk_bf16(v1[2], v1[3]);
                            *(u32x4*)(rowp + bj * HALF) = w; }
                        if (pn >= 16 && pn < 20) {
                            sq = xsum32(xsum16(sq));
                            if (fq == 0) SS[row * 16 + (pn - 16) * 4 + wc] = sq;
                        }
                    }
                } else if constexpr (MODE == EPI_SWIGLU || MODE == EPI_SWIGLU8 || MODE == EPI_SWIGLU_I || MODE == EPI_SWIGLU8_I) {
                    const float rs = (MODE == EPI_SWIGLU8) ? (1.0f / 262144.0f) : rsv[m];
                    bf16_t* rowp = (bf16_t*)O + row * ldc + u.pn * HALF + wc * 32 + 8 * fq;
                    float r[8];
#pragma unroll
                    for (int n = 0; n < 2; ++n)
#pragma unroll
                        for (int j = 0; j < 4; ++j) { constexpr bool IA = (MODE == EPI_SWIGLU_I || MODE == EPI_SWIGLU8_I);
                            const float g = (IA ? (float)__float_as_int(acc[ai][0][m][n][j]) : acc[ai][0][m][n][j]) * rs, up = (IA ? (float)__float_as_int(acc[ai][1][m][n][j]) : acc[ai][1][m][n][j]) * rs;
                            r[n * 4 + j] = g * __builtin_amdgcn_rcpf(1.0f + __builtin_amdgcn_exp2f(-1.4426950408889634f * g)) * up; }
                    if constexpr (MODE == EPI_SWIGLU8 || MODE == EPI_SWIGLU8_I) { u32x2 w8; w8.x = pk4_fp8(r[0] * 32.f, r[1] * 32.f, r[2] * 32.f, r[3] * 32.f); w8.y = pk4_fp8(r[4] * 32.f, r[5] * 32.f, r[6] * 32.f, r[7] * 32.f);
                        *(u32x2*)((unsigned char*)O + row * ldc + u.pn * HALF + wc * 32 + 8 * fq) = w8; }
                    else {
                    u32x4 w; w.x = cvt_pk_bf16(r[0], r[1]); w.y = cvt_pk_bf16(r[2], r[3]); w.z = cvt_pk_bf16(r[4], r[5]); w.w = cvt_pk_bf16(r[6], r[7]);
                    *(u32x4*)rowp = w; }
                }
            }
        }
        if constexpr (IS_RES || IS_PLE) {
            if (SSO) {
                asm volatile("s_waitcnt lgkmcnt(0)" ::: "memory"); __builtin_amdgcn_s_barrier(); asm volatile("" ::: "memory");
                unsigned on2_ = ~0u; asm volatile("" : "+s"(on2_)); const int t = (wr * 4 + wc) * 64 + __builtin_amdgcn_mbcnt_hi(on2_, __builtin_amdgcn_mbcnt_lo(on2_, 0u));
                if (t < 256) SSO[((size_t)u.pm * BM + t) * 8 + u.pn] = (red[t] + red[256 + t]) + (red[512 + t] + red[768 + t]);
            }
        }
    }
};

typedef int v4i_t __attribute__((ext_vector_type(4)));
typedef int v8i_t __attribute__((ext_vector_type(8)));
__device__ __forceinline__ v8i_t cat8(bf16x8 a, bf16x8 b) { const v4i_t x = __builtin_bit_cast(v4i_t, a), y = __builtin_bit_cast(v4i_t, b); return __builtin_shufflevector(x, y, 0, 1, 2, 3, 4, 5, 6, 7); }
__device__ __forceinline__ void mfma8_inplace(f32x4& c, const v8i_t a, const v8i_t b, const int sc) {
    asm volatile("s_nop 1\n\tv_mfma_scale_f32_16x16x128_f8f6f4 %0, %1, %2, %0, %3, %3 op_sel_hi:[0,0,0]" : "+v"(c) : "v"(a), "v"(b), "v"(sc));
}
template <class EpiT, class Sched, int QM = 0>
__device__ __forceinline__ void gemm_phase(LAS unsigned char* lds, const int tid, const int lda, const int ldb, const int K, const Sched& S, const EpiT& E) {
    constexpr bool FP8 = (QM == 1), INT8 = (QM == 2);
    const int wid = __builtin_amdgcn_readfirstlane(tid >> 6), lane = tid & 63, wr = wid >> 2, wc = wid & 3, fr = lane & 15, fq = lane >> 4;
    const int nt = K / BK;
    unsigned voffA[2], voffB[2];
#pragma unroll
    for (int i = 0; i < 2; ++i) { int R, C; stage_rc(tid * 16 + i * 8192, R, C); const int Rb = (R & ~31) + perm32(R & 31);
        voffA[i] = (unsigned)(R * lda + C) * 2u; voffB[i] = (unsigned)(Rb * ldb + C) * 2u; }
    const size_t kstep = (size_t)(BK * 2);
    const size_t hstepA = Sched::GATHER ? (size_t)0 : (size_t)HALF * lda * 2, hstepB = (size_t)HALF * ldb * 2;
    unsigned vc0[2], vc1[2], vn0[2], vn1[2];
#define PG8_ROWOFFS(u_, d0, d1) do { if constexpr (Sched::GATHER) { _Pragma("unroll") for (int i = 0; i < 2; ++i) { int R, C; stage_rc(tid * 16 + i * 8192, R, C); \
        d0[i] = S.rowtok(u_, R) * (unsigned)(lda * 2) + (unsigned)C * 2u; d1[i] = S.rowtok(u_, HALF + R) * (unsigned)(lda * 2) + (unsigned)C * 2u; } } \
        } while (0)
#define PG8_V(arr) (Sched::GATHER ? (const unsigned*)(arr) : (const unsigned*)voffA)
    const unsigned ldsw = (unsigned)wid * 1024u;
    const int aoff = lds_byte(wr * 64 + fr, fq * 8), boff = lds_byte(wc * 32 + fr, fq * 8);
#define PG8_SA(b, h) (((b) * 2 + (h)) * HTB)
#define PG8_SB(b, h) ((4 + (b) * 2 + (h)) * HTB)
#define PG8_STAGE(bufoff, gbase, voff) do { _Pragma("unroll") for (int _i = 0; _i < 2; ++_i) \
        __builtin_amdgcn_global_load_lds((const unsigned*)((const char*)(gbase) + (voff)[_i]), (LAS unsigned*)(lds + (bufoff) + ldsw + _i * 8192), 16, 0, 0); } while (0)
#define PG8_LDA(dst, b, h) do { if constexpr (FP8) { _Pragma("unroll") for (int m = 0; m < 4; ++m) dst##8[m] = cat8(*(const LAS bf16x8*)(lds + PG8_SA(b, h) + aoff + m * 2048), *(const LAS bf16x8*)(lds + PG8_SA(b, h) + aoff + m * 2048 + 1024)); } \
        else { _Pragma("unroll") for (int m = 0; m < 4; ++m) _Pragma("unroll") for (int k = 0; k < 2; ++k) dst[m][k] = *(const LAS bf16x8*)(lds + PG8_SA(b, h) + aoff + m * 2048 + k * 1024); } } while (0)
#define PG8_LDB(dst, b, h) do { if constexpr (FP8) { _Pragma("unroll") for (int n = 0; n < 2; ++n) dst##8[n] = cat8(*(const LAS bf16x8*)(lds + PG8_SB(b, h) + boff + n * 2048), *(const LAS bf16x8*)(lds + PG8_SB(b, h) + boff + n * 2048 + 1024)); } \
        else { _Pragma("unroll") for (int n = 0; n < 2; ++n) _Pragma("unroll") for (int k = 0; k < 2; ++k) dst[n][k] = *(const LAS bf16x8*)(lds + PG8_SB(b, h) + boff + n * 2048 + k * 1024); } } while (0)
#define PG8_MMA(ai, bj, At, Bt) do { __builtin_amdgcn_s_setprio(1); if constexpr (FP8) { _Pragma("unroll") for (int m = 0; m < 4; ++m) _Pragma("unroll") for (int n = 0; n < 2; ++n) \
        mfma8_inplace(acc[ai][bj][m][n], Bt##8[n], At##8[m], sc8); } else if constexpr (INT8) { \
        _Pragma("unroll") for (int m = 0; m < 4; ++m) _Pragma("unroll") for (int n = 0; n < 2; ++n) _Pragma("unroll") for (int k = 0; k < 2; ++k) \
        acc[ai][bj][m][n] = __builtin_bit_cast(f32x4, __builtin_amdgcn_mfma_i32_16x16x64_i8(__builtin_bit_cast(v4i_t, Bt[n][k]), __builtin_bit_cast(v4i_t, At[m][k]), __builtin_bit_cast(v4i_t, acc[ai][bj][m][n]), 0, 0, 0)); } else { \
        _Pragma("unroll") for (int m = 0; m < 4; ++m) _Pragma("unroll") for (int n = 0; n < 2; ++n) _Pragma("unroll") for (int k = 0; k < 2; ++k) \
        acc[ai][bj][m][n] = __builtin_amdgcn_mfma_f32_16x16x32_bf16(Bt[n][k], At[m][k], acc[ai][bj][m][n], 0, 0, 0); } __builtin_amdgcn_s_setprio(0); } while (0)
#define PG8_WAIT_V(n) asm volatile("s_waitcnt vmcnt(" #n ")" ::: "memory")
#define PG8_WAIT_L(n) asm volatile("s_waitcnt lgkmcnt(" #n ")" ::: "memory")
#define PG8_BAR __builtin_amdgcn_s_barrier()
#define PG8_SCHED __builtin_amdgcn_sched_barrier(0)
    Unit cur, nxt; int ui = 0;
    if (!S.next(0, cur)) return;
    f32x4 acc[2][2][4][2];
#pragma unroll
    for (int a = 0; a < 2; ++a)
#pragma unroll
        for (int b = 0; b < 2; ++b)
#pragma unroll
            for (int m = 0; m < 4; ++m)
#pragma unroll
                for (int n = 0; n < 2; ++n) acc[a][b][m][n] = (f32x4){0.f, 0.f, 0.f, 0.f};
    bf16x8 At[4][2], B0[2][2], B1[2][2]; v8i_t At8[4], B08[2], B18[2];
    int sc8 = 0x7f7f7f7f; (void)sc8;
    const char* cA = S.aptr(cur); const char* cB = S.bptr(cur);
    PG8_ROWOFFS(cur, vc0, vc1);
    PG8_STAGE(PG8_SB(0, 0), cB, voffB); PG8_STAGE(PG8_SB(0, 1), cB + hstepB, voffB); PG8_STAGE(PG8_SA(0, 0), cA, PG8_V(vc0)); PG8_STAGE(PG8_SA(0, 1), cA + hstepA, PG8_V(vc1));
    if (wr == 1) PG8_BAR;
    PG8_WAIT_V(2); PG8_BAR;
    PG8_STAGE(PG8_SB(1, 0), cB + kstep, voffB); PG8_STAGE(PG8_SA(1, 0), cA + kstep, PG8_V(vc0)); PG8_STAGE(PG8_SB(1, 1), cB + hstepB + kstep, voffB);
    PG8_WAIT_V(6); PG8_BAR;
    for (;;) {
        const bool has_next = S.next(ui + 1, nxt);
        const char* nA = has_next ? S.aptr(nxt) : cA; const char* nB = has_next ? S.bptr(nxt) : cB;
        if constexpr (Sched::GATHER) { if (has_next) { PG8_ROWOFFS(nxt, vn0, vn1); } else { vn0[0] = vc0[0]; vn0[1] = vc0[1]; vn1[0] = vc1[0]; vn1[1] = vc1[1]; } }
        for (int t = 0; t < nt; t += 2) {
            const bool last = (t == nt - 2);
            const char* a1 = cA + (size_t)(t + 1) * kstep;
            const char* a2 = last ? nA : cA + (size_t)(t + 2) * kstep; const char* b2 = last ? nB : cB + (size_t)(t + 2) * kstep;
            const char* a3 = a2 + kstep; const char* b3 = b2 + kstep;
            unsigned w0[2], w1[2]; if constexpr (Sched::GATHER) { w0[0] = last ? vn0[0] : vc0[0]; w0[1] = last ? vn0[1] : vc0[1]; w1[0] = last ? vn1[0] : vc1[0]; w1[1] = last ? vn1[1] : vc1[1]; }
            PG8_LDB(B0, 0, 0); PG8_LDB(B1, 0, 1); PG8_SCHED; PG8_LDA(At, 0, 0); PG8_STAGE(PG8_SA(1, 1), a1 + hstepA, PG8_V(vc1));
            PG8_WAIT_V(8); PG8_WAIT_L(0); PG8_BAR; PG8_MMA(0, 0, At, B0); PG8_MMA(0, 1, At, B1); PG8_BAR; PG8_SCHED;
            PG8_LDA(At, 0, 1); PG8_STAGE(PG8_SB(0, 0), b2, voffB); PG8_STAGE(PG8_SB(0, 1), b2 + hstepB, voffB); PG8_STAGE(PG8_SA(0, 0), a2, PG8_V(w0));
            PG8_WAIT_V(8); PG8_WAIT_L(0); PG8_BAR; PG8_MMA(1, 0, At, B0); PG8_MMA(1, 1, At, B1); PG8_BAR; PG8_SCHED;
            PG8_LDB(B0, 1, 0); PG8_LDB(B1, 1, 1); PG8_SCHED; PG8_LDA(At, 1, 0); PG8_STAGE(PG8_SA(0, 1), a2 + hstepA, PG8_V(w1));
            PG8_WAIT_V(8); PG8_WAIT_L(0); PG8_BAR; PG8_MMA(0, 0, At, B0); PG8_MMA(0, 1, At, B1); PG8_BAR; PG8_SCHED;
            PG8_LDA(At, 1, 1); PG8_STAGE(PG8_SB(1, 0), b3, voffB); PG8_STAGE(PG8_SB(1, 1), b3 + hstepB, voffB); PG8_STAGE(PG8_SA(1, 0), a3, PG8_V(w0));
            PG8_WAIT_V(8); PG8_WAIT_L(0); PG8_BAR; PG8_MMA(1, 0, At, B0); PG8_MMA(1, 1, At, B1); PG8_BAR; PG8_SCHED;
        }
        if constexpr (FP8) asm volatile("s_nop 15\n\ts_nop 15\n\ts_nop 15\n\ts_nop 15" ::: "memory");
        if (wr == 0) PG8_BAR;
        { unsigned on_ = ~0u; asm volatile("" : "+s"(on_)); const int l2_ = __builtin_amdgcn_mbcnt_hi(on_, __builtin_amdgcn_mbcnt_lo(on_, 0u)); E(acc, cur, wr, wc, l2_ & 15, l2_ >> 4); }
        if (!has_next) break;
#pragma unroll
        for (int a = 0; a < 2; ++a)
#pragma unroll
            for (int b = 0; b < 2; ++b)
#pragma unroll
                for (int m = 0; m < 4; ++m)
#pragma unroll
                    for (int n = 0; n < 2; ++n) acc[a][b][m][n] = (f32x4){0.f, 0.f, 0.f, 0.f};
        cur = nxt; cA = nA; cB = nB; ++ui; if constexpr (Sched::GATHER) { vc0[0] = vn0[0]; vc0[1] = vn0[1]; vc1[0] = vn1[0]; vc1[1] = vn1[1]; }
        if (wr == 1) PG8_BAR;
    }
    PG8_WAIT_V(0);
    PG8_BAR;
#undef PG8_SA
#undef PG8_SB
#undef PG8_STAGE
#undef PG8_LDA
#undef PG8_LDB
#undef PG8_MMA
#undef PG8_WAIT_V
#undef PG8_WAIT_L
#undef PG8_BAR
#undef PG8_SCHED
#undef PG8_ROWOFFS
#undef PG8_V
}
}

#define XB_TMO      128
#define XB_XCNT(j)  (256  + 64 * (j))
#define XB_XSUB(j)  (1280 + 64 * (j))
#define XB_XGEN(j)  (2304 + 64 * (j))
#define XB_TOP      3328
#define XB_TOPGEN   3392
#define XCD_BAR_WORDS 3456
#define XB_SPIN_CAP (1u << 18)
__device__ __forceinline__ unsigned xb_ld(unsigned* p)              { return __hip_atomic_load(p, __ATOMIC_RELAXED, __HIP_MEMORY_SCOPE_AGENT); }
__device__ __forceinline__ unsigned xb_add(unsigned* p, unsigned v) { return __hip_atomic_fetch_add(p, v, __ATOMIC_RELAXED, __HIP_MEMORY_SCOPE_AGENT); }
__device__ __forceinline__ unsigned xb_xcc_id() { return (unsigned)__builtin_amdgcn_s_getreg((3 << 11) | 20) & 0xFu; }
#define XB_SPIN(cond, bar) do { unsigned _sp = 0; while (cond) { __builtin_amdgcn_s_sleep(1); \
    if ((++_sp & 255u) == 0u) { if (xb_ld(&(bar)[XB_TMO])) break; if (_sp > XB_SPIN_CAP) { atomicAdd(&(bar)[XB_TMO], 1u); break; } } } } while (0)
struct XcdBarrier { unsigned* bar; unsigned x; volatile LAS unsigned* st; };
__device__ __forceinline__ XcdBarrier xcd_barrier_post(unsigned* bar, volatile LAS unsigned* st, const bool t0) {
    XcdBarrier b; b.bar = bar; b.x = xb_xcc_id(); b.st = st;
    if (t0) (void)xb_add(&bar[XB_XCNT(b.x)], 1u);
    return b;
}
__device__ __forceinline__ void xcd_barrier_complete(unsigned* bar, unsigned x, unsigned& nloc, unsigned& nx) {
    const unsigned G = gridDim.x * gridDim.y * gridDim.z;
    unsigned sum, cnt, mine, sp = 0u;
    for (;;) {
        sum = 0u; cnt = 0u; mine = 0u;
#pragma unroll
        for (unsigned j = 0; j < 16; ++j) { const unsigned c = xb_ld(&bar[XB_XCNT(j)]); sum += c; cnt += (c > 0u) ? 1u : 0u; mine = (j == x) ? c : mine; }
        if (sum == G) break;
        __builtin_amdgcn_s_sleep(1);
        if ((++sp & 255u) == 0u) { if (xb_ld(&bar[XB_TMO])) break; if (sp > XB_SPIN_CAP) { atomicAdd(&bar[XB_TMO], 1u); break; } }
    }
    nloc = mine > 0u ? mine : 1u; nx = cnt > 0u ? cnt : 1u;
}
__device__ __forceinline__ void xcd_barrier(const XcdBarrier& b, const bool t0) {
    asm volatile("s_waitcnt vmcnt(0)" ::: "memory");
    __syncthreads();
    if (t0) {
        unsigned* bar = b.bar;
        __builtin_amdgcn_s_waitcnt(0);
        unsigned nloc = b.st[0], nx = b.st[1];
        if (nloc == 0u) { xcd_barrier_complete(bar, b.x, nloc, nx); b.st[0] = nloc; b.st[1] = nx; }
        const unsigned old = xb_add(&bar[XB_XSUB(b.x)], 1u);
        const unsigned gen = old / nloc;
        if (old + 1u == (gen + 1u) * nloc) {
            __builtin_amdgcn_fence(__ATOMIC_RELEASE, "agent");
            asm volatile("s_waitcnt vmcnt(0)" ::: "memory");
            const unsigned og = xb_add(&bar[XB_TOP], 1u);
            const unsigned tg = og / nx;
            if (og + 1u == (tg + 1u) * nx) xb_add(&bar[XB_TOPGEN], 1u);
            else XB_SPIN(xb_ld(&bar[XB_TOPGEN]) == tg, bar);
            __builtin_amdgcn_fence(__ATOMIC_ACQUIRE, "agent");
            xb_add(&bar[XB_XGEN(b.x)], 1u);
            asm volatile("s_waitcnt vmcnt(0)" ::: "memory");
        } else {
            XB_SPIN(xb_ld(&bar[XB_XGEN(b.x)]) == gen, bar);
            __builtin_amdgcn_fence(__ATOMIC_ACQUIRE, "agent");
            asm volatile("s_waitcnt vmcnt(0)" ::: "memory");
        }
    }
    __syncthreads();
}

constexpr int RING_OFF = 0, RING_BYTES = pg8::STAGE_BYTES;
constexpr int MISC_OFF = RING_BYTES;
constexpr int RED_OFF = RING_BYTES + 4096;
constexpr int LDS_BYTES = RING_BYTES + 8192;

struct Args { const float* in[N_IN]; float* out; unsigned char* ws; int ph_lo, ph_hi; };

struct Frame {
    LAS unsigned char* lds; volatile LAS unsigned* MISC;
    int tid, lane, wave, vcu, G;
    unsigned char* ws; float* out;
};

__device__ __forceinline__ void transpose_item(const float* W, int K, int N, bf16_t* WT, int dstrow0, int k0, int n0, LAS float* scr, int lane, const float* gk, const float qs = 0.f) {
    if (gk) {
#pragma unroll 8
        for (int i = 0; i < 32; ++i) { const int kk = 2 * i + (lane >> 5); scr[kk * 33 + (lane & 31)] = __builtin_nontemporal_load(&W[(size_t)(k0 + kk) * N + n0 + (lane & 31)]) * gk[k0 + kk]; }
    } else {
#pragma unroll 8
    for (int i = 0; i < 32; ++i) { const int kk = 2 * i + (lane >> 5); scr[kk * 33 + (lane & 31)] = __builtin_nontemporal_load(&W[(size_t)(k0 + kk) * N + n0 + (lane & 31)]); }
    }
    LDS_WAIT(); asm volatile("" ::: "memory");
    const int c = lane & 7;
#pragma unroll
    for (int j = 0; j < 4; ++j) { const int n = (lane >> 3) + 8 * j; const LAS float* s = scr + (8 * c) * 33 + n;
        if (qs < 0.f) { const float q_ = -qs; u32x2 o8; o8.x = pk4_i8(s[0 * 33] * q_, s[1 * 33] * q_, s[2 * 33] * q_, s[3 * 33] * q_); o8.y = pk4_i8(s[4 * 33] * q_, s[5 * 33] * q_, s[6 * 33] * q_, s[7 * 33] * q_);
            *(u32x2*)((unsigned char*)WT + (size_t)(dstrow0 + n) * K + k0 + 8 * c) = o8; }
        else if (qs > 0.f) { u32x2 o8; o8.x = pk4_fp8(s[0 * 33] * qs, s[1 * 33] * qs, s[2 * 33] * qs, s[3 * 33] * qs); o8.y = pk4_fp8(s[4 * 33] * qs, s[5 * 33] * qs, s[6 * 33] * qs, s[7 * 33] * qs);
            *(u32x2*)((unsigned char*)WT + (size_t)(dstrow0 + n) * K + k0 + 8 * c) = o8; }
        else {
        u32x4 o; o.x = cvt_pk_bf16(s[0 * 33], s[1 * 33]); o.y = cvt_pk_bf16(s[2 * 33], s[3 * 33]); o.z = cvt_pk_bf16(s[4 * 33], s[5 * 33]); o.w = cvt_pk_bf16(s[6 * 33], s[7 * 33]);
        *(u32x4*)(WT + (size_t)(dstrow0 + n) * K + k0 + 8 * c) = o; } }
    LDS_WAIT(); asm volatile("" ::: "memory");
}
__device__ __forceinline__ int win_drow(int n0) {
    const int tile = n0 >> 8, pt = n0 & 255;
    if (tile == 2 || tile == 3 || tile == 20) return tile * 256 + ((pt >> 5) & 1) * 128 + (pt >> 6) * 32;
    if (tile == 14) return tile * 256 + ((pt >> 6) & 1) * 128 + (pt >> 7) * 64 + (pt & 63);
    return n0;
}
__device__ __forceinline__ void transpose_job(const float* W, int K, int N, bf16_t* WT, int mode, int item, LAS float* scr, int lane, const float* gk = nullptr, const float qs = 0.f) {
    const int nblk = N / 32, kb = item / nblk, nb = item % nblk, n0 = nb * 32;
    const int drow = mode == 0 ? n0 : (mode == 3 ? win_drow(n0) : ((n0 >> 7) * 256 + (n0 & 127) + (mode == 2 ? 128 : 0)));
    transpose_item(W, K, N, WT, drow, kb * 64, n0, scr, lane, gk, qs);
}
constexpr int IT_WIN = 32 * 162, IT_WUQ = 8 * 24, IT_WUKV = 8 * 32, IT_SQ = 32 * 64, IT_PP = 4 * 64, IT_LAYER = IT_WIN + IT_WUQ + IT_WUKV + 2 * IT_SQ + IT_PP;
constexpr int IT_FF = 32 * 224, IT_FFN = 3 * IT_FF;
constexpr int IT_TOTAL = 2 * IT_LAYER + IT_FFN + NE * IT_FFN;

__device__ __forceinline__ void ffn_job(const float* wg, const float* wu, const float* wd, bf16_t* gu, bf16_t* dn, int r, LAS float* scr, int lane, const float* gk, const bool moe) {
    if (r < IT_FF) { transpose_job(wg, DM, FF, gu, 1, r, scr, lane, gk, -1536.f); return; } r -= IT_FF;
    if (r < IT_FF) { transpose_job(wu, DM, FF, gu, 2, r, scr, lane, gk, -1536.f); return; } r -= IT_FF;
    transpose_job(wd, FF, DM, dn, 0, r, scr, lane, nullptr, 8192.f);
}

__device__ __forceinline__ void rms_row_to_bf16(const float* xrow, const float* g, bf16_t* orow, int lane, float& rinv_out, f32x4 (&v)[8]) {
    const f32x4* xr = (const f32x4*)xrow + lane; float s = 0.f;
#pragma unroll
    for (int j = 0; j < 8; ++j) { v[j] = xr[64 * j]; s += (v[j].x * v[j].x + v[j].y * v[j].y) + (v[j].z * v[j].z + v[j].w * v[j].w); }
    const float rinv = 1.0f / sqrtf(wave_sum(s) * (1.0f / DM) + EPS); rinv_out = rinv;
    u32x2* o8 = (u32x2*)orow + lane;
#pragma unroll
    for (int j = 0; j < 8; ++j) { const f32x4 gg = ((const f32x4*)g)[64 * j + lane]; v[j] = v[j] * rinv * gg;
        u32x2 w; w.x = cvt_pk_bf16(v[j].x, v[j].y); w.y = cvt_pk_bf16(v[j].z, v[j].w); o8[64 * j] = w; }
}


__device__ __forceinline__ void row_hb_ss(const f32x4 (&v)[8], bf16_t* hbrow, float* ssp, int lane) {
    float s = 0.f; u32x2* o8 = (u32x2*)hbrow + lane;
#pragma unroll
    for (int j = 0; j < 8; ++j) { s += (v[j].x * v[j].x + v[j].y * v[j].y) + (v[j].z * v[j].z + v[j].w * v[j].w); u32x2 w; w.x = cvt_pk_bf16(v[j].x, v[j].y); w.y = cvt_pk_bf16(v[j].z, v[j].w); o8[64 * j] = w; }
    s = wave_sum(s);
    if (lane < 8) ssp[lane] = lane == 0 ? s : 0.f;
}

namespace att {
typedef int v4i_t __attribute__((ext_vector_type(4)));
typedef int v8i_t __attribute__((ext_vector_type(8)));
constexpr int KPL = 8192;
constexpr int KBUF = 3 * KPL;
constexpr int VT = 16384;
constexpr int OFF_K = 0, OFF_V = 2 * KBUF, OFF_WS = OFF_V + 2 * VT, OFF_BIAS = OFF_WS + 8 * 256, OFF_QL = OFF_BIAS + 2048, LDS_END = OFF_QL + 8 * 4096;
#define SBAR() __builtin_amdgcn_sched_barrier(0)
__device__ __forceinline__ int crow(int r, int hi) { return (r & 3) + 8 * (r >> 2) + 4 * hi; }
__device__ __forceinline__ int v_st(int k, int c) { const int kk = (k & ~0xC) | ((k & 4) << 1) | ((k & 8) >> 1); return ((kk >> 3) * 4 + (c >> 5)) * 512 + ((kk & 7) * 32 + (c & 31)) * 2; }
__device__ __forceinline__ int v_rd_base(int lane) { return ((lane & 3) << 3) | (((lane >> 2) & 3) << 6) | (((lane >> 4) & 1) << 5) | (((lane >> 5) & 1) << 8); }
constexpr int v_rd_off(int d0, int ks, int half) { return d0 * 512 + ks * 4096 + half * 2048; }
template <int OFF> __device__ __forceinline__ s16x4 tr_read(int vb) {
    s16x4 r; asm volatile("ds_read_b64_tr_b16 %0, %1 offset:%2" : "=&v"(r) : "v"(vb), "i"(OFF) : "memory"); return r;
}
template <int D0> __device__ __forceinline__ void pv_one(f32x16& od, int vb, bf16x8 pa0, bf16x8 pa1, bf16x8 pa2, bf16x8 pa3) {
    const s16x4 l0 = tr_read<v_rd_off(D0, 0, 0)>(vb), h0 = tr_read<v_rd_off(D0, 0, 1)>(vb), l1 = tr_read<v_rd_off(D0, 1, 0)>(vb), h1 = tr_read<v_rd_off(D0, 1, 1)>(vb);
    const s16x4 l2 = tr_read<v_rd_off(D0, 2, 0)>(vb), h2 = tr_read<v_rd_off(D0, 2, 1)>(vb), l3 = tr_read<v_rd_off(D0, 3, 0)>(vb), h3 = tr_read<v_rd_off(D0, 3, 1)>(vb);
    asm volatile("s_waitcnt lgkmcnt(0)" ::: "memory"); SBAR();
#define PK(L, H) (bf16x8){L[0], L[1], L[2], L[3], H[0], H[1], H[2], H[3]}
    od = __builtin_amdgcn_mfma_f32_32x32x16_bf16(pa0, PK(l0, h0), od, 0, 0, 0);
    od = __builtin_amdgcn_mfma_f32_32x32x16_bf16(pa1, PK(l1, h1), od, 0, 0, 0);
    od = __builtin_amdgcn_mfma_f32_32x32x16_bf16(pa2, PK(l2, h2), od, 0, 0, 0);
    od = __builtin_amdgcn_mfma_f32_32x32x16_bf16(pa3, PK(l3, h3), od, 0, 0, 0);
#undef PK
}
__device__ __forceinline__ void partialSM(f32x16& p0, f32x16& p1, float& m_reg, float& alpha, const float C, const float thr) {
    float pmax = p0[0];
#pragma unroll
    for (int r = 1; r < 16; ++r) pmax = fmaxf(pmax, p0[r]);
#pragma unroll
    for (int r = 0; r < 16; ++r) pmax = fmaxf(pmax, p1[r]);
    { auto rr = __builtin_amdgcn_permlane32_swap(__float_as_uint(pmax), __float_as_uint(pmax), false, false);
      pmax = fmaxf(__uint_as_float(rr[0]), __uint_as_float(rr[1])); }
    float mn;
    if (__builtin_expect(__all(pmax - m_reg <= thr), 1)) { mn = m_reg; alpha = 1.f; }
    else { mn = fmaxf(m_reg, pmax); alpha = __builtin_amdgcn_exp2f((m_reg - mn) * C); m_reg = mn; }
    const float mnC = -mn * C;
#pragma unroll
    for (int r = 0; r < 16; ++r) p0[r] = __builtin_amdgcn_exp2f(fmaf(p0[r], C, mnC));
#pragma unroll
    for (int r = 0; r < 16; ++r) p1[r] = __builtin_amdgcn_exp2f(fmaf(p1[r], C, mnC));
}
__device__ __forceinline__ void finishSM(const f32x16& p0, const f32x16& p1, float alpha, float& l_reg, bf16x8& pa0, bf16x8& pa1, bf16x8& pa2, bf16x8& pa3) {
    float ps = 0;
#pragma unroll
    for (int r = 0; r < 16; ++r) ps += p0[r];
#pragma unroll
    for (int r = 0; r < 16; ++r) ps += p1[r];
    { auto rr = __builtin_amdgcn_permlane32_swap(__float_as_uint(ps), __float_as_uint(ps), false, false);
      ps = __uint_as_float(rr[0]) + __uint_as_float(rr[1]); }
    l_reg = l_reg * alpha + ps;
#define PK4(P, BASE, OUT) do { unsigned a0 = cvt_pk_bf16(P[BASE + 0], P[BASE + 1]), a1 = cvt_pk_bf16(P[BASE + 2], P[BASE + 3]);   \
    unsigned b0 = cvt_pk_bf16(P[BASE + 4], P[BASE + 5]), b1 = cvt_pk_bf16(P[BASE + 6], P[BASE + 7]);                              \
    auto r0 = __builtin_amdgcn_permlane32_swap(a0, b0, false, false); auto r1 = __builtin_amdgcn_permlane32_swap(a1, b1, false, false); \
    u32x4 w = {r0[0], r1[0], r0[1], r1[1]}; OUT = *reinterpret_cast<bf16x8*>(&w); } while (0)
    PK4(p0, 0, pa0); PK4(p0, 8, pa1); PK4(p1, 0, pa2); PK4(p1, 8, pa3);
#undef PK4
}

struct Src { const bf16_t* q[3]; const bf16_t* k[3]; const bf16_t* v; int ldq, ldk[3], ldv; };
struct Par { int kt0, nkt; float C, thr; const float* rtab; int qpos0; int na_r0, na_krlo; };

template <int NCH, int MODE, int ROPE_D0S, int ROPE_HW>
__device__ __forceinline__ void attn_pass(LAS unsigned char* lds, const int tid, const Src& S, const Par& P, float& m_reg, float& l_reg, f32x16 (&o)[4]) {
    const int wid = __builtin_amdgcn_readfirstlane(tid >> 6), lane = tid & 63, r32 = lane & 31, hi = lane >> 5;
    LAS float* al_l = (LAS float*)(lds + OFF_WS + wid * 256);
    bf16x8 qr[NCH * 4];
#pragma unroll
    for (int c = 0; c < NCH; ++c)
#pragma unroll
        for (int d = 0; d < 4; ++d) qr[c * 4 + d] = *(const bf16x8*)(S.q[c] + (size_t)(wid * 32 + r32) * S.ldq + d * 16 + hi * 8);
    if constexpr (ROPE_HW > 0) {
        const float* tb = P.rtab + (size_t)(P.qpos0 + wid * 32 + r32) * (ROPE_HW * 32) + hi * 16;
#pragma unroll
        for (int d = 0; d < ROPE_HW; ++d) {
            const f32x4 t0 = *(const f32x4*)(tb + d * 32), t1 = *(const f32x4*)(tb + d * 32 + 4), t2 = *(const f32x4*)(tb + d * 32 + 8), t3 = *(const f32x4*)(tb + d * 32 + 12);
            const float cs[16] = {t0[0], t0[1], t0[2], t0[3], t1[0], t1[1], t1[2], t1[3], t2[0], t2[1], t2[2], t2[3], t3[0], t3[1], t3[2], t3[3]};
            const u32x4 a = *reinterpret_cast<const u32x4*>(&qr[ROPE_D0S + d]), b = *reinterpret_cast<const u32x4*>(&qr[ROPE_D0S + ROPE_HW + d]);
            u32x4 ya, yb;
#pragma unroll
            for (int w = 0; w < 4; ++w) {
                const float x1l = bflo(a[w]), x1h = bfhi(a[w]), x2l = bflo(b[w]), x2h = bfhi(b[w]);
                const float cl = cs[4 * w], sl = cs[4 * w + 1], ch = cs[4 * w + 2], sh = cs[4 * w + 3];
                ya[w] = cvt_pk_bf16(x1l * cl - x2l * sl, x1h * ch - x2h * sh); yb[w] = cvt_pk_bf16(x2l * cl + x1l * sl, x2h * ch + x1h * sh);
            }
            qr[ROPE_D0S + d] = *reinterpret_cast<bf16x8*>(&ya); qr[ROPE_D0S + ROPE_HW + d] = *reinterpret_cast<bf16x8*>(&yb);
        }
    }
    const int krow = tid >> 3, kpc = tid & 7, kst = krow * 128 + ((kpc ^ ((krow >> 1) & 7)) << 4);
    const int sr = tid >> 4, sc = (tid & 15) * 8, vst0 = v_st(sr, sc), vst1 = v_st(32 + sr, sc);
    const int vb0 = (int)(unsigned)(uintptr_t)(lds + OFF_V) + v_rd_base(lane);
    const int ksw = (r32 >> 1) & 7; int kro[4];
#pragma unroll
    for (int d = 0; d < 4; ++d) kro[d] = r32 * 128 + (((d * 2 + hi) ^ ksw) << 4);
    bf16x8 ks[NCH], vs0, vs1;
    unsigned koff[NCH];
#pragma unroll
    for (int c = 0; c < NCH; ++c) koff[c] = (unsigned)(krow * S.ldk[c] + kpc * 8) * 2u;
    const unsigned voff0 = (unsigned)(sr * S.ldv + sc) * 2u, voff1 = (unsigned)((32 + sr) * S.ldv + sc) * 2u;
#define A_SLOAD(k0) do { const int k0_ = __builtin_amdgcn_readfirstlane(k0); _Pragma("unroll") for (int c = 0; c < NCH; ++c) ks[c] = *(const bf16x8*)((const char*)S.k[c] + (size_t)k0_ * S.ldk[c] * 2 + koff[c]); \
        const char* vb_ = (const char*)S.v + (size_t)k0_ * S.ldv * 2; vs0 = *(const bf16x8*)(vb_ + voff0); vs1 = *(const bf16x8*)(vb_ + voff1); } while (0)
#define A_SWRITE(b) do { _Pragma("unroll") for (int c = 0; c < NCH; ++c) *(LAS bf16x8*)(lds + OFF_K + (b) * KBUF + c * KPL + kst) = ks[c]; \
        *(LAS bf16x8*)(lds + OFF_V + (b) * VT + vst0) = vs0; *(LAS bf16x8*)(lds + OFF_V + (b) * VT + vst1) = vs1; } while (0)
    A_SLOAD(P.kt0); VM_WAIT(); A_SWRITE(0); __syncthreads();
    int na_rw = 0, na_rs = 0, na_cq = 0, na_ws = 0, sw_base = 0;
    if constexpr (MODE == 1) { na_rw = P.na_r0 + (wid >> 1); na_rs = min(max(na_rw - 4, 0), 56); na_cq = (wid & 1) * 32 + r32; na_ws = min(max(na_cq - 8, 0), 48); }
    if constexpr (MODE == 2) { sw_base = P.kt0 - (P.qpos0 + wid * 32 + r32) + 128; }
    for (int j = 0; j < P.nkt; ++j) {
        const int b = j & 1;
        if (j + 1 < P.nkt) A_SLOAD(P.kt0 + (j + 1) * 64);
        bool act = true;
        if constexpr (MODE == 1) { const int kr = P.na_krlo + j; act = (kr >= na_rs) && (kr < na_rs + 8); }
        if (act) {
            f32x16 p0 = {}, p1 = {};
            const LAS unsigned char* Kb = lds + OFF_K + b * KBUF;
#pragma unroll
            for (int c = 0; c < NCH; ++c)
#pragma unroll
                for (int d = 0; d < 4; ++d) {
                    const bf16x8 k0v = *(const LAS bf16x8*)(Kb + c * KPL + kro[d]), k1v = *(const LAS bf16x8*)(Kb + c * KPL + 4096 + kro[d]);
                    p0 = __builtin_amdgcn_mfma_f32_32x32x16_bf16(k0v, qr[c * 4 + d], p0, 0, 0, 0);
                    p1 = __builtin_amdgcn_mfma_f32_32x32x16_bf16(k1v, qr[c * 4 + d], p1, 0, 0, 0);
                }
            if constexpr (MODE == 1) {
                const LAS float* bt = (const LAS float*)(lds + OFF_BIAS) + (P.na_krlo + j - na_rw + 7) * 31 + 15;
#pragma unroll
                for (int r = 0; r < 16; ++r) {
                    const int kc0 = crow(r, hi), kc1 = 32 + kc0;
                    const int dc0 = min(max(kc0 - na_cq, -15), 15), dc1 = min(max(kc1 - na_cq, -15), 15);
                    const float b0 = bt[dc0], b1 = bt[dc1];
                    p0[r] = ((unsigned)(kc0 - na_ws) < 16u) ? p0[r] + b0 : -__builtin_inff();
                    p1[r] = ((unsigned)(kc1 - na_ws) < 16u) ? p1[r] + b1 : -__builtin_inff();
                }
            }
            if constexpr (MODE == 2) {
                const int base = sw_base + j * 64;
#pragma unroll
                for (int r = 0; r < 16; ++r) {
                    const int kc0 = crow(r, hi);
                    p0[r] = ((unsigned)(base + kc0) <= 256u) ? p0[r] : -__builtin_inff();
                    p1[r] = ((unsigned)(base + kc0 + 32) <= 256u) ? p1[r] : -__builtin_inff();
                }
            }
            float alpha;
            partialSM(p0, p1, m_reg, alpha, P.C, P.thr);
            if (__any(alpha < 1.f)) {
                if (hi == 0) al_l[r32] = alpha;
                asm volatile("s_waitcnt lgkmcnt(0)" ::: "memory");
#pragma unroll
                for (int r = 0; r < 16; ++r) { const float a = al_l[crow(r, hi)];
#pragma unroll
                    for (int d = 0; d < 4; ++d) o[d][r] *= a; }
            }
            bf16x8 pa0, pa1, pa2, pa3;
            finishSM(p0, p1, alpha, l_reg, pa0, pa1, pa2, pa3); SBAR();
            const int vb = vb0 + b * VT;
            pv_one<0>(o[0], vb, pa0, pa1, pa2, pa3); pv_one<1>(o[1], vb, pa0, pa1, pa2, pa3); pv_one<2>(o[2], vb, pa0, pa1, pa2, pa3); pv_one<3>(o[3], vb, pa0, pa1, pa2, pa3);
        }
        if (j + 1 < P.nkt) { VM_WAIT(); A_SWRITE(b ^ 1); }
        __syncthreads();
    }
#undef A_SLOAD
#undef A_SWRITE
}

__device__ __forceinline__ void partialSM2(f32x16& p0, f32x16& p1, float& m_reg, float& alpha, const float C, const float thr, const float pofs = 0.f) {
    float pmax = p0[0];
#pragma unroll
    for (int r = 1; r < 16; ++r) pmax = fmaxf(pmax, p0[r]);
#pragma unroll
    for (int r = 0; r < 16; ++r) pmax = fmaxf(pmax, p1[r]);
    { auto rr = __builtin_amdgcn_permlane32_swap(__float_as_uint(pmax), __float_as_uint(pmax), false, false);
      pmax = fmaxf(__uint_as_float(rr[0]), __uint_as_float(rr[1])); }
    float mn;
    if (__builtin_expect(__all(pmax - m_reg <= thr), 1)) { mn = m_reg; alpha = 1.f; }
    else { mn = fmaxf(m_reg, pmax); alpha = __builtin_amdgcn_exp2f((m_reg - mn) * C); m_reg = mn; }
    const float mnC = -mn * C + pofs;
#pragma unroll
    for (int r = 0; r < 16; ++r) p0[r] = fmaf(p0[r], C, mnC);
#pragma unroll
    for (int r = 0; r < 16; ++r) p1[r] = fmaf(p1[r], C, mnC);
#pragma unroll
    for (int r = 0; r < 16; ++r) p0[r] = __builtin_amdgcn_exp2f(p0[r]);
}
__device__ __forceinline__ void finishSM2(f32x16& p0, f32x16& p1, float alpha, float& l_reg, bf16x8& pa0, bf16x8& pa1, bf16x8& pa2, bf16x8& pa3) {
#pragma unroll
    for (int r = 0; r < 16; ++r) p1[r] = __builtin_amdgcn_exp2f(p1[r]);
    finishSM(p0, p1, alpha, l_reg, pa0, pa1, pa2, pa3);
}
typedef __bf16 bf16x2_t __attribute__((ext_vector_type(2)));
typedef short s16x2_t __attribute__((ext_vector_type(2)));
__device__ __forceinline__ unsigned cvt4_fp8_bf16(unsigned a, unsigned b) {
    s16x2_t r = {0, 0}; r = __builtin_amdgcn_cvt_scalef32_pk_fp8_bf16(r, __builtin_bit_cast(bf16x2_t, a), 1.0f, false); r = __builtin_amdgcn_cvt_scalef32_pk_fp8_bf16(r, __builtin_bit_cast(bf16x2_t, b), 1.0f, true);
    return __builtin_bit_cast(unsigned, r); }
__device__ __forceinline__ u32x2 cvt8_fp8_bf16(const u32x4 w) { u32x2 e; e.x = cvt4_fp8_bf16(w.x, w.y); e.y = cvt4_fp8_bf16(w.z, w.w); return e; }
__device__ __forceinline__ void finishSM8(f32x16& p0, f32x16& p1, float alpha, float& l_reg, v8i_t& pa8) {
#pragma unroll
    for (int r = 0; r < 16; ++r) p1[r] = __builtin_amdgcn_exp2f(p1[r]);
    float ps = 0;
#pragma unroll
    for (int r = 0; r < 16; ++r) ps += p0[r];
#pragma unroll
    for (int r = 0; r < 16; ++r) ps += p1[r];
    { auto rr = __builtin_amdgcn_permlane32_swap(__float_as_uint(ps), __float_as_uint(ps), false, false);
      ps = __uint_as_float(rr[0]) + __uint_as_float(rr[1]); }
    l_reg = l_reg * alpha + ps;
#pragma unroll
    for (int k = 0; k < 4; ++k) {
        pa8[k] = __builtin_amdgcn_cvt_pk_fp8_f32(p0[4 * k + 2], p0[4 * k + 3], __builtin_amdgcn_cvt_pk_fp8_f32(p0[4 * k], p0[4 * k + 1], 0, false), true);
        pa8[4 + k] = __builtin_amdgcn_cvt_pk_fp8_f32(p1[4 * k + 2], p1[4 * k + 3], __builtin_amdgcn_cvt_pk_fp8_f32(p1[4 * k], p1[4 * k + 1], 0, false), true); }
}
template <int OFF> __device__ __forceinline__ u32x2 tr8_read(int vb) {
    u32x2 r; asm volatile("ds_read_b64_tr_b8 %0, %1 offset:%2" : "=&v"(r) : "v"(vb), "i"(OFF) : "memory"); return r;
}
template <int D0> __device__ __forceinline__ void pv8_one(f32x16& od, int vb, const v8i_t pa8) {
    const u32x2 t0 = tr8_read<D0 * 256>(vb), t1 = tr8_read<D0 * 256 + 2048>(vb), t2 = tr8_read<D0 * 256 + 4096>(vb), t3 = tr8_read<D0 * 256 + 6144>(vb);
    asm volatile("s_waitcnt lgkmcnt(0)" ::: "memory"); SBAR();
    const v8i_t vf = {(int)t0.x, (int)t0.y, (int)t1.x, (int)t1.y, (int)t2.x, (int)t2.y, (int)t3.x, (int)t3.y};
    od = __builtin_amdgcn_mfma_scale_f32_32x32x64_f8f6f4(pa8, vf, od, 0, 0, 0, 0x7f7f7f7f, 0, 0x7f7f7f7f);
}
template <int NCH, int ROPE_D0S, int ROPE_HW, int SDEPTH, int QLDS, int K8 = 0>
__device__ __forceinline__ void attn_pass_pipe(LAS unsigned char* lds, const int tid, const Src& S, const Par& P, float& m_reg, float& l_reg, f32x16 (&o)[4]) {
    const int wid = __builtin_amdgcn_readfirstlane(tid >> 6), lane = tid & 63, r32 = lane & 31, hi = lane >> 5;
    LAS float* al_l = (LAS float*)(lds + OFF_WS + wid * 256);
    bf16x8 qr[NCH * 4];
#pragma unroll
    for (int c = 0; c < NCH; ++c)
#pragma unroll
        for (int d = 0; d < 4; ++d) qr[c * 4 + d] = *(const bf16x8*)(S.q[c] + (size_t)(wid * 32 + r32) * S.ldq + d * 16 + hi * 8);
    v8i_t q8[K8 ? NCH : 1]; (void)q8;
#define P_Q8(c) do { _Pragma("unroll") for (int d = 0; d < 4; ++d) { const u32x2 e_ = cvt8_fp8_bf16(*reinterpret_cast<const u32x4*>(&qr[(c) * 4 + d])); q8[c][d * 2] = (int)e_.x; q8[c][d * 2 + 1] = (int)e_.y; } } while (0)
    if constexpr (K8) {
#pragma unroll
        for (int c = 0; c < NCH; ++c) if (ROPE_HW == 0 || c * 4 + 3 < ROPE_D0S) P_Q8(c);
    }
    if constexpr (ROPE_HW > 0) {
        const float* tb = P.rtab + (size_t)(P.qpos0 + wid * 32 + r32) * (ROPE_HW * 32) + hi * 16;
#pragma unroll
        for (int d = 0; d < ROPE_HW; ++d) {
            const f32x4 t0 = *(const f32x4*)(tb + d * 32), t1 = *(const f32x4*)(tb + d * 32 + 4), t2 = *(const f32x4*)(tb + d * 32 + 8), t3 = *(const f32x4*)(tb + d * 32 + 12);
            const float cs[16] = {t0[0], t0[1], t0[2], t0[3], t1[0], t1[1], t1[2], t1[3], t2[0], t2[1], t2[2], t2[3], t3[0], t3[1], t3[2], t3[3]};
            const u32x4 a = *reinterpret_cast<const u32x4*>(&qr[ROPE_D0S + d]), b = *reinterpret_cast<const u32x4*>(&qr[ROPE_D0S + ROPE_HW + d]);
            u32x4 ya, yb;
#pragma unroll
            for (int w = 0; w < 4; ++w) {
                const float x1l = bflo(a[w]), x1h = bfhi(a[w]), x2l = bflo(b[w]), x2h = bfhi(b[w]);
                const float cl = cs[4 * w], sl = cs[4 * w + 1], ch = cs[4 * w + 2], sh = cs[4 * w + 3];
                ya[w] = cvt_pk_bf16(x1l * cl - x2l * sl, x1h * ch - x2h * sh); yb[w] = cvt_pk_bf16(x2l * cl + x1l * sl, x2h * ch + x1h * sh);
            }
            qr[ROPE_D0S + d] = *reinterpret_cast<bf16x8*>(&ya); qr[ROPE_D0S + ROPE_HW + d] = *reinterpret_cast<bf16x8*>(&yb);
        }
    }
    const int krow = tid >> 3, kpc = tid & 7, kst = krow * 128 + ((kpc ^ ((krow >> 1) & 7)) << 4);
    const int sr = tid >> 4, sc = (tid & 15) * 8, vst0 = v_st(sr, sc), vst1 = v_st(32 + sr, sc);
    const int vb0 = (int)(unsigned)(uintptr_t)(lds + OFF_V) + v_rd_base(lane);
    const int ksw = (r32 >> 1) & 7; int kro[4];
#pragma unroll
    for (int d = 0; d < 4; ++d) kro[d] = r32 * 128 + (((d * 2 + hi) ^ ksw) << 4);
    LAS unsigned char* qlds = lds + OFF_QL + wid * (QLDS > 0 ? QLDS : 1) * 4096 + lane * 16;
    if constexpr (QLDS > 0) {
#pragma unroll
        for (int c = NCH - QLDS; c < NCH; ++c)
#pragma unroll
            for (int d = 0; d < 4; ++d) *(LAS bf16x8*)(qlds + ((c - (NCH - QLDS)) * 4 + d) * 1024) = qr[c * 4 + d];
        asm volatile("s_waitcnt lgkmcnt(0)" ::: "memory");
    }
    if constexpr (K8) {
        static_assert(QLDS == 0, "K8: Q stays in registers");
#pragma unroll
        for (int c = 0; c < NCH; ++c) if (!(ROPE_HW == 0 || c * 4 + 3 < ROPE_D0S)) P_Q8(c);
    }
#undef P_Q8
    constexpr int KS8 = (NCH == 1) ? 80 : 208;
    const int kst8 = krow * KS8 + (kpc & 1) * 32 + (kpc >> 1) * 8, kro8 = r32 * KS8 + hi * 32; (void)kst8; (void)kro8;
    const int vst8 = (((sr >> 4) * 2 + ((sr >> 2) & 1)) * 8 + (sc >> 4)) * 128 + ((sr & 3) | (((sr >> 3) & 1) << 2)) * 16 + ((sc >> 3) & 1) * 8;
    const int vb8 = (int)(unsigned)(uintptr_t)(lds + OFF_V) + (lane >> 5) * 1024 + ((lane >> 4) & 1) * 128 + ((lane & 15) >> 1) * 16 + (lane & 1) * 8; (void)vst8; (void)vb8;
    v8i_t pa8; (void)pa8;
    struct Slot { bf16x8 ks[NCH], vs0, vs1; } st[SDEPTH];
    constexpr int SE = 0, SO = SDEPTH - 1;
    unsigned koff[NCH];
#pragma unroll
    for (int c = 0; c < NCH; ++c) koff[c] = (unsigned)(krow * S.ldk[c] + kpc * 8) * 2u;
    const unsigned voff0 = (unsigned)(sr * S.ldv + sc) * 2u, voff1 = (unsigned)((32 + sr) * S.ldv + sc) * 2u;
#define P_SLOAD(i, k0) do { const int k0_ = __builtin_amdgcn_readfirstlane(k0); _Pragma("unroll") for (int c = 0; c < NCH; ++c) st[i].ks[c] = *(const bf16x8*)((const char*)S.k[c] + (size_t)k0_ * S.ldk[c] * 2 + koff[c]); \
        const char* vb_ = (const char*)S.v + (size_t)k0_ * S.ldv * 2; st[i].vs0 = *(const bf16x8*)(vb_ + voff0); st[i].vs1 = *(const bf16x8*)(vb_ + voff1); } while (0)
#define P_SWRITE(b, i) do { if constexpr (K8) { _Pragma("unroll") for (int c = 0; c < NCH; ++c) { *(LAS u32x2*)(lds + OFF_K + (b) * KBUF + c * 64 + kst8) = cvt8_fp8_bf16(*reinterpret_cast<const u32x4*>(&st[i].ks[c])); } } \
        else { _Pragma("unroll") for (int c = 0; c < NCH; ++c) *(LAS bf16x8*)(lds + OFF_K + (b) * KBUF + c * KPL + kst) = st[i].ks[c]; } \
        if constexpr (K8) { *(LAS u32x2*)(lds + OFF_V + (b) * VT + vst8) = cvt8_fp8_bf16(*reinterpret_cast<const u32x4*>(&st[i].vs0)); *(LAS u32x2*)(lds + OFF_V + (b) * VT + vst8 + 4096) = cvt8_fp8_bf16(*reinterpret_cast<const u32x4*>(&st[i].vs1)); } \
        else { *(LAS bf16x8*)(lds + OFF_V + (b) * VT + vst0) = st[i].vs0; *(LAS bf16x8*)(lds + OFF_V + (b) * VT + vst1) = st[i].vs1; } } while (0)
#define P_SWAIT() do { if constexpr (SDEPTH == 2) { if constexpr (NCH == 1) asm volatile("s_waitcnt vmcnt(3)" ::: "memory"); else if constexpr (NCH == 2) asm volatile("s_waitcnt vmcnt(4)" ::: "memory"); else asm volatile("s_waitcnt vmcnt(5)" ::: "memory"); } \
        else asm volatile("s_waitcnt vmcnt(0)" ::: "memory"); } while (0)
#define P_QKT(p0, p1, b) do { p0 = f32x16{}; p1 = f32x16{}; const LAS unsigned char* Kb_ = lds + OFF_K + (b) * KBUF; \
        if constexpr (K8) { _Pragma("unroll") for (int c = 0; c < NCH; ++c) { \
            const v4i_t a0_ = *(const LAS v4i_t*)(Kb_ + c * 64 + kro8), a1_ = *(const LAS v4i_t*)(Kb_ + c * 64 + kro8 + 16), b0_ = *(const LAS v4i_t*)(Kb_ + 32 * KS8 + c * 64 + kro8), b1_ = *(const LAS v4i_t*)(Kb_ + 32 * KS8 + c * 64 + kro8 + 16); \
            p0 = __builtin_amdgcn_mfma_scale_f32_32x32x64_f8f6f4(__builtin_shufflevector(a0_, a1_, 0, 1, 2, 3, 4, 5, 6, 7), q8[c], p0, 0, 0, 0, 0x7f7f7f7f, 0, 0x7f7f7f7f); \
            p1 = __builtin_amdgcn_mfma_scale_f32_32x32x64_f8f6f4(__builtin_shufflevector(b0_, b1_, 0, 1, 2, 3, 4, 5, 6, 7), q8[c], p1, 0, 0, 0, 0x7f7f7f7f, 0, 0x7f7f7f7f); } } else \
        _Pragma("unroll") for (int c = 0; c < NCH; ++c) _Pragma("unroll") for (int d = 0; d < 4; ++d) { \
            const bf16x8 k0v = *(const LAS bf16x8*)(Kb_ + c * KPL + kro[d]), k1v = *(const LAS bf16x8*)(Kb_ + c * KPL + 4096 + kro[d]); \
            const bf16x8 qv_ = (c < NCH - QLDS) ? qr[c * 4 + d] : *(const LAS bf16x8*)(qlds + ((c - (NCH - QLDS)) * 4 + d) * 1024); \
            p0 = __builtin_amdgcn_mfma_f32_32x32x16_bf16(k0v, qv_, p0, 0, 0, 0); p1 = __builtin_amdgcn_mfma_f32_32x32x16_bf16(k1v, qv_, p1, 0, 0, 0); } } while (0)
#define P_FIN(pX0, pX1, alX) do { if constexpr (K8) finishSM8(pX0, pX1, alX, l_reg, pa8); else finishSM2(pX0, pX1, alX, l_reg, pa0, pa1, pa2, pa3); } while (0)
#define P_PV(b) do { if constexpr (K8) { const int vb_ = vb8 + (b) * VT; pv8_one<0>(o[0], vb_, pa8); pv8_one<1>(o[1], vb_, pa8); pv8_one<2>(o[2], vb_, pa8); pv8_one<3>(o[3], vb_, pa8); } else { const int vb_ = vb0 + (b) * VT; pv_one<0>(o[0], vb_, pa0, pa1, pa2, pa3); pv_one<1>(o[1], vb_, pa0, pa1, pa2, pa3); pv_one<2>(o[2], vb_, pa0, pa1, pa2, pa3); pv_one<3>(o[3], vb_, pa0, pa1, pa2, pa3); } } while (0)
#define P_RESC(a) do { if (__any((a) < 1.f)) { if (hi == 0) al_l[r32] = (a); asm volatile("s_waitcnt lgkmcnt(0)" ::: "memory"); \
        _Pragma("unroll") for (int r = 0; r < 16; ++r) { const float a_ = al_l[crow(r, hi)]; _Pragma("unroll") for (int d = 0; d < 4; ++d) o[d][r] *= a_; } } } while (0)
    f32x16 pA0, pA1, pB0, pB1; float alA, alB; bf16x8 pa0, pa1, pa2, pa3; const int NT = P.nkt, kt0 = P.kt0;
    __syncthreads();
    P_SLOAD(SE, kt0); VM_WAIT(); P_SWRITE(0, SE); __syncthreads();
    P_QKT(pA0, pA1, 0); partialSM2(pA0, pA1, m_reg, alA, P.C, P.thr, K8 ? 4.0f : 0.f);
    P_SLOAD(SO, kt0 + 64); if constexpr (SDEPTH == 2) { P_SLOAD(SE, kt0 + 128); }
    P_SWAIT(); P_SWRITE(1, SO); __syncthreads();
    for (int j = 1; j + 1 < NT; j += 2) {
        SBAR(); P_QKT(pB0, pB1, 1);
        P_FIN(pA0, pA1, alA); SBAR();
        P_SLOAD(SO, kt0 + (j + SDEPTH) * 64); SBAR();
        P_PV(0); partialSM2(pB0, pB1, m_reg, alB, P.C, P.thr, K8 ? 4.0f : 0.f);
        __syncthreads(); P_SWAIT(); P_SWRITE(0, SE);
        P_RESC(alB); __syncthreads();
        SBAR(); P_QKT(pA0, pA1, 0);
        P_FIN(pB0, pB1, alB); SBAR();
        if (SDEPTH == 1 || j + 3 < NT) P_SLOAD(SE, kt0 + (j + 1 + SDEPTH) * 64); SBAR();
        P_PV(1); partialSM2(pA0, pA1, m_reg, alA, P.C, P.thr, K8 ? 4.0f : 0.f);
        __syncthreads(); P_SWAIT(); P_SWRITE(1, SO);
        P_RESC(alA); __syncthreads();
    }
    SBAR(); P_QKT(pB0, pB1, 1);
    P_FIN(pA0, pA1, alA); SBAR();
    P_PV(0); partialSM2(pB0, pB1, m_reg, alB, P.C, P.thr, K8 ? 4.0f : 0.f);
    P_RESC(alB);
    P_FIN(pB0, pB1, alB); SBAR();
    P_PV(1);
#undef P_SLOAD
#undef P_SWRITE
#undef P_SWAIT
#undef P_QKT
#undef P_PV
#undef P_FIN
#undef P_RESC
}
__device__ __forceinline__ void normalize(LAS unsigned char* lds, const int tid, const float l_reg, f32x16 (&o)[4]) {
    const int wid = __builtin_amdgcn_readfirstlane(tid >> 6), lane = tid & 63, r32 = lane & 31, hi = lane >> 5;
    LAS float* li_l = (LAS float*)(lds + OFF_WS + wid * 256) + 32;
    if (hi == 0) li_l[r32] = l_reg;
    asm volatile("s_waitcnt lgkmcnt(0)" ::: "memory");
#pragma unroll
    for (int r = 0; r < 16; ++r) { const float rl = __builtin_amdgcn_rcpf(li_l[crow(r, hi)]);
#pragma unroll
        for (int d = 0; d < 4; ++d) o[d][r] *= rl; }
    asm volatile("s_waitcnt lgkmcnt(0)" ::: "memory");
}
__device__ __forceinline__ void store_o(bf16_t* O, const int ldo, const int tid, const f32x16 (&o)[4]) {
    const int wid = __builtin_amdgcn_readfirstlane(tid >> 6), lane = tid & 63, r32 = lane & 31, hi = lane >> 5;
#pragma unroll
    for (int r = 0; r < 16; ++r) { bf16_t* rowp = O + (size_t)(wid * 32 + crow(r, hi)) * ldo + r32;
#pragma unroll
        for (int d = 0; d < 4; ++d) rowp[d * 32] = f2bf(o[d][r]); }
}
__device__ __forceinline__ void store_o8(unsigned char* O8, const int ldo, const int tid, const f32x16 (&o)[4]) {
    const int wid = __builtin_amdgcn_readfirstlane(tid >> 6), lane = tid & 63, r32 = lane & 31, hi = lane >> 5;
#pragma unroll
    for (int r = 0; r < 16; ++r) { unsigned char* rowp = O8 + (size_t)(wid * 32 + crow(r, hi)) * ldo + r32;
#pragma unroll
        for (int d = 0; d < 4; ++d) rowp[d * 32] = (unsigned char)(signed char)(int)rintf(__builtin_amdgcn_fmed3f(o[d][r] * (127.0f / 1.5f), -127.f, 127.f)); }
}
}

#if NAIVE_ATTN
template <int MODE>
__global__ void __launch_bounds__(256) naive_attn(Args args, int layer) {
    unsigned char* ws = args.ws;
    const bf16_t* z = (const bf16_t*)(ws + WS_Z); bf16_t* mix = (bf16_t*)(ws + WS_MIX);
    const float* tab64 = (const float*)(ws + WS_TAB64); const float* tab128 = (const float*)(ws + WS_TAB128);
    const int lane = threadIdx.x & 63; const int gw = blockIdx.x * 4 + (threadIdx.x >> 6);
    const int b = gw / (4 * SEQ), h = (gw / SEQ) & 3, i = gw % SEQ; const size_t rb = (size_t)b * SEQ;
    if constexpr (MODE == 0) {
        float lam; { float a = lane < 64 ? args.in[I_LQ1][layer * 64 + lane] * args.in[I_LK1][layer * 64 + lane] : 0.f, c = args.in[I_LQ2][layer * 64 + lane] * args.in[I_LK2][layer * 64 + lane];
            const float li = 0.8f - 0.6f * expf(-0.3f * layer); lam = expf(wave_sum(a)) - expf(wave_sum(c)) + li; }
        const float li = 0.8f - 0.6f * expf(-0.3f * layer);
        float oc[2][2];
        for (int comp = 0; comp < 2; ++comp) {
            float q = bf2f(z[(rb + i) * ZP + h * 128 + comp * 64 + lane]);
            { const float qo = __shfl_xor(q, 32); const int j = lane & 31; const float c = tab64[((size_t)i * 32 + j) * 2], s = tab64[((size_t)i * 32 + j) * 2 + 1];
              q = lane < 32 ? q * c - qo * s : q * c + qo * s; }
            float m = -1e30f, l = 0.f, o0 = 0.f, o1 = 0.f;
            for (int k = 0; k < SEQ; ++k) {
                const float kk = bf2f(z[(rb + k) * ZP + 512 + h * 128 + comp * 64 + lane]);
                const float s = wave_sum(q * kk) * 0.125f;
                const float mn = fmaxf(m, s), al = __expf(m - mn), p = __expf(s - mn);
                l = l * al + p; o0 = o0 * al + p * bf2f(z[(rb + k) * ZP + 1024 + h * 128 + lane]); o1 = o1 * al + p * bf2f(z[(rb + k) * ZP + 1024 + h * 128 + 64 + lane]); m = mn;
            }
            oc[comp][0] = o0 / l; oc[comp][1] = o1 / l;
        }
        const float a0 = oc[0][0] - lam * oc[1][0], a1 = oc[0][1] - lam * oc[1][1];
        const float r = 1.0f / sqrtf(wave_sum(a0 * a0 + a1 * a1) * (1.0f / 128) + EPS);
        mix[(rb + i) * DM + h * 128 + lane] = f2bf(a0 * r * args.in[I_SUBLN][layer * 128 + lane] * (1.f - li));
        mix[(rb + i) * DM + h * 128 + 64 + lane] = f2bf(a1 * r * args.in[I_SUBLN][layer * 128 + 64 + lane] * (1.f - li));
    } else if constexpr (MODE == 1) {
        const float* rpb = args.in[I_RPB] + ((size_t)layer * 4 + h) * 15 * 31;
        const int r = i >> 6, c = i & 63, rs = min(max(r - 4, 0), 56), wsx = min(max(c - 8, 0), 48);
        const float q0 = bf2f(z[(rb + i) * ZP + O_NA + h * 128 + lane]), q1 = bf2f(z[(rb + i) * ZP + O_NA + h * 128 + 64 + lane]);
        float m = -1e30f, l = 0.f, o0 = 0.f, o1 = 0.f;
        for (int a = 0; a < 8; ++a) for (int cc = 0; cc < 16; ++cc) {
            const int kr = rs + a, kc = wsx + cc; const size_t kt = rb + kr * 64 + kc;
            const float s = wave_sum(q0 * bf2f(z[kt * ZP + O_NA + 512 + h * 128 + lane]) + q1 * bf2f(z[kt * ZP + O_NA + 512 + h * 128 + 64 + lane])) * 0.08838834764831845f + rpb[(kr - r + 7) * 31 + (kc - c + 15)];
            const float mn = fmaxf(m, s), al = __expf(m - mn), p = __expf(s - mn);
            l = l * al + p; o0 = o0 * al + p * bf2f(z[kt * ZP + O_NA + 1024 + h * 128 + lane]); o1 = o1 * al + p * bf2f(z[kt * ZP + O_NA + 1024 + h * 128 + 64 + lane]); m = mn;
        }
        mix[(rb + i) * DM + 512 + h * 128 + lane] = f2bf(o0 / l); mix[(rb + i) * DM + 512 + h * 128 + 64 + lane] = f2bf(o1 / l);
    } else if constexpr (MODE == 2) {
        const int kvh = h >> 1;
        float q0 = bf2f(z[(rb + i) * ZP + O_SWA + h * 128 + lane]), q1 = bf2f(z[(rb + i) * ZP + O_SWA + h * 128 + 64 + lane]);
        { const float c = tab128[((size_t)i * 64 + lane) * 2], s = tab128[((size_t)i * 64 + lane) * 2 + 1]; const float a = q0 * c - q1 * s, d = q1 * c + q0 * s; q0 = a; q1 = d; }
        float m = args.in[I_SINKS][layer * 4 + h], l = 1.f, o0 = 0.f, o1 = 0.f;
        for (int k = max(0, i - 128); k <= min(SEQ - 1, i + 128); ++k) {
            const size_t kt = rb + k;
            const float s = wave_sum(q0 * bf2f(z[kt * ZP + O_SWA + 512 + kvh * 128 + lane]) + q1 * bf2f(z[kt * ZP + O_SWA + 512 + kvh * 128 + 64 + lane])) * 0.08838834764831845f;
            const float mn = fmaxf(m, s), al = __expf(m - mn), p = __expf(s - mn);
            l = l * al + p; o0 = o0 * al + p * bf2f(z[kt * ZP + O_SWA + 768 + kvh * 128 + lane]); o1 = o1 * al + p * bf2f(z[kt * ZP + O_SWA + 768 + kvh * 128 + 64 + lane]); m = mn;
        }
        mix[(rb + i) * DM + 1024 + h * 128 + lane] = f2bf(o0 / l); mix[(rb + i) * DM + 1024 + h * 128 + 64 + lane] = f2bf(o1 / l);
    } else {
        const bf16_t* qm = (const bf16_t*)(ws + WS_QM); const bf16_t* kvm = (const bf16_t*)(ws + WS_KVM);
        const float q0 = bf2f(qm[(rb + i) * QMW + h * 192 + lane]), q1 = bf2f(qm[(rb + i) * QMW + h * 192 + 64 + lane]); float q2 = bf2f(qm[(rb + i) * QMW + h * 192 + 128 + lane]);
        { const float qo = __shfl_xor(q2, 32); const int j = lane & 31; const float c = tab64[((size_t)i * 32 + j) * 2], s = tab64[((size_t)i * 32 + j) * 2 + 1];
          q2 = lane < 32 ? q2 * c - qo * s : q2 * c + qo * s; }
        float m = -1e30f, l = 0.f, o0 = 0.f, o1 = 0.f;
        for (int k = 0; k < SEQ; ++k) {
            const size_t kt = rb + k;
            const float s = wave_sum(q0 * bf2f(kvm[kt * KVW + h * 256 + lane]) + q1 * bf2f(kvm[kt * KVW + h * 256 + 64 + lane]) + q2 * bf2f(z[kt * ZP + 5120 + lane])) * 0.07216878364870322f;
            const float mn = fmaxf(m, s), al = __expf(m - mn), p = __expf(s - mn);
            l = l * al + p; o0 = o0 * al + p * bf2f(kvm[kt * KVW + h * 256 + 128 + lane]); o1 = o1 * al + p * bf2f(kvm[kt * KVW + h * 256 + 192 + lane]); m = mn;
        }
        mix[(rb + i) * DM + 1536 + h * 128 + lane] = f2bf(o0 / l); mix[(rb + i) * DM + 1536 + h * 128 + 64 + lane] = f2bf(o1 / l);
    }
}
#endif

#define QUANT_ROWS(HSRC, SSP) do { const float* ssp = (SSP); \
    for (int m = gw; m < NTOK; m += NGW) { \
        const f32x4 pa_ = *(const f32x4*)(ssp + (size_t)m * 8), pb_ = *(const f32x4*)(ssp + (size_t)m * 8 + 4); \
        const float ri = 1.0f / sqrtf((((pa_[0] + pa_[1]) + (pa_[2] + pa_[3])) + ((pb_[0] + pb_[1]) + (pb_[2] + pb_[3]))) * (1.0f / DM) + EPS); \
        const u32x2* xr = (const u32x2*)((HSRC) + (size_t)m * DM) + lane; unsigned* hq = (unsigned*)(ws + WS_HQ8 + (size_t)m * DM) + lane; \
        u32x2 w_[8]; float am = 0.f; \
        _Pragma("unroll") for (int j = 0; j < 8; ++j) { w_[j] = xr[64 * j]; am = fmaxf(am, fmaxf(fmaxf(fabsf(bflo(w_[j].x)), fabsf(bfhi(w_[j].x))), fmaxf(fabsf(bflo(w_[j].y)), fabsf(bfhi(w_[j].y))))); } \
        am = fmaxf(wave_max(am), 1e-20f); const float sq_ = 127.0f / am; \
        if (lane == 0) TRINV[m] = am * ri * (1.0f / (127.0f * 1536.0f)); \
        _Pragma("unroll") for (int j = 0; j < 8; ++j) hq[64 * j] = pk4_i8(bflo(w_[j].x) * sq_, bfhi(w_[j].x) * sq_, bflo(w_[j].y) * sq_, bfhi(w_[j].y) * sq_); \
    } } while (0)
constexpr int PH_PER_LAYER = 12, N_PHASES = 1 + DEPTH * PH_PER_LAYER;

#define INP(i) ((const float*)(const GAS float*)args.in[opaque_idx(i)])
__device__ __forceinline__ int opaque_idx(int i) { asm volatile("" : "+s"(i)); return i; }
__global__ void __launch_bounds__(NTHR, 2) fwd(Args args) {
    extern __shared__ __attribute__((aligned(16))) unsigned char lds_raw[];
    for (int u = threadIdx.x; u < 1024; u += NTHR) ((LAS unsigned*)((LAS unsigned char*)lds_raw + MISC_OFF))[u] = 0u;
    __syncthreads();
#if MK_ONE_LAUNCH
    { (void)xcd_barrier_post((unsigned*)(args.ws + WS_CTL) + CW_BAR, (volatile LAS unsigned*)((LAS unsigned char*)lds_raw + MISC_OFF) + 8, threadIdx.x == 0); }
#define GRID_BAR() do { unsigned on_ = ~0u; asm volatile("" : "+s"(on_)); int l_ = __builtin_amdgcn_mbcnt_hi(on_, __builtin_amdgcn_mbcnt_lo(on_, 0u)); XcdBarrier b_; \
    unsigned long long wsb_ = (unsigned long long)args.ws; asm volatile("" : "+s"(wsb_)); b_.bar = (unsigned*)(GAS unsigned*)(wsb_ + WS_CTL) + CW_BAR; b_.x = xb_xcc_id(); \
    b_.st = (volatile LAS unsigned*)((LAS unsigned char*)lds_raw + MISC_OFF) + 8; xcd_barrier(b_, (l_ == 0) && (wave_s == 0)); } while (0)
#else
#define GRID_BAR() do {} while (0)
#endif
    const int wave_s = __builtin_amdgcn_readfirstlane((int)threadIdx.x >> 6);
    const int lo = args.ph_lo, hi = args.ph_hi;
#ifndef PH_MASK
#define PH_MASK 0xFFFFFFFFu
#endif
#define INREL(rel) ((PH_MASK >> (rel)) & 1u)
#ifndef PROBE_REP
#define PROBE_REP -1
#endif
#define NREP(rel) ((PROBE_REP) == (rel) ? 2 : 1)
#define IN(k) (lo <= (k) && (k) < hi)
#define SEAM(k) do { if (IN(k) && IN((k) + 1)) GRID_BAR(); } while (0)
#define PH_LOCALS \
    unsigned ones_o = ~0u; asm volatile("" : "+s"(ones_o)); \
    int lane_o = __builtin_amdgcn_mbcnt_hi(ones_o, __builtin_amdgcn_mbcnt_lo(ones_o, 0u)); asm volatile("" : "+v"(lane_o)); \
    int wave_o = wave_s; asm volatile("" : "+s"(wave_o)); const int tid_o = wave_o * 64 + lane_o; \
    unsigned long long ws_q = (unsigned long long)args.ws; asm volatile("" : "+s"(ws_q)); unsigned char* ws = (unsigned char*)(GAS unsigned char*)ws_q; \
    unsigned long long out_q = (unsigned long long)args.out; asm volatile("" : "+s"(out_q)); float* OUTP = (float*)(GAS float*)out_q; \
    Frame F; F.lds = (LAS unsigned char*)lds_raw; F.MISC = (volatile LAS unsigned*)(F.lds + MISC_OFF); \
    F.tid = tid_o; F.lane = lane_o; F.wave = wave_o; F.G = gridDim.x; \
    { const int bx = blockIdx.x; F.vcu = (F.G % 8 == 0) ? (bx % 8) * (F.G / 8) + bx / 8 : bx; } \
    const int gw = F.vcu * NWAVES + F.wave, NGW = F.G * NWAVES, lane = F.lane; \
    unsigned* ctl = (unsigned*)(ws + WS_CTL); \
    bf16_t* HN = (bf16_t*)(ws + WS_HN); bf16_t* Z = (bf16_t*)(ws + WS_Z); bf16_t* MIX = (bf16_t*)(ws + WS_MIX); \
    bf16_t* QM = (bf16_t*)(ws + WS_QM); bf16_t* KVM = (bf16_t*)(ws + WS_KVM); bf16_t* PPB = (bf16_t*)(ws + WS_PP); \
    bf16_t* ACT = (bf16_t*)(ws + WS_ACT); bf16_t* XG = (bf16_t*)(ws + WS_XG); bf16_t* HB2 = (bf16_t*)(ws + WS_HB2); (void)HB2; \
    float* tab64 = (float*)(ws + WS_TAB64); float* tab128 = (float*)(ws + WS_TAB128); \
    unsigned* MOEI = (unsigned*)(ws + WS_MOEI); float* SSH = (float*)(ws + WS_SSH); float* TRINV = (float*)(ws + WS_TRINV); float* SRINV = (float*)(ws + WS_SRINV); \
    LAS float* RED = (LAS float*)(F.lds + RED_OFF); (void)SSH; (void)TRINV; (void)SRINV; (void)RED; \
    (void)gw; (void)NGW; (void)lane; (void)ctl; (void)HN; (void)Z; (void)MIX; (void)QM; (void)KVM; (void)PPB; (void)ACT; (void)XG; (void)tab64; (void)tab128; (void)MOEI; (void)OUTP;

    for (int rep_ = 0; rep_ < NREP(31); ++rep_) if (INREL(31) && IN(0)) { PH_LOCALS
        LAS float* scr = (LAS float*)(F.lds + RING_OFF + F.wave * 16384);
        for (int it = gw; it < IT_TOTAL; it += NGW) {
            int r = it;
            if (r < 2 * IT_LAYER) {
                const int L = r / IT_LAYER; r -= L * IT_LAYER;
                if (r < IT_WIN) { transpose_job(INP(I_W_IN) + (size_t)L * DM * ZC, DM, ZC, (bf16_t*)(ws + WS_WIN + L * SZ_WIN), 3, r, scr, lane, INP(I_ATTN_NORM) + L * DM, -1536.f); continue; } r -= IT_WIN;
                if (r < IT_WUQ) { transpose_job(INP(I_WUQ) + (size_t)L * 512 * QMW, 512, QMW, (bf16_t*)(ws + WS_WUQ + L * SZ_WUQ), 0, r, scr, lane, INP(I_QNORM) + L * 512); continue; } r -= IT_WUQ;
                if (r < IT_WUKV) { transpose_job(INP(I_WUKV) + (size_t)L * 512 * KVW, 512, KVW, (bf16_t*)(ws + WS_WUKV + L * SZ_WUKV), 0, r, scr, lane, INP(I_KVNORM) + L * 512); continue; } r -= IT_WUKV;
                if (r < IT_SQ) { const int kb_ = r / (DM / 32), n0_ = (r % (DM / 32)) * 32;
                    if (kb_ < 8) transpose_item(INP(I_WOUT) + (size_t)L * DM * DM, DM, DM, (bf16_t*)(ws + WS_WOUT + L * SZ_WSQ), n0_, kb_ * 64, n0_, scr, lane, nullptr);
                    else transpose_item(INP(I_WOUT) + (size_t)L * DM * DM, DM * 2, DM, (bf16_t*)(ws + WS_WOUT + L * SZ_WSQ + 512), n0_, kb_ * 64, n0_, scr, lane, nullptr, -1536.f);
                    continue; } r -= IT_SQ;
                if (r < IT_SQ) { transpose_job(INP(I_PLE_GATE) + (size_t)L * DM * DM, DM, DM, (bf16_t*)(ws + WS_WPG + L * SZ_WSQ), 0, r, scr, lane, INP(I_PLE_NORM) + L * DM, (L & 1) ? 4096.f : -1536.f); continue; } r -= IT_SQ;
                transpose_job(INP(I_PLE_PROJ) + (size_t)L * PLE * DM, PLE, DM, (bf16_t*)(ws + WS_WPP + L * SZ_WPP), 0, r, scr, lane); continue;
            }
            r -= 2 * IT_LAYER;
            if (r < IT_FFN) { ffn_job(INP(I_DG), INP(I_DU), INP(I_DD), (bf16_t*)(ws + WS_DGU), (bf16_t*)(ws + WS_DDN), r, scr, lane, INP(I_FFN_NORM), false); continue; }
            r -= IT_FFN;
            { const int e = r / IT_FFN; r -= e * IT_FFN; const size_t eo = (size_t)e * DM * FF;
              ffn_job(INP(I_MG) + eo, INP(I_MU) + eo, INP(I_MD) + eo, (bf16_t*)(ws + WS_MGU + e * (SZ_GU / 2)), (bf16_t*)(ws + WS_MDN + e * (SZ_DN / 2)), r, scr, lane, INP(I_FFN_NORM) + DM, true); }
        }
        { const f32x4* src = (const f32x4*)INP(I_P); u32x2* dst = (u32x2*)(ws + WS_PBF); const size_t n4 = (size_t)2 * NTOK * PLE / 4;
          for (size_t i = (size_t)blockIdx.x * NTHR + F.tid; i < n4; i += (size_t)F.G * NTHR) { const f32x4 v = src[i]; u32x2 w; w.x = cvt_pk_bf16(v.x, v.y); w.y = cvt_pk_bf16(v.z, v.w); dst[i] = w; } }
        for (int i = blockIdx.x * NTHR + F.tid; i < SEQ * 96; i += F.G * NTHR) {
            const int pos = i / 96, j = i % 96; const bool t128 = j >= 32; const int jj = t128 ? j - 32 : j; const float dim = t128 ? 128.f : 64.f;
            const float inv = (float)exp2(-(double)(2 * jj) / (double)dim * 13.287712379549449);
            const float ang = (float)pos * inv; const double a = (double)ang; const double k = rint(a * 0.15915494309189535); const float r = (float)(a - k * 6.283185307179586);
            const float c = __cosf(r), s = __sinf(r);
            float* t = t128 ? tab128 + ((size_t)pos * 64 + jj) * 2 : tab64 + ((size_t)pos * 32 + jj) * 2; t[0] = c; t[1] = s;
        }
        for (int m = gw; m < NTOK; m += NGW) { const f32x4* xr = (const f32x4*)(INP(I_X) + (size_t)m * DM) + lane; f32x4 v[8];
#pragma unroll
            for (int j = 0; j < 8; ++j) v[j] = __builtin_nontemporal_load(&xr[64 * j]);
            row_hb_ss(v, HB2 + (size_t)m * DM, SSH + (size_t)m * 8, lane);
            { float s_ = 0.f, am = 0.f;
#pragma unroll
              for (int j = 0; j < 8; ++j) { s_ += (v[j].x * v[j].x + v[j].y * v[j].y) + (v[j].z * v[j].z + v[j].w * v[j].w); am = fmaxf(am, fmaxf(fmaxf(fabsf(v[j].x), fabsf(v[j].y)), fmaxf(fabsf(v[j].z), fabsf(v[j].w)))); }
              const float ri = 1.0f / sqrtf(wave_sum(s_) * (1.0f / DM) + EPS); am = fmaxf(wave_max(am), 1e-20f); const float sq_ = 127.0f / am;
              if (lane == 0) TRINV[m] = am * ri * (1.0f / (127.0f * 1536.0f));
              unsigned* hq = (unsigned*)(ws + WS_HQ8 + (size_t)m * DM) + lane;
#pragma unroll
              for (int j = 0; j < 8; ++j) hq[64 * j] = pk4_i8(v[j].x * sq_, v[j].y * sq_, v[j].z * sq_, v[j].w * sq_); } }
    }
    SEAM(0);

    for (int L = 0; L < DEPTH; ++L) {
        const int pb = 1 + L * PH_PER_LAYER;
        for (int rep_ = 0; rep_ < NREP(0); ++rep_) if (INREL(0) && IN(pb + 0)) { PH_LOCALS
            { pg8::SchedDense S; S.o.init(NTOK / 256, ZP / 256, F.G, (int)blockIdx.x); S.A = (const char*)(ws + (L == 0 ? WS_HQ8 : WS_XG8)); S.B = (const char*)(ws + WS_WIN + L * SZ_WIN); S.tA = (size_t)256 * DM; S.tB = (size_t)256 * DM;
              pg8::Epi<pg8::EPI_Z_I> E{Z, tab64, ZP, tab128, (float*)(ws + WS_SS), L == 0 ? TRINV : SSH + (size_t)(3 * L) * NTOK * 8, L == 0 ? 2 : 3, nullptr, nullptr, RED, L == 0 ? nullptr : SSH + (size_t)(3 * L - 1) * NTOK * 8};
              pg8::gemm_phase<pg8::Epi<pg8::EPI_Z_I>, pg8::SchedDense, 2>(F.lds + RING_OFF, F.tid, DM / 2, DM / 2, DM / 2, S, E); }
            if ((L & 1) == 0) {
              const int rem_ = ((NTOK / 256) * (ZP / 256)) % F.G; const bool sh_ = (rem_ > 0 && 2 * rem_ <= F.G);
              const int gpp = sh_ ? F.G - rem_ : F.G, cpp = sh_ ? ((int)blockIdx.x >= rem_ ? (int)blockIdx.x - rem_ : (1 << 24)) : (int)blockIdx.x;
              int gpp_s = gpp, cpp_s = cpp, kpp_s = PLE; asm volatile("" : "+s"(gpp_s), "+s"(cpp_s), "+s"(kpp_s));
              pg8::SchedDense S; S.o.init(NTOK / 256, DM / 256, gpp_s, cpp_s); S.A = (const char*)(ws + WS_PBF + (size_t)L * NTOK * PLE * 2); S.B = (const char*)(ws + WS_WPP + L * SZ_WPP); S.tA = (size_t)256 * PLE * 2; S.tB = (size_t)256 * PLE * 2;
              pg8::Epi<pg8::EPI_BF16> E{PPB, nullptr, DM, nullptr, nullptr, nullptr, 0, nullptr, nullptr, RED};
              pg8::gemm_phase(F.lds + RING_OFF, F.tid, PLE, PLE, kpp_s, S, E); }
        }
        SEAM(pb + 0);
        for (int rep_ = 0; rep_ < NREP(2); ++rep_) if (INREL(2) && IN(pb + 2)) { PH_LOCALS
            { pg8::SchedDense S; S.o.init(NTOK / 256, QMW / 256, F.G, (int)blockIdx.x); S.A = (const char*)(Z + O_MLA); S.B = (const char*)(ws + WS_WUQ + L * SZ_WUQ); S.tA = (size_t)256 * ZP * 2; S.tB = (size_t)256 * 512 * 2;
              pg8::Epi<pg8::EPI_SCALE> E{QM, nullptr, QMW, nullptr, (float*)(ws + WS_SS), nullptr, 0, nullptr, nullptr, RED};
              pg8::gemm_phase(F.lds + RING_OFF, F.tid, ZP, 512, 512, S, E); }
            { pg8::SchedDense S; S.o.init(NTOK / 256, KVW / 256, F.G, (int)blockIdx.x); S.A = (const char*)(Z + O_MLA + 512); S.B = (const char*)(ws + WS_WUKV + L * SZ_WUKV); S.tA = (size_t)256 * ZP * 2; S.tB = (size_t)256 * 512 * 2;
              pg8::Epi<pg8::EPI_SCALE> E{KVM, nullptr, KVW, nullptr, (float*)(ws + WS_SS) + 8, nullptr, 0, nullptr, nullptr, RED};
              pg8::gemm_phase(F.lds + RING_OFF, F.tid, ZP, 512, 512, S, E); }
        }
        SEAM(pb + 2);
#if !NAIVE_ATTN
#define ATT_LOCALS PH_LOCALS LAS unsigned char* al = F.lds + RING_OFF; const int tid = F.tid; const int r32 = lane & 31, hi = lane >> 5; (void)r32; (void)hi;
        for (int rep_ = 0; rep_ < NREP(3); ++rep_) if (INREL(3) && IN(pb + 3)) {
            { ATT_LOCALS
            for (int u = F.vcu; u < 256; u += F.G) {
                const int b = u >> 6, h = (u >> 4) & 3, qt = u & 15; const size_t rb = (size_t)b * SEQ, q0 = rb + qt * 256;
                att::Src S; S.q[0] = QM + q0 * QMW + h * 192; S.q[1] = S.q[0] + 64; S.q[2] = S.q[0] + 128; S.ldq = QMW;
                S.k[0] = KVM + rb * KVW + h * 256; S.k[1] = S.k[0] + 64; S.k[2] = Z + rb * ZP + 5120; S.ldk[0] = KVW; S.ldk[1] = KVW; S.ldk[2] = ZP; S.v = KVM + rb * KVW + h * 256 + 128; S.ldv = KVW;
                att::Par P; P.kt0 = 0; P.nkt = SEQ / 64; P.C = 0.07216878364870322f * 1.4426950408889634f; P.thr = 3.f / 0.07216878364870322f; P.rtab = tab64;       P.qpos0 = qt * 256; P.na_r0 = 0; P.na_krlo = 0;
                float m_reg = -1e30f, l_reg = 0.f; f32x16 o[4] = {};
                int tid_u = tid; asm volatile("" : "+v"(tid_u));
                att::attn_pass_pipe<3, 8, 2, 1, 0, 1>(al, tid_u, S, P, m_reg, l_reg, o);
                asm volatile("" : "+v"(tid_u));
                att::normalize(al, tid_u, l_reg, o);
                att::store_o8((unsigned char*)MIX + q0 * (DM * 2) + 1024 + 1024 + h * 128, DM * 2, tid_u, o);
            }
            }
            { ATT_LOCALS
                const float li = 0.8f - 0.6f * __expf(-0.3f * (float)L);
                float lam; { const float a = INP(I_LQ1)[L * 64 + lane] * INP(I_LK1)[L * 64 + lane], c = INP(I_LQ2)[L * 64 + lane] * INP(I_LK2)[L * 64 + lane]; lam = __expf(wave_sum(a)) - __expf(wave_sum(c)) + li; }
                const float* subln = INP(I_SUBLN) + L * 128;
                for (int u = F.vcu; u < 256; u += F.G) {
                    const int b = u >> 6, h = (u >> 4) & 3, qt = u & 15; const size_t rb = (size_t)b * SEQ, q0 = rb + qt * 256;
                    att::Src S; S.ldq = ZP; S.ldk[0] = ZP; S.ldk[1] = ZP; S.ldk[2] = ZP; S.ldv = ZP; S.v = Z + rb * ZP + 1024 + h * 128;
                    att::Par P; P.kt0 = 0; P.nkt = SEQ / 64; P.C = 0.125f * 1.4426950408889634f; P.thr = 8.f / 0.125f; P.rtab = tab64; P.qpos0 = qt * 256; P.na_r0 = 0; P.na_krlo = 0;
                    LAS unsigned* stash = (LAS unsigned*)(al + (F.wave < 4 ? att::OFF_K + (F.wave >> 1) * att::KBUF + att::KPL + (F.wave & 1) * 8192 : att::OFF_QL + (F.wave - 4) * 8192)) + lane;
                    {
                        S.q[0] = Z + q0 * ZP + h * 128; S.q[1] = S.q[0]; S.q[2] = S.q[0]; S.k[0] = Z + rb * ZP + 512 + h * 128; S.k[1] = S.k[0]; S.k[2] = S.k[0];
                        float m_reg = -1e30f, l_reg = 0.f; f32x16 o[4] = {};
                        int tid_v = tid; asm volatile("" : "+v"(tid_v));
                        att::attn_pass_pipe<1, 0, 2, 2, 0>(al, tid_v, S, P, m_reg, l_reg, o);
                        asm volatile("" : "+v"(tid_v));
                        att::normalize(al, tid_v, l_reg, o);
#pragma unroll
                        for (int d = 0; d < 4; ++d)
#pragma unroll
                            for (int r = 0; r < 8; ++r) stash[(d * 8 + r) * 64] = cvt_pk_bf16(o[d][2 * r], o[d][2 * r + 1]);
                    }
                    S.q[0] = Z + q0 * ZP + h * 128 + 64; S.q[1] = S.q[0]; S.q[2] = S.q[0]; S.k[0] = Z + rb * ZP + 512 + h * 128 + 64; S.k[1] = S.k[0]; S.k[2] = S.k[0];
                    float m_reg = -1e30f, l_reg = 0.f; f32x16 o[4] = {};
                    P.thr = 3.f / 0.125f;
                    int tid_u = tid; asm volatile("" : "+v"(tid_u));
                    att::attn_pass_pipe<1, 0, 2, 2, 0, 1>(al, tid_u, S, P, m_reg, l_reg, o);
                    asm volatile("" : "+v"(tid_u));
                    att::normalize(al, tid_u, l_reg, o);
                    const float sg[4] = {subln[r32] * (1.f - li), subln[32 + r32] * (1.f - li), subln[64 + r32] * (1.f - li), subln[96 + r32] * (1.f - li)};
#pragma unroll
                    for (int r = 0; r < 16; ++r) {
                        float ss = 0.f;
#pragma unroll
                        for (int d = 0; d < 4; ++d) { const unsigned w1 = stash[(d * 8 + (r >> 1)) * 64]; const float o1 = (r & 1) ? bfhi(w1) : bflo(w1); const float v = o1 - lam * o[d][r]; o[d][r] = v; ss += v * v; }
                        ss += swz_xor<1>(ss); ss += swz_xor<2>(ss); ss += swz_xor<4>(ss); ss += swz_xor<8>(ss); ss += swz_xor<16>(ss);
                        const float rn = 1.0f / sqrtf(ss * (1.0f / 128) + EPS);
#pragma unroll
                        for (int d = 0; d < 4; ++d) o[d][r] = o[d][r] * rn * sg[d];
                    }
                    att::store_o(MIX + q0 * DM + h * 128, DM, tid_u, o);
                }
            }
            { ATT_LOCALS
            for (int u = F.vcu; u < 256; u += F.G) {
                const int b = u >> 6, h = (u >> 4) & 3, qt = u & 15, kvh = h >> 1; const size_t rb = (size_t)b * SEQ, q0 = rb + qt * 256;
                att::Src S; S.q[0] = Z + q0 * ZP + O_SWA + h * 128; S.q[1] = S.q[0] + 64; S.q[2] = S.q[0]; S.ldq = ZP;
                S.k[0] = Z + rb * ZP + O_SWA + 512 + kvh * 128; S.k[1] = S.k[0] + 64; S.k[2] = S.k[0]; S.ldk[0] = ZP; S.ldk[1] = ZP; S.ldk[2] = ZP; S.v = Z + rb * ZP + O_SWA + 768 + kvh * 128; S.ldv = ZP;
                const int klo = max(0, qt * 256 - 128), khi = min(SEQ, qt * 256 + 384);
                att::Par P; P.kt0 = klo; P.nkt = (khi - klo) / 64; P.C = 0.08838834764831845f * 1.4426950408889634f; P.thr = 8.f / 0.08838834764831845f; P.rtab = tab128; P.qpos0 = qt * 256; P.na_r0 = 0; P.na_krlo = 0;
                float m_reg = INP(I_SINKS)[L * 4 + h] * (1.0f / 0.08838834764831845f), l_reg = 1.f; f32x16 o[4] = {};
                att::attn_pass<2, 2, 0, 4>(al, tid, S, P, m_reg, l_reg, o);
                att::normalize(al, tid, l_reg, o);
                att::store_o8((unsigned char*)MIX + q0 * (DM * 2) + 1024 + 512 + h * 128, DM * 2, tid, o);
            }
            }
            { ATT_LOCALS
            for (int u = F.vcu; u < 256; u += F.G) {
                const int b = u >> 6, h = (u >> 4) & 3, qt = u & 15; const size_t rb = (size_t)b * SEQ, q0 = rb + qt * 256;
                { const float* rpb = INP(I_RPB) + ((size_t)L * 4 + h) * 465; LAS float* bt = (LAS float*)(al + att::OFF_BIAS);
                  if (tid < 465) bt[tid] = rpb[tid] * (1.0f / 0.08838834764831845f);
                  __syncthreads(); }
                att::Src S; S.q[0] = Z + q0 * ZP + O_NA + h * 128; S.q[1] = S.q[0] + 64; S.q[2] = S.q[0]; S.ldq = ZP;
                S.k[0] = Z + rb * ZP + O_NA + 512 + h * 128; S.k[1] = S.k[0] + 64; S.k[2] = S.k[0]; S.ldk[0] = ZP; S.ldk[1] = ZP; S.ldk[2] = ZP; S.v = Z + rb * ZP + O_NA + 1024 + h * 128; S.ldv = ZP;
                const int r0 = qt * 4, krlo = min(max(r0 - 4, 0), 56), krhi = min(max(r0 + 3 - 4, 0), 56) + 7;
                att::Par P; P.kt0 = krlo * 64; P.nkt = krhi - krlo + 1; P.C = 0.08838834764831845f * 1.4426950408889634f; P.thr = 8.f / 0.08838834764831845f; P.rtab = tab64; P.qpos0 = qt * 256; P.na_r0 = r0; P.na_krlo = krlo;
                float m_reg = -1e30f, l_reg = 0.f; f32x16 o[4] = {};
                att::attn_pass<2, 1, 0, 0>(al, tid, S, P, m_reg, l_reg, o);
                att::normalize(al, tid, l_reg, o);
                att::store_o8((unsigned char*)MIX + q0 * (DM * 2) + 1024 + h * 128, DM * 2, tid, o);
                __syncthreads();
            }
            }
        }
#endif
        SEAM(pb + 3);
        for (int rep_ = 0; rep_ < NREP(4); ++rep_) if (INREL(4) && IN(pb + 4)) { PH_LOCALS
            { pg8::SchedDense S; S.o.init(NTOK / 256, DM / 256, F.G, (int)blockIdx.x); S.A = (const char*)MIX; S.B = (const char*)(ws + WS_WOUT + L * SZ_WSQ); S.tA = (size_t)256 * DM * 2; S.tB = (size_t)256 * DM * 2;
              pg8::Epi<pg8::EPI_RESID> E{nullptr, HB2, DM, nullptr, nullptr, nullptr, 0, HN, nullptr, RED};
              int k_ = 512; asm volatile("" : "+s"(k_)); pg8::gemm_phase(F.lds + RING_OFF, F.tid, DM, DM, k_, S, E); }
            { pg8::SchedDense S; S.o.init(NTOK / 256, DM / 256, F.G, (int)blockIdx.x); S.A = (const char*)MIX + 1024; S.B = (const char*)(ws + WS_WOUT + L * SZ_WSQ + 1024); S.tA = (size_t)256 * DM * 2; S.tB = (size_t)256 * DM * 2;
              int k_ = 768; asm volatile("" : "+s"(k_));
              if ((L & 1) == 0) {
                pg8::Epi<pg8::EPI_RESID_QI> E{ws + WS_HQ8, HN, DM, nullptr, nullptr, SSH + (size_t)(3 * L) * NTOK * 8, 1, HN, SSH + (size_t)(3 * L + 1) * NTOK * 8, RED};
                pg8::gemm_phase<pg8::Epi<pg8::EPI_RESID_QI>, pg8::SchedDense, 2>(F.lds + RING_OFF, F.tid, DM, DM, k_, S, E);
              } else {
                pg8::Epi<pg8::EPI_RESID_I> E{nullptr, HN, DM, nullptr, nullptr, nullptr, 0, HN, SSH + (size_t)(3 * L + 1) * NTOK * 8, RED};
                pg8::gemm_phase<pg8::Epi<pg8::EPI_RESID_I>, pg8::SchedDense, 2>(F.lds + RING_OFF, F.tid, DM, DM, k_, S, E);
              } }
        }
        SEAM(pb + 4);
        for (int rep_ = 0; rep_ < NREP(5); ++rep_) if (INREL(5) && IN(pb + 5)) { PH_LOCALS
            const float* g = INP(I_FFN_NORM) + L * DM;
            if (L & 1) {
                const float* wr = INP(I_ROUTER) + (size_t)(L >> 1) * DM * NE;
                LAS f32x4* wrl = (LAS f32x4*)(F.lds + RING_OFF);
                for (int p = F.tid; p < DM * 2; p += NTHR) { const int c = p >> 1, hf = p & 1; wrl[((((c >> 8) * 4 + (c & 3)) * 2 + hf) << 6) + ((c & 255) >> 2)] = *(const f32x4*)(wr + (size_t)c * 8 + hf * 4); }
                __syncthreads();
                volatile LAS unsigned* lcnt = F.MISC + 16;
                volatile LAS unsigned* lbase = F.MISC + 32;
                volatile LAS unsigned* linfo = F.MISC + 64;
                for (int chunk = blockIdx.x; chunk < NTOK / 64; chunk += F.G) {
                    if (F.tid < 8) lcnt[F.tid] = 0u;
                    __syncthreads();
                    for (int rr = 0; rr < 8; ++rr) {
                        const int lr = F.wave * 8 + rr, m = chunk * 64 + lr;
                        float ri; f32x4 v[8];
                        { const u32x2* xr = (const u32x2*)(HN + (size_t)m * DM) + lane; float s_ = 0.f;
#pragma unroll
                          for (int j = 0; j < 8; ++j) { const u32x2 w_ = xr[64 * j]; v[j] = (f32x4){bflo(w_.x), bfhi(w_.x), bflo(w_.y), bfhi(w_.y)}; s_ += (v[j].x * v[j].x + v[j].y * v[j].y) + (v[j].z * v[j].z + v[j].w * v[j].w); }
                          ri = 1.0f / sqrtf(wave_sum(s_) * (1.0f / DM) + EPS);
#pragma unroll
                          for (int j = 0; j < 8; ++j) v[j] = v[j] * ri * ((const f32x4*)g)[64 * j + lane];
                          { float am = 0.f; f32x4 x[8];
#pragma unroll
                            for (int j = 0; j < 8; ++j) { const f32x4 gg = ((const f32x4*)g)[64 * j + lane]; x[j] = (f32x4){v[j].x / gg.x, v[j].y / gg.y, v[j].z / gg.z, v[j].w / gg.w};
                                am = fmaxf(am, fmaxf(fmaxf(fabsf(x[j].x), fabsf(x[j].y)), fmaxf(fabsf(x[j].z), fabsf(x[j].w)))); }
                            am = fmaxf(wave_max(am), 1e-20f); const float sq_ = 127.0f / am;
                            if (lane == 0) TRINV[m] = am * (1.0f / (127.0f * 1536.0f));
                            unsigned* hq = (unsigned*)(ws + WS_HQ8 + (size_t)m * DM) + lane;
#pragma unroll
                            for (int j = 0; j < 8; ++j) hq[64 * j] = pk4_i8(x[j].x * sq_, x[j].y * sq_, x[j].z * sq_, x[j].w * sq_); } }
                        float lg[8];
#pragma unroll
                        for (int e = 0; e < 8; ++e) lg[e] = 0.f;
#pragma unroll
                        for (int j = 0; j < 8; ++j)
#pragma unroll
                            for (int q = 0; q < 4; ++q) { const f32x4 w0 = wrl[(((j * 4 + q) * 2 + 0) << 6) + lane], w1 = wrl[(((j * 4 + q) * 2 + 1) << 6) + lane]; const float x = v[j][q];
                                lg[0] += x * w0.x; lg[1] += x * w0.y; lg[2] += x * w0.z; lg[3] += x * w0.w; lg[4] += x * w1.x; lg[5] += x * w1.y; lg[6] += x * w1.z; lg[7] += x * w1.w; }
#pragma unroll
                        for (int e = 0; e < 8; ++e) lg[e] = wave_sum(lg[e]);
                        int e0 = 0; float v0 = lg[0];
#pragma unroll
                        for (int e = 1; e < 8; ++e) if (lg[e] > v0) { v0 = lg[e]; e0 = e; }
                        int e1 = -1; float v1 = -3.0e38f;
#pragma unroll
                        for (int e = 0; e < 8; ++e) if (e != e0 && lg[e] > v1) { v1 = lg[e]; e1 = e; }
                        if (lane == 0) {
                            const float g1 = 1.0f / (1.0f + __expf(v0 - v1)), g0 = 1.0f - g1;
                            const unsigned p0 = atomicAdd((unsigned*)&lcnt[e0], 1u), p1 = atomicAdd((unsigned*)&lcnt[e1], 1u);
                            linfo[lr * 6 + 0] = (unsigned)e0; linfo[lr * 6 + 1] = (unsigned)e1; linfo[lr * 6 + 2] = p0; linfo[lr * 6 + 3] = p1; linfo[lr * 6 + 4] = __float_as_uint(g0); linfo[lr * 6 + 5] = __float_as_uint(g1);
                        }
                    }
                    __syncthreads();
                    if (F.tid < 8) lbase[F.tid] = __hip_atomic_fetch_add(ctl + CW_MOE_CNT + 64 * F.tid, lcnt[F.tid], __ATOMIC_RELAXED, __HIP_MEMORY_SCOPE_AGENT);
                    __syncthreads();
                    if (F.tid < 64) { const int m = chunk * 64 + F.tid; const unsigned e0 = linfo[F.tid * 6], e1 = linfo[F.tid * 6 + 1];
                        unsigned* o = MOEI + (size_t)m * 8; o[0] = e0; o[1] = e1; o[2] = lbase[e0] + linfo[F.tid * 6 + 2]; o[3] = lbase[e1] + linfo[F.tid * 6 + 3]; o[4] = linfo[F.tid * 6 + 4]; o[5] = linfo[F.tid * 6 + 5]; }
                    __syncthreads();
                }
            }
        }
        if (L & 1) SEAM(pb + 5);
        for (int rep_ = 0; rep_ < NREP(6); ++rep_) if (INREL(6) && IN(pb + 6) && (L & 1)) { PH_LOCALS
            volatile LAS unsigned* tstart = F.MISC + 48;
            if (F.tid == 0) { unsigned acc = 0;
                for (int e = 0; e < 8; ++e) { tstart[e] = acc; const unsigned c = __hip_atomic_load(ctl + CW_MOE_CNT + 64 * e, __ATOMIC_RELAXED, __HIP_MEMORY_SCOPE_AGENT); acc += (c + 255u) >> 8; }
                tstart[8] = acc;
                if (blockIdx.x == 0) ctl[CW_MOE_TILES] = acc; }
            __syncthreads();
            if (blockIdx.x == 0 && F.tid < MOE_MAXT) { unsigned e = 0;
#pragma unroll
                for (int q = 1; q < 8; ++q) e += ((unsigned)F.tid >= tstart[q]) ? 1u : 0u;
                ctl[CW_MOE_TILES + 64 + F.tid] = e; }
            unsigned* STOK = (unsigned*)(ws + WS_STOK);
            for (int a = (int)blockIdx.x * NTHR + F.tid; a < NTOK * 2; a += F.G * NTHR) {
                const int m = a >> 1, k = a & 1; unsigned* inf = MOEI + (size_t)m * 8; const unsigned e = inf[k], pos = inf[2 + k]; const unsigned slot = tstart[e] * 256u + pos;
                inf[6 + k] = slot; STOK[slot] = (unsigned)m; SRINV[slot] = TRINV[m];
            }
            { unsigned char* XG8 = (unsigned char*)(ws + WS_XG8);
              for (int a = gw; a < NTOK * 2; a += NGW) { const int m = a >> 1, k = a & 1; const unsigned* inf = MOEI + (size_t)m * 8; const unsigned slot = tstart[inf[k]] * 256u + inf[2 + k];
                  const u32x4* src = (const u32x4*)(ws + WS_HQ8 + (size_t)m * DM) + lane; u32x4* dst = (u32x4*)(XG8 + (size_t)slot * DM) + lane;
                  dst[0] = src[0]; dst[64] = src[64]; } }
            if (blockIdx.x == 0) {
                for (int e = 0; e < 8; ++e) { const unsigned c = __hip_atomic_load(ctl + CW_MOE_CNT + 64 * e, __ATOMIC_RELAXED, __HIP_MEMORY_SCOPE_AGENT);
                    for (unsigned sl = tstart[e] * 256u + c + (unsigned)F.tid; sl < tstart[e + 1] * 256u; sl += NTHR) { STOK[sl] = 0u; SRINV[sl] = 0.f; } }
            }
        }
        if (L & 1) SEAM(pb + 6);
        for (int rep_ = 0; rep_ < NREP(7); ++rep_) if (INREL(7) && IN(pb + 7)) { PH_LOCALS
            if ((L & 1) == 0) {
                pg8::SchedDense S; S.o.init(NTOK / 256, 2 * FF / 256, F.G, (int)blockIdx.x); S.A = (const char*)(ws + WS_HQ8); S.B = (const char*)(ws + WS_DGU); S.tA = (size_t)256 * DM; S.tB = (size_t)256 * DM;
                pg8::Epi<pg8::EPI_SWIGLU8_I> E{ACT, nullptr, FF, nullptr, nullptr, SSH + (size_t)(3 * L + 1) * NTOK * 8, 3, nullptr, nullptr, RED, SSH + (size_t)(3 * L) * NTOK * 8};
                pg8::gemm_phase<pg8::Epi<pg8::EPI_SWIGLU8_I>, pg8::SchedDense, 2>(F.lds + RING_OFF, F.tid, DM / 2, DM / 2, DM / 2, S, E);
            } else {
                const int nT = __builtin_amdgcn_readfirstlane((int)__hip_atomic_load(ctl + CW_MOE_TILES, __ATOMIC_RELAXED, __HIP_MEMORY_SCOPE_AGENT));
                pg8::SchedMoe S; S.o.init(nT, 2 * FF / 256, F.G, (int)blockIdx.x); S.A = (const char*)(ws + WS_XG8); S.B = (const char*)(ws + WS_MGU); S.tA = (size_t)256 * DM; S.tB = (size_t)256 * DM; S.tE = SZ_GU / 2; S.tile_expert = ctl + CW_MOE_TILES + 64;
                pg8::Epi<pg8::EPI_SWIGLU8_I> E{ACT, nullptr, FF, nullptr, nullptr, SRINV, 2, nullptr, nullptr, RED};
                pg8::gemm_phase<pg8::Epi<pg8::EPI_SWIGLU8_I>, pg8::SchedMoe, 2>(F.lds + RING_OFF, F.tid, DM / 2, DM / 2, DM / 2, S, E);
            }
        }
        SEAM(pb + 7);
        for (int rep_ = 0; rep_ < NREP(8); ++rep_) if (INREL(8) && IN(pb + 8)) { PH_LOCALS
            if ((L & 1) == 0) {
                pg8::SchedDense S; S.o.init(NTOK / 256, DM / 256, F.G, (int)blockIdx.x); S.A = (const char*)ACT; S.B = (const char*)(ws + WS_DDN); S.tA = (size_t)256 * FF; S.tB = (size_t)256 * FF;
                pg8::Epi<pg8::EPI_RESID_Q8> E{ws + WS_HQ8, HN, DM, nullptr, nullptr, SSH + (size_t)(3 * L + 1) * NTOK * 8, 1, HN, SSH + (size_t)(3 * L + 2) * NTOK * 8, RED};
                pg8::gemm_phase<pg8::Epi<pg8::EPI_RESID_Q8>, pg8::SchedDense, 1>(F.lds + RING_OFF, F.tid, FF / 2, FF / 2, FF / 2, S, E);
            } else {
                const int nT = __builtin_amdgcn_readfirstlane((int)__hip_atomic_load(ctl + CW_MOE_TILES, __ATOMIC_RELAXED, __HIP_MEMORY_SCOPE_AGENT));
                pg8::SchedMoe S; S.o.init(nT, DM / 256, F.G, (int)blockIdx.x); S.A = (const char*)ACT; S.B = (const char*)(ws + WS_MDN); S.tA = (size_t)256 * FF; S.tB = (size_t)256 * FF; S.tE = SZ_DN / 2; S.tile_expert = ctl + CW_MOE_TILES + 64;
                pg8::Epi<pg8::EPI_BF16S> E{XG, nullptr, DM, nullptr, nullptr, nullptr, 0, nullptr, nullptr, RED};
                pg8::gemm_phase<pg8::Epi<pg8::EPI_BF16S>, pg8::SchedMoe, 1>(F.lds + RING_OFF, F.tid, FF / 2, FF / 2, FF / 2, S, E);
            }
        }
        for (int rep_ = 0; rep_ < NREP(8); ++rep_) if (INREL(8) && IN(pb + 8) && (L & 1)) { PH_LOCALS
            const int nT = __builtin_amdgcn_readfirstlane((int)__hip_atomic_load(ctl + CW_MOE_TILES, __ATOMIC_RELAXED, __HIP_MEMORY_SCOPE_AGENT));
                { const int rem_ = (nT * (DM / 256)) % F.G; const bool sh_ = (rem_ > 0 && 2 * rem_ <= F.G);
                  const int gpp = sh_ ? F.G - rem_ : F.G, cpp = sh_ ? ((int)blockIdx.x >= rem_ ? (int)blockIdx.x - rem_ : (1 << 24)) : (int)blockIdx.x;
                  int gpp_s = gpp, cpp_s = cpp, kpp_s = PLE; asm volatile("" : "+s"(gpp_s), "+s"(cpp_s), "+s"(kpp_s));
                  pg8::SchedDense S2; S2.o.init(NTOK / 256, DM / 256, gpp_s, cpp_s); S2.A = (const char*)(ws + WS_PBF + (size_t)L * NTOK * PLE * 2); S2.B = (const char*)(ws + WS_WPP + L * SZ_WPP); S2.tA = (size_t)256 * PLE * 2; S2.tB = (size_t)256 * PLE * 2;
                  pg8::Epi<pg8::EPI_BF16> E2{PPB, nullptr, DM, nullptr, nullptr, nullptr, 0, nullptr, nullptr, RED};
                  pg8::gemm_phase(F.lds + RING_OFF, F.tid, PLE, PLE, kpp_s, S2, E2); }
        }
        SEAM(pb + 8);
        for (int rep_ = 0; rep_ < NREP(9); ++rep_) if (INREL(9) && IN(pb + 9) && (L & 1)) { PH_LOCALS
            for (int m = gw; m < NTOK; m += NGW) {
                const unsigned* inf = MOEI + (size_t)m * 8; const float g0 = __uint_as_float(inf[4]), g1 = __uint_as_float(inf[5]);
                const u32x2* y0 = (const u32x2*)(XG + (size_t)inf[6] * DM) + lane; const u32x2* y1 = (const u32x2*)(XG + (size_t)inf[7] * DM) + lane;
                const u32x2* hp = (const u32x2*)(HN + (size_t)m * DM) + lane; f32x4 v[8];
#pragma unroll
                for (int j = 0; j < 8; ++j) { const u32x2 hw = hp[64 * j], a = y0[64 * j], b = y1[64 * j];
                    f32x4 h = {bflo(hw.x), bfhi(hw.x), bflo(hw.y), bfhi(hw.y)};
                    h.x += g0 * bflo(a.x) + g1 * bflo(b.x); h.y += g0 * bfhi(a.x) + g1 * bfhi(b.x); h.z += g0 * bflo(a.y) + g1 * bflo(b.y); h.w += g0 * bfhi(a.y) + g1 * bfhi(b.y); v[j] = h; }
                row_hb_ss(v, HN + (size_t)m * DM, SSH + ((size_t)(3 * L + 2) * NTOK + m) * 8, lane);
                { float s_ = 0.f;
#pragma unroll
                  for (int j = 0; j < 8; ++j) s_ += (v[j].x * v[j].x + v[j].y * v[j].y) + (v[j].z * v[j].z + v[j].w * v[j].w);
                  const float ri = 64.0f / sqrtf(wave_sum(s_) * (1.0f / DM) + EPS); unsigned* hq = (unsigned*)(ws + WS_HQ8 + (size_t)m * DM) + lane;
#pragma unroll
                  for (int j = 0; j < 8; ++j) hq[64 * j] = pk4_fp8(v[j].x * ri, v[j].y * ri, v[j].z * ri, v[j].w * ri); }
            }
        }
        if (L & 1) SEAM(pb + 9);
        for (int rep_ = 0; rep_ < NREP(10); ++rep_) if (INREL(10) && IN(pb + 10)) { PH_LOCALS
            if (L & 1) {
                pg8::SchedDense S; S.o.init(NTOK / 256, DM / 256, F.G, (int)blockIdx.x); S.A = (const char*)(ws + WS_HQ8); S.B = (const char*)(ws + WS_WPG + L * SZ_WSQ); S.tA = (size_t)256 * DM; S.tB = (size_t)256 * DM;
                pg8::Epi<pg8::EPI_PLE8> E{nullptr, PPB, DM, HN, nullptr, nullptr, 0, HB2, (L + 1 < DEPTH) ? SSH + (size_t)(3 * (L + 1)) * NTOK * 8 : nullptr, RED};
                pg8::gemm_phase<pg8::Epi<pg8::EPI_PLE8>, pg8::SchedDense, 1>(F.lds + RING_OFF, F.tid, DM / 2, DM / 2, DM / 2, S, E);
            } else {
            pg8::SchedDense S; S.o.init(NTOK / 256, DM / 256, F.G, (int)blockIdx.x); S.A = (const char*)(ws + WS_HQ8); S.B = (const char*)(ws + WS_WPG + L * SZ_WSQ); S.tA = (size_t)256 * DM; S.tB = (size_t)256 * DM;
            pg8::Epi<pg8::EPI_PLE_I> E{(L + 1 < DEPTH) ? ws + WS_XG8 : nullptr, PPB, DM, HN, nullptr, SSH + (size_t)(3 * L + 2) * NTOK * 8, 1, HB2, (L + 1 < DEPTH) ? SSH + (size_t)(3 * (L + 1)) * NTOK * 8 : nullptr, RED, SSH + (size_t)(3 * L + 1) * NTOK * 8};
            pg8::gemm_phase<pg8::Epi<pg8::EPI_PLE_I>, pg8::SchedDense, 2>(F.lds + RING_OFF, F.tid, DM / 2, DM / 2, DM / 2, S, E);
            }
        }
        SEAM(pb + 10);
        for (int rep_ = 0; rep_ < NREP(11); ++rep_) if (INREL(11) && IN(pb + 11) && (L + 1 == DEPTH)) { PH_LOCALS
            const float* g = INP(I_FINAL_NORM);
            for (int m = gw; m < NTOK; m += NGW) { f32x4* hp = (f32x4*)(OUTP + (size_t)m * DM) + lane; const u32x2* hb = (const u32x2*)(HB2 + (size_t)m * DM) + lane; f32x4 v[8]; float s = 0.f;
#pragma unroll
                for (int j = 0; j < 8; ++j) { const u32x2 w_ = hb[64 * j]; v[j] = (f32x4){bflo(w_.x), bfhi(w_.x), bflo(w_.y), bfhi(w_.y)}; s += (v[j].x * v[j].x + v[j].y * v[j].y) + (v[j].z * v[j].z + v[j].w * v[j].w); }
                const float ri = 1.0f / sqrtf(wave_sum(s) * (1.0f / DM) + EPS);
#pragma unroll
                for (int j = 0; j < 8; ++j) __builtin_nontemporal_store(v[j] * ri * ((const f32x4*)g)[64 * j + lane], &hp[64 * j]); }
        }
    }
#undef IN
#undef SEAM
}

extern "C" void kernel_launch(void* const* d_in, const int* in_sizes, int n_in, void* d_out, int out_size, void* d_ws, size_t ws_size, hipStream_t stream) {
    static int grid = 0;
    if (grid == 0) {
        if (n_in != N_IN || out_size != NTOK * DM || ws_size < WS_END) { fprintf(stderr, "kernel_launch: shape/ws mismatch: n_in %d out %d ws %zu need %zu\n", n_in, out_size, ws_size, (size_t)WS_END); grid = -1; return; }
        int dev = 0, cus = 0, per_cu = 0;
        if (hipGetDevice(&dev) != hipSuccess || hipDeviceGetAttribute(&cus, hipDeviceAttributeMultiprocessorCount, dev) != hipSuccess) { grid = -1; return; }
        if (hipFuncSetAttribute((const void*)fwd, hipFuncAttributeMaxDynamicSharedMemorySize, LDS_BYTES) != hipSuccess) { fprintf(stderr, "hipFuncSetAttribute failed\n"); grid = -1; return; }
        if (hipOccupancyMaxActiveBlocksPerMultiprocessor(&per_cu, (const void*)fwd, NTHR, LDS_BYTES) != hipSuccess || per_cu < 1) { fprintf(stderr, "occupancy query: %d\n", per_cu); }
        (void)hipGetLastError();
        grid = cus;
    }
    if (grid < 0) return;
    (void)hipMemsetAsync((char*)d_ws + WS_CTL, 0, CTL_ZERO_BYTES, stream);
    Args a; memset(&a, 0, sizeof(a));
    for (int i = 0; i < N_IN; ++i) a.in[i] = (const float*)d_in[i];
    a.out = (float*)d_out; a.ws = (unsigned char*)d_ws;
#if MK_ONE_LAUNCH
    a.ph_lo = 0; a.ph_hi = N_PHASES;
    hipLaunchKernelGGL(fwd, dim3(grid), dim3(NTHR), LDS_BYTES, stream, a);
#else
    for (int ph = 0; ph < N_PHASES; ++ph) {
        const int rel = ph == 0 ? -1 : (ph - 1) % PH_PER_LAYER, L = ph == 0 ? 0 : (ph - 1) / PH_PER_LAYER;
        if (rel == 3) {
#if NAIVE_ATTN
            hipLaunchKernelGGL(naive_attn<0>, dim3(NB * 4 * SEQ / 4), dim3(256), 0, stream, a, L);
            hipLaunchKernelGGL(naive_attn<1>, dim3(NB * 4 * SEQ / 4), dim3(256), 0, stream, a, L);
            hipLaunchKernelGGL(naive_attn<2>, dim3(NB * 4 * SEQ / 4), dim3(256), 0, stream, a, L);
            hipLaunchKernelGGL(naive_attn<3>, dim3(NB * 4 * SEQ / 4), dim3(256), 0, stream, a, L);
            continue;
#endif
        }
        if (rel == 6 && !(L & 1)) continue;
        a.ph_lo = ph; a.ph_hi = ph + 1;
        hipLaunchKernelGGL(fwd, dim3(grid), dim3(NTHR), LDS_BYTES, stream, a);
    }
#endif
    const hipError_t le = hipPeekAtLastError();
    if (le != hipSuccess) fprintf(stderr, "kernel_launch: launch failed: %s\n", hipGetErrorName(le));
}
```
